# Optimizing an MI355X kernel written in HIP

```python
import jax, jax.numpy as jnp
from jax import lax
import numpy as np

D_MODEL = 1024
BATCH = 2
SEQ = 16384
DEPTH = 1
DEC_BATCH = 8
DEC_SEQ = 16
PAST_LEN = 4096

CHUNK = 64
BAND_PAST_CHUNKS = 8
BAND_CHUNKS = BAND_PAST_CHUNKS + 1
HEAD_DIM = 64
H_A = 8
H_B = 8
W_A = H_A * HEAD_DIM
W_B = H_B * HEAD_DIM
REL_CLIP_PAST = 128
REL_TABLE = REL_CLIP_PAST + CHUNK
Q_BLOCK = 128
EPS = 1e-6
NEG_INF = -1e30
FORGET_BIAS_MEAN = 2.0
SCALE = HEAD_DIM ** -0.5
SPLIT_SIZES = [W_A] * 4 + [W_B] * 4 + [H_B, D_MODEL, D_MODEL]
N_IN = sum(SPLIT_SIZES)

kernel_name = "chunk_band_fox_hybrid_step"


def rmsnorm(x, g):
    x32 = x.astype(jnp.float32)
    y = x32 * lax.rsqrt(jnp.mean(x32 * x32, axis=-1, keepdims=True) + EPS) * g.astype(jnp.float32)
    return y.astype(x.dtype)


def rel_bias(table, dist):
    idx = jnp.clip(dist, -(CHUNK - 1), REL_CLIP_PAST) + (CHUNK - 1)
    return jnp.take(table, idx, axis=1).astype(jnp.float32)


def mixer_inputs(x, g_pre, w_in, b_f):
    h = rmsnorm(x, g_pre)
    z = jnp.einsum('bsd,dn->bsn', h, w_in)
    cuts = np.cumsum(SPLIT_SIZES)[:-1].tolist()
    qa, ka, va, za, qb, kb, vb, zb, fl, ma, mb = jnp.split(z, cuts, axis=-1)
    b, s = x.shape[0], x.shape[1]
    heads = lambda t, nh: t.reshape(b, s, nh, HEAD_DIM)
    logf = jax.nn.log_sigmoid((fl + b_f).astype(jnp.float32))
    return (heads(qa, H_A), heads(ka, H_A), heads(va, H_A), za,
            heads(qb, H_B), heads(kb, H_B), heads(vb, H_B), zb, logf, ma, mb)


def mixer_outputs(x, ya, yb, za, zb, ma, mb, w_br_a, w_br_b, w_out, g_post):
    ua = jnp.einsum('bsw,wd->bsd', ya.astype(x.dtype) * jax.nn.silu(za), w_br_a)
    ub = jnp.einsum('bsw,wd->bsd', yb.astype(x.dtype) * jax.nn.silu(zb), w_br_b)
    merged = jax.nn.sigmoid(ma) * ua + jax.nn.sigmoid(mb) * ub
    out = jnp.einsum('bsd,de->bse', merged, w_out)
    return x + rmsnorm(out, g_post)


def chunk_band_attention_prompt(q, k, v, table):
    b, s, h, d = q.shape
    nc = s // CHUNK
    pad = BAND_PAST_CHUNKS * CHUNK
    band = BAND_CHUNKS * CHUNK
    kp = jnp.pad(k, ((0, 0), (pad, 0), (0, 0), (0, 0)))
    vp = jnp.pad(v, ((0, 0), (pad, 0), (0, 0), (0, 0)))
    qc = jnp.moveaxis(q.reshape(b, nc, CHUNK, h, d), 1, 0)
    ki = jnp.arange(band)
    qi = jnp.arange(CHUNK)
    bias = rel_bias(table, (qi[:, None] + pad) - ki[None, :])

    def one_chunk(args):
        c, q_c = args
        k_c = lax.dynamic_slice_in_dim(kp, c * CHUNK, band, axis=1)
        v_c = lax.dynamic_slice_in_dim(vp, c * CHUNK, band, axis=1)
        sc = jnp.einsum('bqhd,bkhd->bhqk', q_c, k_c).astype(jnp.float32) * SCALE + bias[None]
        valid = (c * CHUNK - pad + ki) >= 0
        sc = jnp.where(valid[None, None, None, :], sc, NEG_INF)
        p = jax.nn.softmax(sc, axis=-1).astype(v.dtype)
        return jnp.einsum('bhqk,bkhd->bqhd', p, v_c)

    out = lax.map(one_chunk, (jnp.arange(nc), qc))
    return jnp.moveaxis(out, 0, 1).reshape(b, s, h * d)


def chunk_band_attention_sample(q, k_all, v_all, n_cache, table):
    b, t, h, d = q.shape
    sc = jnp.einsum('bqhd,bkhd->bhqk', q, k_all).astype(jnp.float32) * SCALE
    q_pos = n_cache + jnp.arange(t)
    k_pos = jnp.arange(n_cache + t)
    sc = sc + rel_bias(table, q_pos[:, None] - k_pos[None, :])[None]
    p = jax.nn.softmax(sc, axis=-1).astype(v_all.dtype)
    return jnp.einsum('bhqk,bkhd->bqhd', p, v_all).reshape(b, t, h * d)


def fox_prompt(q, k, v, logf):
    b, s, h, d = q.shape
    nb = s // Q_BLOCK
    F = jnp.cumsum(logf, axis=1)
    F_k = jnp.transpose(F, (0, 2, 1))
    qb = jnp.moveaxis(q.reshape(b, nb, Q_BLOCK, h, d), 1, 0)
    Fq = jnp.moveaxis(F.reshape(b, nb, Q_BLOCK, h), 1, 0)
    k_pos = jnp.arange(s)

    def one_block(args):
        i, q_i, F_i = args
        sc = jnp.einsum('bqhd,bkhd->bhqk', q_i, k).astype(jnp.float32) * SCALE
        sc = sc + jnp.transpose(F_i, (0, 2, 1))[..., None] - F_k[:, :, None, :]
        q_pos = i * Q_BLOCK + jnp.arange(Q_BLOCK)
        sc = jnp.where((k_pos[None, :] <= q_pos[:, None])[None, None], sc, NEG_INF)
        p = jax.nn.softmax(sc, axis=-1).astype(v.dtype)
        return jnp.einsum('bhqk,bkhd->bqhd', p, v)

    out = lax.map(one_block, (jnp.arange(nb), qb, Fq))
    return jnp.moveaxis(out, 0, 1).reshape(b, s, h * d)


def fox_sample(q, k_all, v_all, logf_all, n_cache):
    b, t, h, d = q.shape
    F = jnp.cumsum(logf_all.astype(jnp.float32), axis=1)
    F_k = jnp.transpose(F, (0, 2, 1))
    F_q = F_k[:, :, n_cache:]
    sc = jnp.einsum('bqhd,bkhd->bhqk', q, k_all).astype(jnp.float32) * SCALE
    sc = sc + F_q[..., None] - F_k[:, :, None, :]
    q_pos = n_cache + jnp.arange(t)
    k_pos = jnp.arange(n_cache + t)
    sc = jnp.where((k_pos[None, :] <= q_pos[:, None])[None, None], sc, NEG_INF)
    p = jax.nn.softmax(sc, axis=-1).astype(v_all.dtype)
    return jnp.einsum('bhqk,bkhd->bqhd', p, v_all).reshape(b, t, h * d)


def setup_inputs(seed: int = 0) -> dict:
    key = jax.random.key(seed)
    ks = jax.random.split(key, 16)
    a_keep = min(BAND_PAST_CHUNKS * CHUNK, PAST_LEN)
    nrm = lambda k, shape, s=1.0: s * jax.random.normal(k, shape, jnp.float32)
    return {
        "x_prompt": nrm(ks[0], (BATCH, SEQ, D_MODEL)),
        "x_sample": nrm(ks[1], (DEC_BATCH, DEC_SEQ, D_MODEL)),
        "cache_a_k": nrm(ks[2], (DEPTH, DEC_BATCH, a_keep, H_A, HEAD_DIM)),
        "cache_a_v": nrm(ks[3], (DEPTH, DEC_BATCH, a_keep, H_A, HEAD_DIM)),
        "cache_b_k": nrm(ks[4], (DEPTH, DEC_BATCH, PAST_LEN, H_B, HEAD_DIM)),
        "cache_b_v": nrm(ks[5], (DEPTH, DEC_BATCH, PAST_LEN, H_B, HEAD_DIM)),
        "cache_b_logf": jax.nn.log_sigmoid(FORGET_BIAS_MEAN + nrm(ks[6], (DEPTH, DEC_BATCH, PAST_LEN, H_B))),
        "g_pre": 1.0 + nrm(ks[7], (DEPTH, D_MODEL), 0.05),
        "w_in": nrm(ks[8], (DEPTH, D_MODEL, N_IN), D_MODEL ** -0.5),
        "b_f": FORGET_BIAS_MEAN + nrm(ks[9], (DEPTH, H_B), 0.5),
        "rel_table": nrm(ks[10], (DEPTH, H_A, REL_TABLE), 0.5),
        "w_br_a": nrm(ks[11], (DEPTH, W_A, D_MODEL), W_A ** -0.5),
        "w_br_b": nrm(ks[12], (DEPTH, W_B, D_MODEL), W_B ** -0.5),
        "w_out": nrm(ks[13], (DEPTH, D_MODEL, D_MODEL), D_MODEL ** -0.5),
        "g_post": 1.0 + nrm(ks[14], (DEPTH, D_MODEL), 0.05),
    }


def reference(x_prompt, x_sample, cache_a_k, cache_a_v, cache_b_k, cache_b_v, cache_b_logf,
              g_pre, w_in, b_f, rel_table, w_br_a, w_br_b, w_out, g_post):
    xp, xs = x_prompt, x_sample
    n_keep_p = min(BAND_PAST_CHUNKS * CHUNK, x_prompt.shape[1])
    n_cache_a = cache_a_k.shape[2]
    n_cache_b = cache_b_k.shape[2]
    akp, avp, bkp, bvp, blp = [], [], [], [], []
    aks, avs, bks, bvs, bls = [], [], [], [], []
    for l in range(DEPTH):
        qa, ka, va, za, qb, kb, vb, zb, logf, ma, mb = mixer_inputs(xp, g_pre[l], w_in[l], b_f[l])
        ya = chunk_band_attention_prompt(qa, ka, va, rel_table[l])
        yb = fox_prompt(qb, kb, vb, logf)
        akp.append(ka[:, -n_keep_p:])
        avp.append(va[:, -n_keep_p:])
        bkp.append(kb)
        bvp.append(vb)
        blp.append(logf)
        xp = mixer_outputs(xp, ya, yb, za, zb, ma, mb, w_br_a[l], w_br_b[l], w_out[l], g_post[l])

        qa, ka, va, za, qb, kb, vb, zb, logf, ma, mb = mixer_inputs(xs, g_pre[l], w_in[l], b_f[l])
        ka_all = jnp.concatenate([cache_a_k[l], ka], axis=1)
        va_all = jnp.concatenate([cache_a_v[l], va], axis=1)
        ya = chunk_band_attention_sample(qa, ka_all, va_all, n_cache_a, rel_table[l])
        kb_all = jnp.concatenate([cache_b_k[l], kb], axis=1)
        vb_all = jnp.concatenate([cache_b_v[l], vb], axis=1)
        lf_all = jnp.concatenate([cache_b_logf[l].astype(jnp.float32), logf], axis=1)
        yb = fox_sample(qb, kb_all, vb_all, lf_all, n_cache_b)
        aks.append(ka_all[:, -n_cache_a:])
        avs.append(va_all[:, -n_cache_a:])
        bks.append(kb)
        bvs.append(vb)
        bls.append(logf)
        xs = mixer_outputs(xs, ya, yb, za, zb, ma, mb, w_br_a[l], w_br_b[l], w_out[l], g_post[l])

    return (xp, xs,
            jnp.stack(akp), jnp.stack(avp), jnp.stack(bkp), jnp.stack(bvp), jnp.stack(blp),
            jnp.stack(aks), jnp.stack(avs), jnp.stack(bks), jnp.stack(bvs), jnp.stack(bls))
```

```cpp
#include <hip/hip_runtime.h>
#include <hip/hip_bf16.h>
#include <cstdio>
#include <cstdint>

constexpr int DM = 1024, NB = 2, SEQ = 16384, DECB = 8, DECS = 16, PAST = 4096, AKEEP = 512;
constexpr int NH = 8, HD = 64, WA = 512;
constexpr int NIN = 6152;
constexpr int NG = 6144;
constexpr int MP = NB * SEQ;
constexpr int MS = DECB * DECS;
constexpr int MTOT = MP + 256;
constexpr int NREL = 192;
constexpr float EPS = 1e-6f;
constexpr float L2E = 1.4426950408889634f;
constexpr float C2 = 0.125f * L2E;
constexpr int FS_PITCH = 4160;

constexpr size_t O_YP = 0, O_YS = 33554432, O_AKP = 33685504, O_AVP = 34209792, O_BKP = 34734080, O_BVP = 51511296, O_BLP = 68288512,
                 O_AKS = 68550656, O_AVS = 70647808, O_BKS = 72744960, O_BVS = 72810496, O_BLS = 72876032, O_END = 72877056;

constexpr size_t MiB = 1u << 20;
constexpr size_t WS_CTL = 0, CTL_ZERO_BYTES = 1 * MiB;
constexpr size_t WS_FP = 1 * MiB;
constexpr size_t WS_LFP = 2 * MiB;
constexpr size_t WS_FS = 3 * MiB;
constexpr size_t WS_LFN = 5 * MiB;
constexpr size_t WS_WIN = 6 * MiB;
constexpr size_t WS_WBR = 18 * MiB;
constexpr size_t WS_WOUT = 20 * MiB;
constexpr size_t WS_XN = 24 * MiB;
constexpr size_t ACT_BYTES = (size_t)MTOT * 512 * 2;
constexpr size_t WS_QA = 89 * MiB, WS_KA = 122 * MiB, WS_VA = 155 * MiB, WS_QB = 188 * MiB, WS_KB = 221 * MiB, WS_VB = 254 * MiB;
constexpr size_t WS_MG = 89 * MiB;
constexpr size_t WS_OUTF = 155 * MiB;
constexpr size_t WS_SZA = 287 * MiB, WS_SZB = 320 * MiB;
constexpr size_t WS_SMA = 353 * MiB, WS_SMB = 418 * MiB;
constexpr size_t WS_END = 483 * MiB;
static_assert(ACT_BYTES <= 33 * MiB && WS_XN + 2 * ACT_BYTES <= WS_QA && WS_OUTF + (size_t)MTOT * 1024 * 4 <= WS_SZA && WS_MG + 2 * ACT_BYTES <= WS_OUTF, "ws map");

constexpr int CW_KNORM = 64;
constexpr int CW_BAR = 4096;

constexpr int RING_BYTES = 131072;
constexpr int LDSCTL_OFF = RING_BYTES, MISC_OFF = LDSCTL_OFF + 320;
constexpr int TB_OFF = LDSCTL_OFF + 1024;
constexpr int WSF_OFF = LDSCTL_OFF + 2048;
constexpr int QMX_OFF = LDSCTL_OFF + 4096;
constexpr int LDS_BYTES = 147456;

#define GAS __attribute__((address_space(1)))
#define LAS __attribute__((address_space(3)))
typedef unsigned short bf16;
typedef unsigned v4u __attribute__((ext_vector_type(4)));
typedef unsigned v2u __attribute__((ext_vector_type(2)));
typedef float f32x4 __attribute__((ext_vector_type(4)));
typedef float f32x2 __attribute__((ext_vector_type(2)));
typedef float f32x16 __attribute__((ext_vector_type(16)));
typedef short bf16x8 __attribute__((ext_vector_type(8)));
typedef short s16x4 __attribute__((ext_vector_type(4)));
typedef short v4i16_t __attribute__((ext_vector_type(4)));
typedef __bf16 bf16x2_t __attribute__((ext_vector_type(2)));
typedef GAS unsigned gu32;
#define RLX_AGENT __ATOMIC_RELAXED, __HIP_MEMORY_SCOPE_AGENT

__device__ __forceinline__ unsigned cvtpk(float lo, float hi) { f32x2 v = {lo, hi}; bf16x2_t b = __builtin_convertvector(v, bf16x2_t); return __builtin_bit_cast(unsigned, b); }
__device__ __forceinline__ int fresh_tid() { int t = threadIdx.x; asm volatile("" : "+v"(t)); return t; }
__device__ __forceinline__ float bflo(unsigned u) { return __uint_as_float(u << 16); }
__device__ __forceinline__ float bfhi(unsigned u) { return __uint_as_float(u & 0xffff0000u); }
__device__ __forceinline__ float fexp2(float x) { return __builtin_amdgcn_exp2f(x); }
__device__ __forceinline__ float sigmoidf_(float v) { return __builtin_amdgcn_rcpf(1.0f + fexp2(-v * L2E)); }

namespace pg8 {
#define PG8_LAS __attribute__((address_space(3)))
typedef unsigned short bf16_t;
typedef unsigned u32x4 __attribute__((ext_vector_type(4)));
constexpr int BM = 256, BK = 64, HALF = 128, HTB = HALF * BK * 2, STAGE_BYTES = 8 * HTB, NXCD = 8, WGM = 8;

__host__ __device__ __forceinline__ int lds_byte(int r, int c) { const int st = (r >> 4) * 2 + (c >> 5), rr = r & 15, cc = c & 31, ob = rr * 64 + cc * 2; return st * 1024 + (ob ^ (((ob >> 9) & 1) << 5)); }
__host__ __device__ __forceinline__ void stage_rc(int b, int& R, int& C) { const int st = b / 1024, sb = b % 1024, swz = sb ^ (((sb >> 9) & 1) << 5); R = (st >> 1) * 16 + swz / 64; C = (st & 1) * 32 + (swz % 64) / 2; }
__host__ __device__ __forceinline__ int perm32(int rho) { const int n = rho >> 4, i = rho & 15; return 8 * (i >> 2) + 4 * n + (i & 3); }

struct Unit { int pm, pn, kh; };
struct Gemm { const bf16_t* A; const bf16_t* Bt; int ldk; int nt; };

struct StaticOrder {
    int nM, nN, nwg, G, c, nkh;
    __device__ void init(int M, int N, int G_, int c_, int nkh_) { nM = M / BM; nN = N / BM; nwg = nM * nN; G = G_; c = c_; nkh = nkh_; }
    __device__ bool next(int i, Unit& u) const {
        const int ti = i / nkh; u.kh = i - ti * nkh;
        const long L = (long)ti * G + c; if (L >= nwg) return false;
        int wgid = (int)L; { const int q = nwg / NXCD, r = nwg % NXCD, xcd = wgid % NXCD, off = wgid / NXCD; wgid = (xcd < r ? xcd * (q + 1) : r * (q + 1) + (xcd - r) * q) + off; }
        const int nig = WGM * nN, gid = wgid / nig, fm = gid * WGM, gsz = (nM - fm) < WGM ? (nM - fm) : WGM;
        u.pm = fm + ((wgid % nig) % gsz); u.pn = (wgid % nig) / gsz; return true;
    }
};


struct EpiInProj {
    static constexpr bool PERM = true;
    bf16_t *QA, *KA, *VA, *SZA, *QB, *KB, *VB, *SZB, *SMA, *SMB;
    float* out;
    unsigned* knorm;
    __device__ __forceinline__ bool keep(const Unit&) const { return false; }
    __device__ __forceinline__ void operator()(f32x4 (&acc)[2][2][4][2], const Unit& u, int wr, int wc, int fr, int fq) const {
        const int pn = u.pn, pm = u.pm;
        bf16_t* dst; int ldd, dcol, actk; float* f32p = nullptr; int fmode = 0, nvalid = 256; bool dnorm = false;
        const bool sample = (pm == 128);
        if (pn < 16) {
            const int seg = pn >> 1; dcol = (pn & 1) * 256; ldd = 512;
            if (seg == 0) { dst = QA; actk = 1; }
            else if (seg == 1) { dst = KA; actk = 0; }
            else if (seg == 2) { dst = VA; actk = 0; }
            else if (seg == 3) { dst = SZA; actk = 2; }
            else if (seg == 4) { dst = QB; actk = 1; }
            else if (seg == 5) { dst = KB; actk = 0; }
            else if (seg == 6) { dst = VB; actk = 0; }
            else { dst = SZB; actk = 2; }
            if (seg == 1 || seg == 2) {
                if (!sample) { const int bt = pm & 63; if (bt >= 62) { f32p = out + (seg == 1 ? O_AKP : O_AVP) + ((size_t)((pm >> 6) * 512 + (bt - 62) * 256)) * 512 + dcol; fmode = 1; } }
                else { f32p = out + (seg == 1 ? O_AKS : O_AVS) + dcol; fmode = 2; nvalid = 128; }
            } else if (seg == 5 || seg == 6) {
                if (!sample) { f32p = out + (seg == 5 ? O_BKP : O_BVP) + (size_t)pm * 256 * 512 + dcol; fmode = 1; dnorm = (seg == 5); }
                else { f32p = out + (seg == 5 ? O_BKS : O_BVS) + dcol; fmode = 1; nvalid = 128; }
            }
        } else { ldd = 1024; actk = 3; if (pn < 20) { dst = SMA; dcol = (pn - 16) * 256; } else { dst = SMB; dcol = (pn - 20) * 256; } }
        const int rl0 = wr * 64 + fr, cl = wc * 32 + 8 * fq;
        if (dnorm) {
#pragma unroll
            for (int bj = 0; bj < 2; ++bj) { float mx = 0.f;
#pragma unroll
                for (int ai = 0; ai < 2; ++ai)
#pragma unroll
                    for (int m = 0; m < 4; ++m) { const f32x4 a = acc[ai][bj][m][0], b = acc[ai][bj][m][1];
                        float s = (a[0] * a[0] + a[1] * a[1]) + (a[2] * a[2] + a[3] * a[3]) + (b[0] * b[0] + b[1] * b[1]) + (b[2] * b[2] + b[3] * b[3]);
                        s += __shfl_xor(s, 16); s += __shfl_xor(s, 32); mx = fmaxf(mx, s); }
                mx = fmaxf(mx, __shfl_xor(mx, 1)); mx = fmaxf(mx, __shfl_xor(mx, 2)); mx = fmaxf(mx, __shfl_xor(mx, 4)); mx = fmaxf(mx, __shfl_xor(mx, 8));
                if (fr == 0 && fq == 0) { const int head = (pn & 1) * 4 + bj * 2 + (wc >> 1);
                    __hip_atomic_fetch_max(knorm + (((pm >> 6) * 8 + head) * 2 + (wc & 1)), __float_as_uint(mx), __ATOMIC_RELAXED, __HIP_MEMORY_SCOPE_AGENT); }
            }
        }
#pragma unroll
        for (int ai = 0; ai < 2; ++ai)
#pragma unroll
            for (int m = 0; m < 4; ++m) { const int rl = rl0 + ai * HALF + m * 16; const size_t grow = (size_t)pm * BM + rl;
#pragma unroll
                for (int bj = 0; bj < 2; ++bj) { f32x4 v0 = acc[ai][bj][m][0], v1 = acc[ai][bj][m][1];
                    if (f32p != nullptr && rl < nvalid) { const size_t ro = (fmode == 1) ? (size_t)rl * 512 : ((size_t)((rl >> 4) * 512 + 496 + (rl & 15))) * 512;
                        *(f32x4*)(f32p + ro + cl + bj * HALF) = v0; *(f32x4*)(f32p + ro + cl + bj * HALF + 4) = v1; }
                    if (actk == 1) { v0 = v0 * C2; v1 = v1 * C2; }
                    else if (actk == 2) {
#pragma unroll
                        for (int e = 0; e < 4; ++e) { v0[e] = v0[e] * sigmoidf_(v0[e]); v1[e] = v1[e] * sigmoidf_(v1[e]); } }
                    else if (actk == 3) {
#pragma unroll
                        for (int e = 0; e < 4; ++e) { v0[e] = sigmoidf_(v0[e]); v1[e] = sigmoidf_(v1[e]); } }
                    u32x4 w; w.x = cvtpk(v0[0], v0[1]); w.y = cvtpk(v0[2], v0[3]); w.z = cvtpk(v1[0], v1[1]); w.w = cvtpk(v1[2], v1[3]);
                    *(u32x4*)(dst + grow * ldd + dcol + cl + bj * HALF) = w; } }
    }
};
struct EpiMerge {
    static constexpr bool PERM = true;
    const bf16_t *SMA, *SMB; bf16_t* MG;
    __device__ __forceinline__ bool keep(const Unit& u) const { return u.kh == 0; }
    __device__ __forceinline__ void operator()(f32x4 (&acc)[2][2][4][2], const Unit& u, int wr, int wc, int fr, int fq) const {
        const int rl0 = wr * 64 + fr, cl = wc * 32 + 8 * fq;
#pragma unroll
        for (int ai = 0; ai < 2; ++ai)
#pragma unroll
            for (int m = 0; m < 4; ++m) { const size_t grow = (size_t)u.pm * BM + rl0 + ai * HALF + m * 16;
#pragma unroll
                for (int bj = 0; bj < 2; ++bj) { const size_t off = grow * 1024 + u.pn * BM + cl + bj * HALF;
                    const u32x4 sb = *(const u32x4*)(SMB + off);
                    float g[8] = {bflo(sb.x), bfhi(sb.x), bflo(sb.y), bfhi(sb.y), bflo(sb.z), bfhi(sb.z), bflo(sb.w), bfhi(sb.w)};
                    if (u.kh == 0) { const u32x4 sa = *(const u32x4*)(SMA + off);
                        const float a[8] = {bflo(sa.x), bfhi(sa.x), bflo(sa.y), bfhi(sa.y), bflo(sa.z), bfhi(sa.z), bflo(sa.w), bfhi(sa.w)};
#pragma unroll
                        for (int e = 0; e < 8; ++e) g[e] = a[e] * __builtin_amdgcn_rcpf(g[e]);
#pragma unroll
                        for (int e = 0; e < 4; ++e) { acc[ai][bj][m][0][e] *= g[e]; acc[ai][bj][m][1][e] *= g[4 + e]; }
                    } else { f32x4 v0 = acc[ai][bj][m][0], v1 = acc[ai][bj][m][1];
#pragma unroll
                        for (int e = 0; e < 4; ++e) { v0[e] *= g[e]; v1[e] *= g[4 + e]; }
                        u32x4 w; w.x = cvtpk(v0[0], v0[1]); w.y = cvtpk(v0[2], v0[3]); w.z = cvtpk(v1[0], v1[1]); w.w = cvtpk(v1[2], v1[3]);
                        *(u32x4*)(MG + off) = w; } } }
    }
};
struct EpiF32 {
    static constexpr bool PERM = false;
    float* C; int ldc;
    __device__ __forceinline__ bool keep(const Unit&) const { return false; }
    __device__ __forceinline__ void operator()(f32x4 (&acc)[2][2][4][2], const Unit& u, int wr, int wc, int fr, int fq) const {
        const int row0 = u.pm * BM + wr * 64 + fr, col0 = u.pn * BM + wc * 32 + 4 * fq;
#pragma unroll
        for (int ai = 0; ai < 2; ++ai)
#pragma unroll
            for (int m = 0; m < 4; ++m) { float* rowp = C + (size_t)(row0 + ai * HALF + m * 16) * ldc + col0;
#pragma unroll
                for (int bj = 0; bj < 2; ++bj)
#pragma unroll
                    for (int n = 0; n < 2; ++n) *(f32x4*)(rowp + bj * HALF + n * 16) = acc[ai][bj][m][n]; }
    }
};

template <class Epi, class Sched>
__device__ __forceinline__ void gemm_phase(PG8_LAS unsigned char* lds, const Gemm g, const Sched& S, const Epi& E) {
    const int tid = fresh_tid(), wid = __builtin_amdgcn_readfirstlane(tid >> 6), lane = tid & 63, wr = wid >> 2, wc = wid & 3, fr = lane & 15, fq = lane >> 4;
    const int K = g.ldk, nt = g.nt;
    unsigned voffA[2], voffB[2];
#pragma unroll
    for (int i = 0; i < 2; ++i) { int R, C; stage_rc(tid * 16 + i * 8192, R, C); const int Rb = Epi::PERM ? ((R & ~31) + perm32(R & 31)) : R;
        voffA[i] = (unsigned)(R * K + C) * 2u; voffB[i] = (unsigned)(Rb * K + C) * 2u; }
    const size_t kstep = (size_t)(BK * 2);
    const size_t hstep = (size_t)HALF * K * 2;
    const size_t tstep = 2 * hstep;
    const size_t khb = (size_t)nt * BK * 2;
    const unsigned ldsw = (unsigned)wid * 1024u;
    const int aoff = lds_byte(wr * 64 + fr, fq * 8), boff = lds_byte(wc * 32 + fr, fq * 8);
#define PG8_SA(b, h) (((b) * 2 + (h)) * HTB)
#define PG8_SB(b, h) ((4 + (b) * 2 + (h)) * HTB)
#define PG8_STAGE(bufoff, gbase, voff) do { _Pragma("unroll") for (int _i = 0; _i < 2; ++_i) \
        __builtin_amdgcn_global_load_lds((const unsigned*)((const char*)(gbase) + (voff)[_i]), (PG8_LAS unsigned*)(lds + (bufoff) + ldsw + _i * 8192), 16, 0, 0); } while (0)
#define PG8_LDA(dst, b, h) do { _Pragma("unroll") for (int m = 0; m < 4; ++m) _Pragma("unroll") for (int k = 0; k < 2; ++k) dst[m][k] = *(const PG8_LAS bf16x8*)(lds + PG8_SA(b, h) + aoff + m * 2048 + k * 1024); } while (0)
#define PG8_LDB(dst, b, h) do { _Pragma("unroll") for (int n = 0; n < 2; ++n) _Pragma("unroll") for (int k = 0; k < 2; ++k) dst[n][k] = *(const PG8_LAS bf16x8*)(lds + PG8_SB(b, h) + boff + n * 2048 + k * 1024); } while (0)
#define PG8_MMA(ai, bj, At, Bt) do { __builtin_amdgcn_s_setprio(1); _Pragma("unroll") for (int m = 0; m < 4; ++m) _Pragma("unroll") for (int n = 0; n < 2; ++n) _Pragma("unroll") for (int k = 0; k < 2; ++k) \
        acc[ai][bj][m][n] = __builtin_amdgcn_mfma_f32_16x16x32_bf16(Bt[n][k], At[m][k], acc[ai][bj][m][n], 0, 0, 0); __builtin_amdgcn_s_setprio(0); } while (0)
#define PG8_WAIT_V(n) asm volatile("s_waitcnt vmcnt(" #n ")" ::: "memory")
#define PG8_WAIT_L(n) asm volatile("s_waitcnt lgkmcnt(" #n ")" ::: "memory")
#define PG8_BAR __builtin_amdgcn_s_barrier()
#define PG8_SCHED __builtin_amdgcn_sched_barrier(0)
    Unit cur, nxt; int ui = 0;
    if (!S.next(0, cur)) return;
    f32x4 acc[2][2][4][2];
#pragma unroll
    for (int a = 0; a < 2; ++a)
#pragma unroll
        for (int b = 0; b < 2; ++b)
#pragma unroll
            for (int m = 0; m < 4; ++m)
#pragma unroll
                for (int n = 0; n < 2; ++n) acc[a][b][m][n] = (f32x4){0.f, 0.f, 0.f, 0.f};
    bf16x8 At[4][2], B0[2][2], B1[2][2];
    const char* cA = (const char*)g.A + (size_t)cur.pm * tstep + (size_t)cur.kh * khb; const char* cB = (const char*)g.Bt + (size_t)cur.pn * tstep + (size_t)cur.kh * khb;
    PG8_STAGE(PG8_SB(0, 0), cB, voffB); PG8_STAGE(PG8_SB(0, 1), cB + hstep, voffB); PG8_STAGE(PG8_SA(0, 0), cA, voffA); PG8_STAGE(PG8_SA(0, 1), cA + hstep, voffA);
    if (wr == 1) PG8_BAR;
    PG8_WAIT_V(2); PG8_BAR;
    PG8_STAGE(PG8_SB(1, 0), cB + kstep, voffB); PG8_STAGE(PG8_SA(1, 0), cA + kstep, voffA); PG8_STAGE(PG8_SB(1, 1), cB + hstep + kstep, voffB);
    PG8_WAIT_V(6); PG8_BAR;
    for (;;) {
        const bool has_next = S.next(ui + 1, nxt);
        const char* nA = has_next ? (const char*)g.A + (size_t)nxt.pm * tstep + (size_t)nxt.kh * khb : cA; const char* nB = has_next ? (const char*)g.Bt + (size_t)nxt.pn * tstep + (size_t)nxt.kh * khb : cB;
        for (int t = 0; t < nt; t += 2) {
            const bool last = (t == nt - 2);
            const char* a1 = cA + (size_t)(t + 1) * kstep;
            const char* a2 = last ? nA : cA + (size_t)(t + 2) * kstep; const char* b2 = last ? nB : cB + (size_t)(t + 2) * kstep;
            const char* a3 = a2 + kstep; const char* b3 = b2 + kstep;
            PG8_LDB(B0, 0, 0); PG8_LDB(B1, 0, 1); PG8_SCHED; PG8_LDA(At, 0, 0); PG8_STAGE(PG8_SA(1, 1), a1 + hstep, voffA);
            PG8_WAIT_V(8); PG8_WAIT_L(0); PG8_BAR; PG8_MMA(0, 0, At, B0); PG8_MMA(0, 1, At, B1); PG8_BAR; PG8_SCHED;
            PG8_LDA(At, 0, 1); PG8_STAGE(PG8_SB(0, 0), b2, voffB); PG8_STAGE(PG8_SB(0, 1), b2 + hstep, voffB); PG8_STAGE(PG8_SA(0, 0), a2, voffA);
            PG8_WAIT_V(8); PG8_WAIT_L(0); PG8_BAR; PG8_MMA(1, 0, At, B0); PG8_MMA(1, 1, At, B1); PG8_BAR; PG8_SCHED;
            PG8_LDB(B0, 1, 0); PG8_LDB(B1, 1, 1); PG8_SCHED; PG8_LDA(At, 1, 0); PG8_STAGE(PG8_SA(0, 1), a2 + hstep, voffA);
            PG8_WAIT_V(8); PG8_WAIT_L(0); PG8_BAR; PG8_MMA(0, 0, At, B0); PG8_MMA(0, 1, At, B1); PG8_BAR; PG8_SCHED;
            PG8_LDA(At, 1, 1); PG8_STAGE(PG8_SB(1, 0), b3, voffB); PG8_STAGE(PG8_SB(1, 1), b3 + hstep, voffB); PG8_STAGE(PG8_SA(1, 0), a3, voffA);
            PG8_WAIT_V(8); PG8_WAIT_L(0); PG8_BAR; PG8_MMA(1, 0, At, B0); PG8_MMA(1, 1, At, B1); PG8_BAR; PG8_SCHED;
        }
        if (wr == 0) PG8_BAR;
        E(acc, cur, wr, wc, fr, fq);
        if (!has_next) break;
        if (!E.keep(cur)) {
#pragma unroll
            for (int a = 0; a < 2; ++a)
#pragma unroll
                for (int b = 0; b < 2; ++b)
#pragma unroll
                    for (int m = 0; m < 4; ++m)
#pragma unroll
                        for (int n = 0; n < 2; ++n) acc[a][b][m][n] = (f32x4){0.f, 0.f, 0.f, 0.f};
        }
        cur = nxt; cA = nA; cB = nB; ++ui;
        if (wr == 1) PG8_BAR;
    }
    PG8_WAIT_V(0);
    PG8_BAR;
#undef PG8_SA
#undef PG8_SB
#undef PG8_STAGE
#undef PG8_LDA
#undef PG8_LDB
#undef PG8_MMA
#undef PG8_WAIT_V
#undef PG8_WAIT_L
#undef PG8_BAR
#undef PG8_SCHED
}
}

#define XB_TMO      128
#define XB_XCNT(j)  (256  + 64 * (j))
#define XB_XSUB(j)  (1280 + 64 * (j))
#define XB_XGEN(j)  (2304 + 64 * (j))
#define XB_TOP      3328
#define XB_TOPGEN   3392
#define XCD_BAR_WORDS 3456
#define XB_SPIN_CAP (1u << 18)
__device__ __forceinline__ unsigned xb_ld(unsigned* p)              { return __hip_atomic_load(p, __ATOMIC_RELAXED, __HIP_MEMORY_SCOPE_AGENT); }
__device__ __forceinline__ unsigned xb_add(unsigned* p, unsigned v) { return __hip_atomic_fetch_add(p, v, __ATOMIC_RELAXED, __HIP_MEMORY_SCOPE_AGENT); }
__device__ __forceinline__ unsigned xb_xcc_id() { return (unsigned)__builtin_amdgcn_s_getreg((3 << 11) | 20) & 0xFu; }
#define XB_SPIN(cond, bar) do { unsigned _sp = 0; while (cond) { __builtin_amdgcn_s_sleep(1); \
    if ((++_sp & 255u) == 0u) { if (xb_ld(&(bar)[XB_TMO])) break; if (_sp > XB_SPIN_CAP) { atomicAdd(&(bar)[XB_TMO], 1u); break; } } } } while (0)
struct XcdBarrier { unsigned* bar; unsigned x; volatile LAS unsigned* st; };
__device__ __forceinline__ XcdBarrier xcd_barrier_post(unsigned* bar, volatile LAS unsigned* st) {
    XcdBarrier b; b.bar = bar; b.x = xb_xcc_id(); b.st = st;
    if (threadIdx.x == 0) (void)xb_add(&bar[XB_XCNT(b.x)], 1u);
    return b;
}
__device__ __forceinline__ void xcd_barrier_complete(unsigned* bar, unsigned x, unsigned& nloc, unsigned& nx) {
    const unsigned G = gridDim.x * gridDim.y * gridDim.z;
    unsigned sum, cnt, mine, sp = 0u;
    for (;;) {
        sum = 0u; cnt = 0u; mine = 0u;
#pragma unroll
        for (unsigned j = 0; j < 16; ++j) { const unsigned c = xb_ld(&bar[XB_XCNT(j)]); sum += c; cnt += (c > 0u) ? 1u : 0u; mine = (j == x) ? c : mine; }
        if (sum == G) break;
        __builtin_amdgcn_s_sleep(1);
        if ((++sp & 255u) == 0u) { if (xb_ld(&bar[XB_TMO])) break; if (sp > XB_SPIN_CAP) { atomicAdd(&bar[XB_TMO], 1u); break; } }
    }
    nloc = mine > 0u ? mine : 1u; nx = cnt > 0u ? cnt : 1u;
}
__device__ __forceinline__ void xcd_barrier(const XcdBarrier& b) {
    asm volatile("s_waitcnt vmcnt(0)" ::: "memory");
    __syncthreads();
    if (threadIdx.x == 0) {
        unsigned* bar = b.bar;
        __builtin_amdgcn_s_waitcnt(0);
        unsigned nloc = b.st[0], nx = b.st[1];
        if (nloc == 0u) { xcd_barrier_complete(bar, b.x, nloc, nx); b.st[0] = nloc; b.st[1] = nx; }
        const unsigned old = xb_add(&bar[XB_XSUB(b.x)], 1u);
        const unsigned gen = old / nloc;
        if (old + 1u == (gen + 1u) * nloc) {
            __builtin_amdgcn_fence(__ATOMIC_RELEASE, "agent");
            asm volatile("s_waitcnt vmcnt(0)" ::: "memory");
            const unsigned og = xb_add(&bar[XB_TOP], 1u);
            const unsigned tg = og / nx;
            if (og + 1u == (tg + 1u) * nx) xb_add(&bar[XB_TOPGEN], 1u);
            else XB_SPIN(xb_ld(&bar[XB_TOPGEN]) == tg, bar);
            __builtin_amdgcn_fence(__ATOMIC_ACQUIRE, "agent");
            xb_add(&bar[XB_XGEN(b.x)], 1u);
            asm volatile("s_waitcnt vmcnt(0)" ::: "memory");
        } else {
            XB_SPIN(xb_ld(&bar[XB_XGEN(b.x)]) == gen, bar);
            __builtin_amdgcn_fence(__ATOMIC_ACQUIRE, "agent");
            asm volatile("s_waitcnt vmcnt(0)" ::: "memory");
        }
    }
    __syncthreads();
}

struct Args { const float* in[15]; float* out; unsigned char* ws; };

__device__ __forceinline__ float wave_sum(float v) {
#pragma unroll
    for (int o = 1; o < 64; o <<= 1) v += __shfl_xor(v, o);
    return v;
}
__device__ __forceinline__ float wave_max(float v) {
#pragma unroll
    for (int o = 1; o < 64; o <<= 1) v = fmaxf(v, __shfl_xor(v, o));
    return v;
}

__device__ __forceinline__ void p0_transpose_item(const float* W, int ldw, int csrc, bf16* WT, int ldt, int kdst, int nrow0, LAS float* scr, int k0, int lane) {
#pragma unroll 8
    for (int i = 0; i < 32; ++i) { const int kk = 2 * i + (lane >> 5); scr[kk * 33 + (lane & 31)] = W[(size_t)(k0 + kk) * ldw + csrc + (lane & 31)]; }
    asm volatile("s_waitcnt lgkmcnt(0)" ::: "memory");
    const int c = lane & 7;
#pragma unroll
    for (int j = 0; j < 4; ++j) { const int n = (lane >> 3) + 8 * j; const LAS float* s = scr + (8 * c) * 33 + n;
        v4u o; o.x = cvtpk(s[0 * 33], s[1 * 33]); o.y = cvtpk(s[2 * 33], s[3 * 33]); o.z = cvtpk(s[4 * 33], s[5 * 33]); o.w = cvtpk(s[6 * 33], s[7 * 33]);
        *(GAS v4u*)(WT + (size_t)(nrow0 + n) * ldt + kdst + k0 + 8 * c) = o; }
    asm volatile("s_waitcnt lgkmcnt(0)" ::: "memory");
}

namespace att {
typedef LAS const unsigned char* ldsc;
__device__ __forceinline__ int crow(int r, int hi) { return (r & 3) + 8 * (r >> 2) + 4 * hi; }
#define MFMA32(a, b, c) __builtin_amdgcn_mfma_f32_32x32x16_bf16(a, b, c, 0, 0, 0)
__device__ __forceinline__ s16x4 vtr(ldsc p) { return __builtin_bit_cast(s16x4, __builtin_amdgcn_ds_read_tr16_b64_v4i16((LAS v4i16_t*)p)); }

__device__ __forceinline__ void qkt(f32x16& p0, f32x16& p1, ldsc Kslot, const bf16x8* qr, const f32x16& c0, const f32x16& c1, int r32, int hi) {
    ldsc kb = Kslot + hi * 1024 + r32 * 16;
#pragma unroll
    for (int d0 = 0; d0 < 4; ++d0) {
        const bf16x8 b0 = *(LAS const bf16x8*)(kb + d0 * 2048);
        const bf16x8 b1 = *(LAS const bf16x8*)(kb + d0 * 2048 + 512);
        if (d0 == 0) { p0 = MFMA32(b0, qr[0], c0); p1 = MFMA32(b1, qr[0], c1); }
        else { p0 = MFMA32(b0, qr[d0], p0); p1 = MFMA32(b1, qr[d0], p1); } }
}
__device__ __forceinline__ float rowmax(const f32x16& p0, const f32x16& p1) {
    float a = fmaxf(p0[0], p1[0]);
#pragma unroll
    for (int r = 1; r < 16; ++r) a = fmaxf(a, fmaxf(p0[r], p1[r]));
    auto rr = __builtin_amdgcn_permlane32_swap(__float_as_uint(a), __float_as_uint(a), false, false);
    return fmaxf(__uint_as_float(rr[0]), __uint_as_float(rr[1]));
}
__device__ __forceinline__ float halfsum(float a) {
    auto rr = __builtin_amdgcn_permlane32_swap(__float_as_uint(a), __float_as_uint(a), false, false);
    return __uint_as_float(rr[0]) + __uint_as_float(rr[1]);
}
__device__ __forceinline__ void softmax_pv(f32x16& p0, f32x16& p1, f32x16 (&o)[2], float& m_run, float& l_run, LAS float* wsf, ldsc Vslot, int lane, int r32, int hi) {
    const float rm = rowmax(p0, p1);
    const float mn = fmaxf(m_run, rm); const float alpha = fexp2(m_run - mn); m_run = mn;
    float s = 0.f;
#pragma unroll
    for (int r = 0; r < 16; ++r) { p0[r] = fexp2(p0[r] - mn); p1[r] = fexp2(p1[r] - mn); s += p0[r] + p1[r]; }
    l_run = l_run * alpha + s;
    if (hi == 0) wsf[r32] = alpha;
#pragma unroll
    for (int g = 0; g < 4; ++g) { const f32x4 a4 = *(LAS const f32x4*)(wsf + 8 * g + 4 * hi);
#pragma unroll
        for (int j = 0; j < 4; ++j) { o[0][4 * g + j] *= a4[j]; o[1][4 * g + j] *= a4[j]; } }
    bf16x8 pa[4];
    { v4u w;
      w.x = cvtpk(p0[0], p0[1]); w.y = cvtpk(p0[2], p0[3]); w.z = cvtpk(p0[4], p0[5]); w.w = cvtpk(p0[6], p0[7]); pa[0] = __builtin_bit_cast(bf16x8, w);
      w.x = cvtpk(p0[8], p0[9]); w.y = cvtpk(p0[10], p0[11]); w.z = cvtpk(p0[12], p0[13]); w.w = cvtpk(p0[14], p0[15]); pa[1] = __builtin_bit_cast(bf16x8, w);
      w.x = cvtpk(p1[0], p1[1]); w.y = cvtpk(p1[2], p1[3]); w.z = cvtpk(p1[4], p1[5]); w.w = cvtpk(p1[6], p1[7]); pa[2] = __builtin_bit_cast(bf16x8, w);
      w.x = cvtpk(p1[8], p1[9]); w.y = cvtpk(p1[10], p1[11]); w.z = cvtpk(p1[12], p1[13]); w.w = cvtpk(p1[14], p1[15]); pa[3] = __builtin_bit_cast(bf16x8, w); }
    ldsc vp = Vslot + ((lane >> 4) & 1) * 32 + (lane & 3) * 8 + (4 * hi + ((lane & 15) >> 2)) * 64;
#pragma unroll
    for (int d0 = 0; d0 < 2; ++d0)
#pragma unroll
        for (int ks = 0; ks < 4; ++ks) { const s16x4 lo = vtr(vp + d0 * 4096 + ks * 1024), hh = vtr(vp + d0 * 4096 + ks * 1024 + 512);
            const bf16x8 vb = (bf16x8){lo[0], lo[1], lo[2], lo[3], hh[0], hh[1], hh[2], hh[3]};
            o[d0] = MFMA32(pa[ks], vb, o[d0]); }
}
__device__ __forceinline__ v4u mul8(v4u a, v4u z) {
    v4u r; r.x = cvtpk(bflo(a.x) * bflo(z.x), bfhi(a.x) * bfhi(z.x)); r.y = cvtpk(bflo(a.y) * bflo(z.y), bfhi(a.y) * bfhi(z.y));
    r.z = cvtpk(bflo(a.z) * bflo(z.z), bfhi(a.z) * bfhi(z.z)); r.w = cvtpk(bflo(a.w) * bflo(z.w), bfhi(a.w) * bfhi(z.w)); return r;
}

struct Ctx {
    LAS unsigned char* lds;
    const bf16 *QA, *KA, *VA, *QB, *KB, *VB, *SZA, *SZB; bf16* G;
    const float *Fp, *Fs, *rel; const float *cak, *cav, *cbk, *cbv;
    const unsigned* knorm;
};

template <int KIND>
__device__ __forceinline__ void prompt_unit(const Ctx& X, int b, int h, int qb) {
    const int tid = fresh_tid(), lane = tid & 63, r32 = lane & 31, hi = lane >> 5; const int wid = __builtin_amdgcn_readfirstlane(tid >> 6);
    LAS unsigned char* lds = X.lds;
    const bf16* Q = KIND ? X.QA : X.QB; const bf16* Kt = KIND ? X.KA : X.KB; const bf16* Vt = KIND ? X.VA : X.VB; const bf16* SZ = KIND ? X.SZA : X.SZB;
    const size_t rowbase = (size_t)b * SEQ; const int q0 = qb * 256;
    const bf16* Qw = Q + (rowbase + q0 + wid * 32) * 512 + h * 64;
    const bf16* Kh = Kt + rowbase * 512 + h * 64; const bf16* Vh = Vt + rowbase * 512 + h * 64;
    LAS float* wsf = (LAS float*)(lds + WSF_OFF) + wid * 64;
    LAS float* tb = (LAS float*)(lds + TB_OFF);
    LAS float* qmx = (LAS float*)(lds + QMX_OFF);
    bf16x8 qr[4];
#pragma unroll
    for (int d0 = 0; d0 < 4; ++d0) qr[d0] = *(const bf16x8*)(Qw + (size_t)r32 * 512 + d0 * 16 + hi * 8);
    int j_lo, j_hi = 4 * qb + 3; float Fq0 = 0.f;
    const float* Fbh = X.Fp + (size_t)(b * 8 + h) * SEQ;
    if (KIND == 0) {
        float ss = 0.f;
#pragma unroll
        for (int d0 = 0; d0 < 4; ++d0)
#pragma unroll
            for (int e = 0; e < 8; ++e) { const float v = __uint_as_float(((unsigned)(unsigned short)qr[d0][e]) << 16); ss += v * v; }
        ss = halfsum(ss); ss = wave_max(ss);
        if (lane == 0) qmx[wid] = ss;
        __syncthreads();
        float qm = 0.f;
#pragma unroll
        for (int w = 0; w < 8; ++w) qm = fmaxf(qm, qmx[w]);
        const float kn = __uint_as_float(__hip_atomic_load(X.knorm + ((b * 8 + h) * 2), RLX_AGENT)) + __uint_as_float(__hip_atomic_load(X.knorm + ((b * 8 + h) * 2) + 1, RLX_AGENT));
        const float thr = 2.0f * sqrtf(qm * kn) * 1.02f + 40.0f;
        Fq0 = Fbh[q0];
        int cnt = 0, base = 4 * qb - 1;
        for (;;) {
            const int jb = base - lane; bool ok = false;
            if (jb >= 0) ok = (Fq0 - Fbh[64 * jb + 63]) * L2E >= -thr;
            const unsigned long long mk = __ballot(ok);
            const int c = (mk == ~0ull) ? 64 : __builtin_ctzll(~mk);
            cnt += c; if (c < 64) break; base -= 64; if (base < 0) break;
        }
        j_lo = 4 * qb - cnt; if (j_lo < 0) j_lo = 0;
    } else {
        j_lo = 4 * qb - 8; if (j_lo < 0) j_lo = 0;
        if (tid < NREL) tb[tid] = X.rel[h * NREL + tid] * L2E;
        __syncthreads();
    }
    const bf16* ksrc = Kh + (size_t)lane * 512 + wid * 8;
    const bf16* vsrc = Vh + (size_t)(16 * (wid & 3) + (lane >> 2)) * 512 + (wid >> 2) * 32 + (lane & 3) * 8;
#define DMA_TILE(j, s) do { \
        __builtin_amdgcn_global_load_lds((const unsigned*)(ksrc + (size_t)(j) * 64 * 512), (LAS unsigned*)(lds + (s) * 16384 + wid * 1024), 16, 0, 0); \
        __builtin_amdgcn_global_load_lds((const unsigned*)(vsrc + (size_t)(j) * 64 * 512), (LAS unsigned*)(lds + (s) * 16384 + 8192 + wid * 1024), 16, 0, 0); \
        if (KIND == 0 && wid == 0) __builtin_amdgcn_global_load_lds((const unsigned*)(Fbh + 64 * (j) + lane), (LAS unsigned*)(lds + 32768 + (s) * 256), 4, 0, 0); } while (0)
    float m_run = -1e30f, l_run = 0.f; f32x16 o[2]; o[0] = f32x16{}; o[1] = f32x16{};
    const int tpos0 = q0 + wid * 32;
    const int cw = 4 * qb + (wid >> 1);
    DMA_TILE(j_lo, 0);
    for (int j = j_lo; j <= j_hi; ++j) {
        const int s = (j - j_lo) & 1;
        asm volatile("s_waitcnt vmcnt(0)" ::: "memory");
        __syncthreads();
        if (j < j_hi) DMA_TILE(j + 1, s ^ 1);
        bool active;
        if (KIND == 0) active = (64 * j <= tpos0 + 31);
        else active = (j <= cw) && (j >= cw - 8);
        if (active) {
            f32x16 c0, c1, p0, p1;
            if (KIND == 0) {
                LAS const float* fb = (LAS const float*)(lds + 32768 + s * 256);
#pragma unroll
                for (int g = 0; g < 4; ++g) { const f32x4 f0 = *(LAS const f32x4*)(fb + 8 * g + 4 * hi), f1 = *(LAS const f32x4*)(fb + 32 + 8 * g + 4 * hi);
#pragma unroll
                    for (int e = 0; e < 4; ++e) { c0[4 * g + e] = (Fq0 - f0[e]) * L2E; c1[4 * g + e] = (Fq0 - f1[e]) * L2E; } }
            } else { c0 = f32x16{}; c1 = f32x16{}; }
            qkt(p0, p1, (ldsc)(lds + s * 16384), qr, c0, c1, r32, hi);
            if (KIND == 0) {
                if (64 * j + 63 > tpos0) {
                    const int tq = tpos0 + r32, kb0 = 64 * j + 4 * hi;
#pragma unroll
                    for (int r = 0; r < 16; ++r) { const int kv = kb0 + (r & 3) + 8 * (r >> 2); if (kv > tq) p0[r] = -1e30f; if (kv + 32 > tq) p1[r] = -1e30f; }
                }
            } else {
                const int dist0 = 64 * (cw - j) + 32 * (wid & 1) + r32 - 4 * hi + 63;
#pragma unroll
                for (int r = 0; r < 16; ++r) { const int i0 = dist0 - ((r & 3) + 8 * (r >> 2));
                    const int a0 = min(max(i0, 0), NREL - 1), a1 = min(max(i0 - 32, 0), NREL - 1);
                    p0[r] += tb[a0]; p1[r] += tb[a1]; }
            }
            softmax_pv(p0, p1, o, m_run, l_run, wsf, (ldsc)(lds + s * 16384 + 8192), lane, r32, hi);
        }
    }
#undef DMA_TILE
    const float lt = halfsum(l_run);
    if (hi == 0) wsf[32 + r32] = lt;
    float rli[16];
#pragma unroll
    for (int g = 0; g < 4; ++g) { const f32x4 a4 = *(LAS const f32x4*)(wsf + 32 + 8 * g + 4 * hi);
#pragma unroll
        for (int e = 0; e < 4; ++e) rli[4 * g + e] = __builtin_amdgcn_rcpf(a4[e]); }
    LAS bf16* stg = (LAS bf16*)(lds + 36864 + wid * 4096);
#pragma unroll
    for (int r = 0; r < 16; ++r) { const int orow = crow(r, hi);
#pragma unroll
        for (int d0 = 0; d0 < 2; ++d0) stg[orow * 64 + d0 * 32 + r32] = (bf16)(cvtpk(o[d0][r] * rli[r], 0.f) & 0xffffu); }
    const size_t grow0 = rowbase + q0 + wid * 32;
#pragma unroll
    for (int i = 0; i < 4; ++i) { const int row = i * 8 + (lane >> 3), ch = lane & 7;
        const v4u v = *(LAS const v4u*)(stg + row * 64 + ch * 8);
        const v4u z = *(const v4u*)(SZ + (grow0 + row) * 512 + h * 64 + ch * 8);
        *(v4u*)(X.G + (grow0 + row) * 1024 + (KIND ? 0 : 512) + h * 64 + ch * 8) = mul8(v, z); }
    __syncthreads();
}

template <int KIND>
__device__ __forceinline__ void sample_unit(const Ctx& X, int bs, int h) {
    const int tid = fresh_tid(), lane = tid & 63, r32 = lane & 31, hi = lane >> 5; const int wid = __builtin_amdgcn_readfirstlane(tid >> 6);
    LAS unsigned char* lds = X.lds;
    const int ncache = KIND ? AKEEP : PAST, nct = ncache / 64, ntile = nct + 1;
    const float* Kc = (KIND ? X.cak : X.cbk) + ((size_t)bs * ncache * 8 + h) * 64;
    const float* Vc = (KIND ? X.cav : X.cbv) + ((size_t)bs * ncache * 8 + h) * 64;
    const bf16* Q = KIND ? X.QA : X.QB; const bf16* Kn = KIND ? X.KA : X.KB; const bf16* Vn = KIND ? X.VA : X.VB; const bf16* SZ = KIND ? X.SZA : X.SZB;
    const size_t nrow0 = (size_t)MP + 16 * bs;
    LAS float* wsf = (LAS float*)(lds + WSF_OFF) + wid * 64;
    LAS float* tb = (LAS float*)(lds + TB_OFF);
    if (KIND == 1) { if (tid < NREL) tb[tid] = X.rel[h * NREL + tid] * L2E; }
    __syncthreads();
    bf16x8 qr[4];
#pragma unroll
    for (int d0 = 0; d0 < 4; ++d0) qr[d0] = *(const bf16x8*)(Q + (nrow0 + (r32 & 15)) * 512 + h * 64 + d0 * 16 + hi * 8);
    const float* Fsr = X.Fs + (size_t)(bs * 8 + h) * FS_PITCH;
    const float Fref = (KIND == 0) ? Fsr[PAST - 1] : 0.f;
    LAS unsigned char* kslot = lds + wid * 16384; LAS unsigned char* vslot = kslot + 8192;
    float m_run = -1e30f, l_run = 0.f; f32x16 o[2]; o[0] = f32x16{}; o[1] = f32x16{};
    const int tq = r32 & 15;
    for (int t = wid; t < ntile; t += 8) {
        if (t < nct) {
            const float* kr = Kc + (size_t)(t * 64 + lane) * 512; const float* vr = Vc + (size_t)(t * 64 + lane) * 512;
#pragma unroll
            for (int c = 0; c < 8; ++c) { const f32x4 a = *(const f32x4*)(kr + 8 * c), bq = *(const f32x4*)(kr + 8 * c + 4);
                v4u w; w.x = cvtpk(a[0], a[1]); w.y = cvtpk(a[2], a[3]); w.z = cvtpk(bq[0], bq[1]); w.w = cvtpk(bq[2], bq[3]);
                *(LAS v4u*)(kslot + c * 1024 + lane * 16) = w; }
#pragma unroll
            for (int c = 0; c < 8; ++c) { const f32x4 a = *(const f32x4*)(vr + 8 * c), bq = *(const f32x4*)(vr + 8 * c + 4);
                v4u w; w.x = cvtpk(a[0], a[1]); w.y = cvtpk(a[2], a[3]); w.z = cvtpk(bq[0], bq[1]); w.w = cvtpk(bq[2], bq[3]);
                *(LAS v4u*)(vslot + (c >> 2) * 4096 + lane * 64 + (c & 3) * 16) = w; }
        } else {
#pragma unroll
            for (int c = 0; c < 8; ++c) { v4u wk = (v4u){0u, 0u, 0u, 0u}, wv = wk;
                if (lane < 16) { wk = *(const v4u*)(Kn + (nrow0 + lane) * 512 + h * 64 + c * 8); wv = *(const v4u*)(Vn + (nrow0 + lane) * 512 + h * 64 + c * 8); }
                *(LAS v4u*)(kslot + c * 1024 + lane * 16) = wk;
                *(LAS v4u*)(vslot + (c >> 2) * 4096 + lane * 64 + (c & 3) * 16) = wv; }
        }
        f32x16 c0, c1, p0, p1;
        if (KIND == 0) {
            const float* fb = Fsr + t * 64;
#pragma unroll
            for (int g = 0; g < 4; ++g) { const f32x4 f0 = *(const f32x4*)(fb + 8 * g + 4 * hi), f1 = *(const f32x4*)(fb + 32 + 8 * g + 4 * hi);
#pragma unroll
                for (int e = 0; e < 4; ++e) { c0[4 * g + e] = (Fref - f0[e]) * L2E; c1[4 * g + e] = (Fref - f1[e]) * L2E; } }
        } else { c0 = f32x16{}; c1 = f32x16{}; }
        qkt(p0, p1, (ldsc)kslot, qr, c0, c1, r32, hi);
        if (KIND == 1) {
            const int dist0 = ncache + tq - (64 * t + 4 * hi) + 63;
#pragma unroll
            for (int r = 0; r < 16; ++r) { const int i0 = dist0 - ((r & 3) + 8 * (r >> 2));
                const int a0 = min(max(i0, 0), NREL - 1), a1 = min(max(i0 - 32, 0), NREL - 1);
                p0[r] += tb[a0]; p1[r] += tb[a1]; }
        }
        if (t == nct) {
#pragma unroll
            for (int r = 0; r < 16; ++r) { const int kv = 4 * hi + (r & 3) + 8 * (r >> 2);
                const bool ok = (kv < 16) && (KIND == 1 || kv <= tq);
                if (!ok) p0[r] = -1e30f; p1[r] = -1e30f; }
        }
        softmax_pv(p0, p1, o, m_run, l_run, wsf, (ldsc)vslot, lane, r32, hi);
    }
    const float lt = halfsum(l_run);
    __syncthreads();
    LAS float* OP = (LAS float*)lds;
    LAS float* ML = (LAS float*)(lds + 32768);
    if (lane < 16) { ML[(wid * 16 + lane) * 2] = m_run; ML[(wid * 16 + lane) * 2 + 1] = lt; }
#pragma unroll
    for (int r = 0; r < 8; ++r) { const int q = crow(r, hi);
#pragma unroll
        for (int d0 = 0; d0 < 2; ++d0) OP[(wid * 16 + q) * 64 + d0 * 32 + r32] = o[d0][r]; }
    __syncthreads();
    { const int q = tid >> 5, d = (tid & 31) * 2;
      float M = -1e30f;
#pragma unroll
      for (int w = 0; w < 8; ++w) M = fmaxf(M, ML[(w * 16 + q) * 2]);
      float L = 0.f, a0 = 0.f, a1 = 0.f;
#pragma unroll
      for (int w = 0; w < 8; ++w) { const float f = fexp2(ML[(w * 16 + q) * 2] - M); L += ML[(w * 16 + q) * 2 + 1] * f;
          const f32x2 ov = *(LAS const f32x2*)(OP + (w * 16 + q) * 64 + d); a0 += ov[0] * f; a1 += ov[1] * f; }
      const float rl = 1.0f / L;
      const unsigned z = *(const unsigned*)(SZ + (nrow0 + q) * 512 + h * 64 + d);
      *(unsigned*)(X.G + (nrow0 + q) * 1024 + (KIND ? 0 : 512) + h * 64 + d) = cvtpk(a0 * rl * bflo(z), a1 * rl * bfhi(z)); }
    __syncthreads();
}
}

__global__ void __launch_bounds__(512, 2) fwd_kernel(Args args) {
    extern __shared__ __attribute__((aligned(16))) unsigned char lds_raw[];
    LAS unsigned char* lds = (LAS unsigned char*)lds_raw;
    const int G = gridDim.x; const int bx = blockIdx.x; const int vcu = (G % 8 == 0) ? (bx % 8) * (G / 8) + bx / 8 : bx;
    unsigned char* ws = args.ws; float* out = args.out;
    gu32* ctl = (gu32*)(ws + WS_CTL);
    const float* x_p = args.in[0]; const float* x_s = args.in[1];
    const float *cak = args.in[2], *cav = args.in[3], *cbk = args.in[4], *cbv = args.in[5], *cbl = args.in[6];
    const float *g_pre = args.in[7], *w_in = args.in[8], *b_f = args.in[9], *rel = args.in[10], *w_bra = args.in[11], *w_brb = args.in[12], *w_out = args.in[13], *g_post = args.in[14];
    float* Fp = (float*)(ws + WS_FP); float* LFp = (float*)(ws + WS_LFP); float* Fs = (float*)(ws + WS_FS); float* LFn = (float*)(ws + WS_LFN);
    bf16* WIN = (bf16*)(ws + WS_WIN); bf16* WBR = (bf16*)(ws + WS_WBR); bf16* WOUT = (bf16*)(ws + WS_WOUT);
    bf16* XN = (bf16*)(ws + WS_XN);
    bf16 *QA = (bf16*)(ws + WS_QA), *KA = (bf16*)(ws + WS_KA), *VA = (bf16*)(ws + WS_VA), *QB = (bf16*)(ws + WS_QB), *KB = (bf16*)(ws + WS_KB), *VB = (bf16*)(ws + WS_VB);
    bf16 *SZA = (bf16*)(ws + WS_SZA), *SZB = (bf16*)(ws + WS_SZB), *SMA = (bf16*)(ws + WS_SMA), *SMB = (bf16*)(ws + WS_SMB);
    bf16* MG = (bf16*)(ws + WS_MG); float* OUTF = (float*)(ws + WS_OUTF);

    for (int u = threadIdx.x; u < (LDS_BYTES - LDSCTL_OFF) / 4; u += 512) ((LAS unsigned*)(lds + LDSCTL_OFF))[u] = 0u;
    __syncthreads();
    volatile LAS unsigned* MISC = (volatile LAS unsigned*)(lds + MISC_OFF);
    XcdBarrier bar = xcd_barrier_post((unsigned*)(ctl + CW_BAR), MISC + 8);
    const int NGW = G * 8;

    {
        const int tid = fresh_tid(), lane = tid & 63; const int wave = __builtin_amdgcn_readfirstlane(tid >> 6); const int gw = vcu * 8 + wave;
        LAS float* wfT = (LAS float*)(lds + 73728);
        for (int k = tid; k < DM; k += 512) { const f32x4 a = *(const f32x4*)(w_in + (size_t)k * NIN + 4096), b = *(const f32x4*)(w_in + (size_t)k * NIN + 4100);
            wfT[0 * DM + k] = a[0]; wfT[1 * DM + k] = a[1]; wfT[2 * DM + k] = a[2]; wfT[3 * DM + k] = a[3];
            wfT[4 * DM + k] = b[0]; wfT[5 * DM + k] = b[1]; wfT[6 * DM + k] = b[2]; wfT[7 * DM + k] = b[3]; }
        __syncthreads();
        LAS float* scr = (LAS float*)(lds + wave * 8704);
        constexpr int I_IN = 16 * 192, I_BR = 8 * 32, I_OUT = 16 * 32, NITEMS = I_IN + 2 * I_BR + I_OUT;
        for (int it = gw; it < NITEMS; it += NGW) {
            int r = it;
            if (r < I_IN) { const int kb = r / 192, nb = r % 192, n0 = 32 * nb; p0_transpose_item(w_in, NIN, n0 + (n0 >= 4096 ? 8 : 0), WIN, DM, 0, n0, scr, 64 * kb, lane); continue; } r -= I_IN;
            if (r < I_BR) { const int kb = r / 32, nb = r % 32; p0_transpose_item(w_bra, DM, 32 * nb, WBR, DM, 0, 32 * nb, scr, 64 * kb, lane); continue; } r -= I_BR;
            if (r < I_BR) { const int kb = r / 32, nb = r % 32; p0_transpose_item(w_brb, DM, 32 * nb, WBR, DM, 512, 32 * nb, scr, 64 * kb, lane); continue; } r -= I_BR;
            { const int kb = r / 32, nb = r % 32; p0_transpose_item(w_out, DM, 32 * nb, WOUT, DM, 0, 32 * nb, scr, 64 * kb, lane); }
        }
        f32x4 gv[4];
#pragma unroll
        for (int j = 0; j < 4; ++j) gv[j] = *((const f32x4*)g_pre + lane + 64 * j);
        for (int m = gw; m < MTOT; m += NGW) {
            GAS unsigned long long* o8 = (GAS unsigned long long*)(XN + (size_t)m * DM) + lane;
            if (m >= MP + MS) {
#pragma unroll
                for (int j = 0; j < 4; ++j) o8[64 * j] = 0ull;
                continue; }
            const float* xrow = (m < MP) ? x_p + (size_t)m * DM : x_s + (size_t)(m - MP) * DM;
            f32x4 v[4]; float ss = 0.f;
#pragma unroll
            for (int j = 0; j < 4; ++j) { v[j] = *((const f32x4*)xrow + lane + 64 * j); ss += (v[j][0] * v[j][0] + v[j][1] * v[j][1]) + (v[j][2] * v[j][2] + v[j][3] * v[j][3]); }
            float dt[8];
#pragma unroll
            for (int hh = 0; hh < 8; ++hh) dt[hh] = 0.f;
#pragma unroll
            for (int j = 0; j < 4; ++j) { v[j] = v[j] * gv[j];
#pragma unroll
                for (int hh = 0; hh < 8; ++hh) { const f32x4 w = *(LAS const f32x4*)(wfT + hh * DM + 256 * j + 4 * lane);
                    dt[hh] += (v[j][0] * w[0] + v[j][1] * w[1]) + (v[j][2] * w[2] + v[j][3] * w[3]); } }
            ss = wave_sum(ss);
            const float rs = 1.0f / sqrtf(ss * (1.0f / DM) + EPS);
            {
                const bool u5 = (lane & 32) != 0, u4 = (lane & 16) != 0, u3 = (lane & 8) != 0;
#pragma unroll
                for (int i = 0; i < 4; ++i) { const float snd = u5 ? dt[i] : dt[i + 4], kp = u5 ? dt[i + 4] : dt[i]; dt[i] = kp + __shfl_xor(snd, 32); }
#pragma unroll
                for (int i = 0; i < 2; ++i) { const float snd = u4 ? dt[i] : dt[i + 2], kp = u4 ? dt[i + 2] : dt[i]; dt[i] = kp + __shfl_xor(snd, 16); }
                { const float snd = u3 ? dt[0] : dt[1], kp = u3 ? dt[1] : dt[0]; dt[0] = kp + __shfl_xor(snd, 8); }
                dt[0] += __shfl_xor(dt[0], 1); dt[0] += __shfl_xor(dt[0], 2); dt[0] += __shfl_xor(dt[0], 4);
            }
            if ((lane & 7) == 0) {
                const int hh = lane >> 3;
                const float val = dt[0] * rs + b_f[hh];
                const float lf = (val >= 0.f) ? -log1pf(expf(-val)) : (val - log1pf(expf(val)));
                if (m < MP) { out[O_BLP + (size_t)m * 8 + hh] = lf; LFp[(size_t)((m >> 14) * 8 + hh) * SEQ + (m & (SEQ - 1))] = lf; }
                else { const int ms = m - MP; out[O_BLS + (size_t)ms * 8 + hh] = lf; LFn[((ms >> 4) * 8 + hh) * 16 + (ms & 15)] = lf; }
            }
#pragma unroll
            for (int j = 0; j < 4; ++j) o8[64 * j] = (unsigned long long)cvtpk(v[j][0] * rs, v[j][1] * rs) | ((unsigned long long)cvtpk(v[j][2] * rs, v[j][3] * rs) << 32);
        }
        { const int gt = vcu * 512 + tid, NT = G * 512; constexpr int PER = 496 * 128;
          for (int i = gt; i < 2 * 8 * PER; i += NT) { const int ten = i / (8 * PER), r = i - ten * 8 * PER, bb = r / PER, off = r - bb * PER;
              const f32x4* src = (const f32x4*)(ten ? cav : cak) + (size_t)bb * 65536 + 2048 + off;
              f32x4* dst = (f32x4*)(out + (ten ? O_AVS : O_AKS)) + (size_t)bb * 65536 + off; *dst = *src; } }
    }
    xcd_barrier(bar);

    if (vcu < 80 && __builtin_amdgcn_readfirstlane(fresh_tid() >> 6) == 0) {
        const int lane = fresh_tid() & 63;
        if (vcu < 16) {
            const float* in = LFp + (size_t)vcu * SEQ + 256 * lane; float* o = Fp + (size_t)vcu * SEQ + 256 * lane;
            float tot = 0.f;
            for (int i = 0; i < 64; ++i) { const f32x4 a = *((const f32x4*)in + i); tot += (a[0] + a[1]) + (a[2] + a[3]); }
            float inc = tot;
#pragma unroll
            for (int ofs = 1; ofs < 64; ofs <<= 1) { const float t = __shfl_up(inc, ofs); if (lane >= ofs) inc += t; }
            float run = inc - tot;
            for (int i = 0; i < 64; ++i) { f32x4 a = *((const f32x4*)in + i); a[0] += run; a[1] += a[0]; a[2] += a[1]; a[3] += a[2]; run = a[3]; *((f32x4*)o + i) = a; }
        } else {
            const int sidx = vcu - 16, bs = sidx >> 3, hh = sidx & 7;
            const float* in = cbl + ((size_t)bs * PAST + 64 * lane) * 8 + hh; float* o = Fs + (size_t)sidx * FS_PITCH + 64 * lane;
            float tot = 0.f;
            for (int i = 0; i < 64; ++i) tot += in[i * 8];
            float inc = tot;
#pragma unroll
            for (int ofs = 1; ofs < 64; ofs <<= 1) { const float t = __shfl_up(inc, ofs); if (lane >= ofs) inc += t; }
            float run = inc - tot;
            for (int i = 0; i < 64; ++i) { run += in[i * 8]; o[i] = run; }
            const float last = __shfl(run, 63);
            if (lane == 0) { float r2 = last; float* on = Fs + (size_t)sidx * FS_PITCH + PAST;
                for (int i = 0; i < 16; ++i) { r2 += LFn[sidx * 16 + i]; on[i] = r2; }
                for (int i = 16; i < 64; ++i) on[i] = r2; }
        }
    }
    {
        pg8::Gemm g{XN, WIN, DM, DM / 64}; pg8::StaticOrder S; S.init(MTOT, NG, G, bx, 1);
        pg8::EpiInProj E{QA, KA, VA, SZA, QB, KB, VB, SZB, SMA, SMB, out, (unsigned*)(ctl + CW_KNORM)};
        pg8::gemm_phase<pg8::EpiInProj, pg8::StaticOrder>(lds, g, S, E);
    }
    xcd_barrier(bar);

    {
        att::Ctx X; X.lds = lds; X.QA = QA; X.KA = KA; X.VA = VA; X.QB = QB; X.KB = KB; X.VB = VB; X.SZA = SZA; X.SZB = SZB; X.G = XN;
        X.Fp = Fp; X.Fs = Fs; X.rel = rel; X.cak = cak; X.cav = cav; X.cbk = cbk; X.cbv = cbv; X.knorm = (const unsigned*)(ctl + CW_KNORM);
        constexpr int NU = 64 + 1024 + 1024 + 64;
        for (int u = vcu; u < NU; u += G) {
            if (u < 64) att::sample_unit<0>(X, u >> 3, u & 7);
            else if (u < 64 + 2048) { const int kind = (u - 64) >> 10, idx = (u - 64) & 1023;
                const int hh = ((idx & 7) + (idx >> 8)) & 7, bb = (idx >> 3) & 1, qb = 63 - (idx >> 4);
                if (kind == 0) att::prompt_unit<0>(X, bb, hh, qb); else att::prompt_unit<1>(X, bb, hh, qb); }
            else { const int i2 = u - 64 - 2048; att::sample_unit<1>(X, i2 >> 3, i2 & 7); }
        }
    }
    xcd_barrier(bar);

    {
        pg8::Gemm g{XN, WBR, DM, 8}; pg8::StaticOrder S; S.init(MTOT, DM, G, bx, 2);
        pg8::EpiMerge E{SMA, SMB, MG};
        pg8::gemm_phase<pg8::EpiMerge, pg8::StaticOrder>(lds, g, S, E);
    }
    xcd_barrier(bar);
    {
        pg8::Gemm g{MG, WOUT, DM, DM / 64}; pg8::StaticOrder S; S.init(MTOT, DM, G, bx, 1);
        pg8::EpiF32 E{OUTF, DM};
        pg8::gemm_phase<pg8::EpiF32, pg8::StaticOrder>(lds, g, S, E);
    }
    xcd_barrier(bar);
    {
        const int tid = fresh_tid(), lane = tid & 63; const int wave = __builtin_amdgcn_readfirstlane(tid >> 6); const int gw = vcu * 8 + wave;
        f32x4 gv[4];
#pragma unroll
        for (int j = 0; j < 4; ++j) gv[j] = *((const f32x4*)g_post + lane + 64 * j);
        for (int m = gw; m < MP + MS; m += NGW) {
            const float* xrow = (m < MP) ? x_p + (size_t)m * DM : x_s + (size_t)(m - MP) * DM;
            float* yrow = (m < MP) ? out + O_YP + (size_t)m * DM : out + O_YS + (size_t)(m - MP) * DM;
            const float* orow = OUTF + (size_t)m * DM;
            f32x4 v[4], xv[4]; float ss = 0.f;
#pragma unroll
            for (int j = 0; j < 4; ++j) { v[j] = *((const f32x4*)orow + lane + 64 * j); xv[j] = *((const f32x4*)xrow + lane + 64 * j);
                ss += (v[j][0] * v[j][0] + v[j][1] * v[j][1]) + (v[j][2] * v[j][2] + v[j][3] * v[j][3]); }
            ss = wave_sum(ss);
            const float rs = 1.0f / sqrtf(ss * (1.0f / DM) + EPS);
#pragma unroll
            for (int j = 0; j < 4; ++j) *((f32x4*)yrow + lane + 64 * j) = xv[j] + v[j] * rs * gv[j];
        }
    }
}

extern "C" void kernel_launch(void* const* d_in, const int* in_sizes, int n_in, void* d_out, int out_size, void* d_ws, size_t ws_size, hipStream_t stream) {
    static int grid = 0;
    if (grid == 0) {
        if (n_in != 15 || in_sizes[0] != MP * DM || (size_t)out_size != O_END || ws_size < WS_END) {
            fprintf(stderr, "kernel_launch: unexpected shapes: n_in %d in0 %d out %d ws %zu (need %zu)\n", n_in, n_in > 0 ? in_sizes[0] : -1, out_size, ws_size, (size_t)WS_END); grid = -1; return; }
        int dev = 0, cus = 0, per_cu = 0;
        if (hipGetDevice(&dev) != hipSuccess || hipDeviceGetAttribute(&cus, hipDeviceAttributeMultiprocessorCount, dev) != hipSuccess) { fprintf(stderr, "kernel_launch: device query failed\n"); grid = -1; return; }
        if (hipFuncSetAttribute((const void*)fwd_kernel, hipFuncAttributeMaxDynamicSharedMemorySize, LDS_BYTES) != hipSuccess) { fprintf(stderr, "kernel_launch: hipFuncSetAttribute failed\n"); grid = -1; return; }
        if (hipOccupancyMaxActiveBlocksPerMultiprocessor(&per_cu, (const void*)fwd_kernel, 512, LDS_BYTES) != hipSuccess || per_cu < 1) {
            fprintf(stderr, "kernel_launch: occupancy query reports %d blocks per CU\n", per_cu); (void)hipGetLastError(); grid = -1; return; }
        grid = cus;
    }
    if (grid < 0) return;
    if (hipMemsetAsync((char*)d_ws + WS_CTL, 0, CTL_ZERO_BYTES, stream) != hipSuccess) { fprintf(stderr, "kernel_launch: memset failed\n"); return; }
    Args a{};
    for (int i = 0; i < 15; ++i) a.in[i] = (const float*)d_in[i];
    a.out = (float*)d_out; a.ws = (unsigned char*)d_ws;
    hipLaunchKernelGGL(fwd_kernel, dim3(grid), dim3(512), LDS_BYTES, stream, a);
    const hipError_t le = hipPeekAtLastError();
    if (le != hipSuccess) fprintf(stderr, "kernel_launch: launch failed: %s\n", hipGetErrorName(le));
}
```

```cpp
#include <hip/hip_runtime.h>
#include <hip/hip_bf16.h>
#include <cstdio>
#include <cstdint>

constexpr int DM = 1024, NB = 2, SEQ = 16384, DECB = 8, DECS = 16, PAST = 4096, AKEEP = 512;
constexpr int NH = 8, HD = 64, WA = 512;
constexpr int NIN = 6152;
constexpr int NG = 6144;
constexpr int MP = NB * SEQ;
constexpr int MS = DECB * DECS;
constexpr int MTOT = MP + 256;
constexpr int NREL = 192;
constexpr float EPS = 1e-6f;
constexpr float L2E = 1.4426950408889634f;
constexpr float C2 = 0.125f * L2E;
constexpr int FS_PITCH = 4160;

constexpr size_t O_YP = 0, O_YS = 33554432, O_AKP = 33685504, O_AVP = 34209792, O_BKP = 34734080, O_BVP = 51511296, O_BLP = 68288512,
                 O_AKS = 68550656, O_AVS = 70647808, O_BKS = 72744960, O_BVS = 72810496, O_BLS = 72876032, O_END = 72877056;

constexpr size_t MiB = 1u << 20;
constexpr size_t WS_CTL = 0, CTL_ZERO_BYTES = 1 * MiB;
constexpr size_t WS_FP = 1 * MiB;
constexpr size_t WS_LFP = 2 * MiB;
constexpr size_t WS_FS = 3 * MiB;
constexpr size_t WS_LFN = 5 * MiB;
constexpr size_t WS_WIN = 6 * MiB;
constexpr size_t WS_WBR = 18 * MiB;
constexpr size_t WS_WOUT = 20 * MiB;
constexpr size_t WS_XN = 24 * MiB;
constexpr size_t ACT_BYTES = (size_t)MTOT * 512 * 2;
constexpr size_t WS_QA = 89 * MiB, WS_KA = 122 * MiB, WS_VA = 155 * MiB, WS_QB = 188 * MiB, WS_KB = 221 * MiB, WS_VB = 254 * MiB;
constexpr size_t WS_MG = 89 * MiB;
constexpr size_t WS_OUTF = 155 * MiB;
constexpr size_t WS_SZA = 287 * MiB, WS_SZB = 320 * MiB;
constexpr size_t WS_SMA = 353 * MiB, WS_SMB = 418 * MiB;
constexpr size_t WS_END = 483 * MiB;
static_assert(ACT_BYTES <= 33 * MiB && WS_XN + 2 * ACT_BYTES <= WS_QA && WS_OUTF + (size_t)MTOT * 1024 * 4 <= WS_SZA && WS_MG + 2 * ACT_BYTES <= WS_OUTF, "ws map");

constexpr int CW_KNORM = 64;
constexpr int CW_QUEUE = 1024;
constexpr int CW_BAR = 4096;

constexpr int RING_BYTES = 131072;
constexpr int LDSCTL_OFF = RING_BYTES, MISC_OFF = LDSCTL_OFF + 320;
constexpr int TB_OFF = LDSCTL_OFF + 1024;
constexpr int WSF_OFF = LDSCTL_OFF + 2048;
constexpr int QMX_OFF = LDSCTL_OFF + 4096;
constexpr int LDS_BYTES = 147456;

#define GAS __attribute__((address_space(1)))
#define LAS __attribute__((address_space(3)))
typedef unsigned short bf16;
typedef unsigned v4u __attribute__((ext_vector_type(4)));
typedef unsigned v2u __attribute__((ext_vector_type(2)));
typedef float f32x4 __attribute__((ext_vector_type(4)));
typedef float f32x2 __attribute__((ext_vector_type(2)));
typedef float f32x16 __attribute__((ext_vector_type(16)));
typedef short bf16x8 __attribute__((ext_vector_type(8)));
typedef short s16x4 __attribute__((ext_vector_type(4)));
typedef short v4i16_t __attribute__((ext_vector_type(4)));
typedef __bf16 bf16x2_t __attribute__((ext_vector_type(2)));
typedef GAS unsigned gu32;
#define RLX_AGENT __ATOMIC_RELAXED, __HIP_MEMORY_SCOPE_AGENT

__device__ __forceinline__ unsigned cvtpk(float lo, float hi) { f32x2 v = {lo, hi}; bf16x2_t b = __builtin_convertvector(v, bf16x2_t); return __builtin_bit_cast(unsigned, b); }
__device__ __forceinline__ int fresh_tid() { int t = threadIdx.x; asm volatile("" : "+v"(t)); return t; }
__device__ __forceinline__ float bflo(unsigned u) { return __uint_as_float(u << 16); }
__device__ __forceinline__ float bfhi(unsigned u) { return __uint_as_float(u & 0xffff0000u); }
__device__ __forceinline__ float fexp2(float x) { return __builtin_amdgcn_exp2f(x); }
__device__ __forceinline__ float sigmoidf_(float v) { return __builtin_amdgcn_rcpf(1.0f + fexp2(-v * L2E)); }

namespace pg8 {
#define PG8_LAS __attribute__((address_space(3)))
typedef unsigned short bf16_t;
typedef unsigned u32x4 __attribute__((ext_vector_type(4)));
constexpr int BM = 256, BK = 64, HALF = 128, HTB = HALF * BK * 2, STAGE_BYTES = 8 * HTB, NXCD = 8, WGM = 8;

__host__ __device__ __forceinline__ int lds_byte(int r, int c) { const int st = (r >> 4) * 2 + (c >> 5), rr = r & 15, cc = c & 31, ob = rr * 64 + cc * 2; return st * 1024 + (ob ^ (((ob >> 9) & 1) << 5)); }
__host__ __device__ __forceinline__ void stage_rc(int b, int& R, int& C) { const int st = b / 1024, sb = b % 1024, swz = sb ^ (((sb >> 9) & 1) << 5); R = (st >> 1) * 16 + swz / 64; C = (st & 1) * 32 + (swz % 64) / 2; }
__host__ __device__ __forceinline__ int perm32(int rho) { const int n = rho >> 4, i = rho & 15; return 8 * (i >> 2) + 4 * n + (i & 3); }

struct Unit { int pm, pn, kh; };
struct Gemm { const bf16_t* A; const bf16_t* Bt; int ldk; int nt; };

struct StaticOrder {
    int nM, nN, nwg, G, c, nkh;
    __device__ void init(int M, int N, int G_, int c_, int nkh_) { nM = M / BM; nN = N / BM; nwg = nM * nN; G = G_; c = c_; nkh = nkh_; }
    __device__ bool next(int i, Unit& u) const {
        const int ti = i / nkh; u.kh = i - ti * nkh;
        const long L = (long)ti * G + c; if (L >= nwg) return false;
        int wgid = (int)L; { const int q = nwg / NXCD, r = nwg % NXCD, xcd = wgid % NXCD, off = wgid / NXCD; wgid = (xcd < r ? xcd * (q + 1) : r * (q + 1) + (xcd - r) * q) + off; }
        const int nig = WGM * nN, gid = wgid / nig, fm = gid * WGM, gsz = (nM - fm) < WGM ? (nM - fm) : WGM;
        u.pm = fm + ((wgid % nig) % gsz); u.pn = (wgid % nig) / gsz; return true;
    }
};


struct EpiInProj {
    static constexpr bool PERM = true;
    bf16_t *QA, *KA, *VA, *SZA, *QB, *KB, *VB, *SZB, *SMA, *SMB;
    float* out;
    unsigned* knorm;
    __device__ __forceinline__ bool keep(const Unit&) const { return false; }
    __device__ __forceinline__ void operator()(f32x4 (&acc)[2][2][4][2], const Unit& u, int wr, int wc, int fr, int fq) const {
        const int pn = u.pn, pm = u.pm;
        bf16_t* dst; int ldd, dcol, actk; float* f32p = nullptr; int fmode = 0, nvalid = 256; bool dnorm = false; int noff = 0;
        const bool sample = (pm == 128);
        if (pn < 16) {
            const int seg = pn >> 1; dcol = (pn & 1) * 256; ldd = 512;
            if (seg == 0) { dst = QA; actk = 1; }
            else if (seg == 1) { dst = KA; actk = 0; }
            else if (seg == 2) { dst = VA; actk = 0; }
            else if (seg == 3) { dst = SZA; actk = 2; }
            else if (seg == 4) { dst = QB; actk = 1; }
            else if (seg == 5) { dst = KB; actk = 0; }
            else if (seg == 6) { dst = VB; actk = 0; }
            else { dst = SZB; actk = 2; }
            if (seg == 1 || seg == 2) {
                if (!sample) { const int bt = pm & 63; if (bt >= 62) { f32p = out + (seg == 1 ? O_AKP : O_AVP) + ((size_t)((pm >> 6) * 512 + (bt - 62) * 256)) * 512 + dcol; fmode = 1; } }
                else { f32p = out + (seg == 1 ? O_AKS : O_AVS) + dcol; fmode = 2; nvalid = 128; }
            } else if (seg == 4) { if (!sample) { dnorm = true; noff = 32; }
            } else if (seg == 5 || seg == 6) {
                if (!sample) { f32p = out + (seg == 5 ? O_BKP : O_BVP) + (size_t)pm * 256 * 512 + dcol; fmode = 1; dnorm = (seg == 5); }
                else { f32p = out + (seg == 5 ? O_BKS : O_BVS) + dcol; fmode = 1; nvalid = 128; }
            }
        } else { ldd = 1024; actk = 3; if (pn < 20) { dst = SMA; dcol = (pn - 16) * 256; } else { dst = SMB; dcol = (pn - 20) * 256; } }
        const int rl0 = wr * 64 + fr, cl = wc * 32 + 8 * fq;
        if (dnorm) {
#pragma unroll
            for (int bj = 0; bj < 2; ++bj) { float mx = 0.f;
#pragma unroll
                for (int ai = 0; ai < 2; ++ai)
#pragma unroll
                    for (int m = 0; m < 4; ++m) { const f32x4 a = acc[ai][bj][m][0], b = acc[ai][bj][m][1];
                        float s = (a[0] * a[0] + a[1] * a[1]) + (a[2] * a[2] + a[3] * a[3]) + (b[0] * b[0] + b[1] * b[1]) + (b[2] * b[2] + b[3] * b[3]);
                        s += __shfl_xor(s, 16); s += __shfl_xor(s, 32); mx = fmaxf(mx, s); }
                mx = fmaxf(mx, __shfl_xor(mx, 1)); mx = fmaxf(mx, __shfl_xor(mx, 2)); mx = fmaxf(mx, __shfl_xor(mx, 4)); mx = fmaxf(mx, __shfl_xor(mx, 8));
                if (fr == 0 && fq == 0) { const int head = (pn & 1) * 4 + bj * 2 + (wc >> 1);
                    __hip_atomic_fetch_max(knorm + noff + (((pm >> 6) * 8 + head) * 2 + (wc & 1)), __float_as_uint(mx), __ATOMIC_RELAXED, __HIP_MEMORY_SCOPE_AGENT); }
            }
        }
#pragma unroll
        for (int ai = 0; ai < 2; ++ai)
#pragma unroll
            for (int m = 0; m < 4; ++m) { const int rl = rl0 + ai * HALF + m * 16; const size_t grow = (size_t)pm * BM + rl;
#pragma unroll
                for (int bj = 0; bj < 2; ++bj) { f32x4 v0 = acc[ai][bj][m][0], v1 = acc[ai][bj][m][1];
                    if (f32p != nullptr && rl < nvalid) { const size_t ro = (fmode == 1) ? (size_t)rl * 512 : ((size_t)((rl >> 4) * 512 + 496 + (rl & 15))) * 512;
                        *(f32x4*)(f32p + ro + cl + bj * HALF) = v0; *(f32x4*)(f32p + ro + cl + bj * HALF + 4) = v1; }
                    if (actk == 1) { v0 = v0 * C2; v1 = v1 * C2; }
                    else if (actk == 2) {
#pragma unroll
                        for (int e = 0; e < 4; ++e) { v0[e] = v0[e] * sigmoidf_(v0[e]); v1[e] = v1[e] * sigmoidf_(v1[e]); } }
                    else if (actk == 3) {
#pragma unroll
                        for (int e = 0; e < 4; ++e) { v0[e] = sigmoidf_(v0[e]); v1[e] = sigmoidf_(v1[e]); } }
                    u32x4 w; w.x = cvtpk(v0[0], v0[1]); w.y = cvtpk(v0[2], v0[3]); w.z = cvtpk(v1[0], v1[1]); w.w = cvtpk(v1[2], v1[3]);
                    *(u32x4*)(dst + grow * ldd + dcol + cl + bj * HALF) = w; } }
    }
};
struct EpiMerge {
    static constexpr bool PERM = true;
    const bf16_t *SMA, *SMB; bf16_t* MG;
    __device__ __forceinline__ bool keep(const Unit& u) const { return u.kh == 0; }
    __device__ __forceinline__ void operator()(f32x4 (&acc)[2][2][4][2], const Unit& u, int wr, int wc, int fr, int fq) const {
        const int rl0 = wr * 64 + fr, cl = wc * 32 + 8 * fq;
#pragma unroll
        for (int ai = 0; ai < 2; ++ai)
#pragma unroll
            for (int m = 0; m < 4; ++m) { const size_t grow = (size_t)u.pm * BM + rl0 + ai * HALF + m * 16;
#pragma unroll
                for (int bj = 0; bj < 2; ++bj) { const size_t off = grow * 1024 + u.pn * BM + cl + bj * HALF;
                    const u32x4 sb = *(const u32x4*)(SMB + off);
                    float g[8] = {bflo(sb.x), bfhi(sb.x), bflo(sb.y), bfhi(sb.y), bflo(sb.z), bfhi(sb.z), bflo(sb.w), bfhi(sb.w)};
                    if (u.kh == 0) { const u32x4 sa = *(const u32x4*)(SMA + off);
                        const float a[8] = {bflo(sa.x), bfhi(sa.x), bflo(sa.y), bfhi(sa.y), bflo(sa.z), bfhi(sa.z), bflo(sa.w), bfhi(sa.w)};
#pragma unroll
                        for (int e = 0; e < 8; ++e) g[e] = a[e] * __builtin_amdgcn_rcpf(g[e]);
#pragma unroll
                        for (int e = 0; e < 4; ++e) { acc[ai][bj][m][0][e] *= g[e]; acc[ai][bj][m][1][e] *= g[4 + e]; }
                    } else { f32x4 v0 = acc[ai][bj][m][0], v1 = acc[ai][bj][m][1];
#pragma unroll
                        for (int e = 0; e < 4; ++e) { v0[e] *= g[e]; v1[e] *= g[4 + e]; }
                        u32x4 w; w.x = cvtpk(v0[0], v0[1]); w.y = cvtpk(v0[2], v0[3]); w.z = cvtpk(v1[0], v1[1]); w.w = cvtpk(v1[2], v1[3]);
                        *(u32x4*)(MG + off) = w; } } }
    }
};
struct EpiF32 {
    static constexpr bool PERM = false;
    float* C; int ldc;
    __device__ __forceinline__ bool keep(const Unit&) const { return false; }
    __device__ __forceinline__ void operator()(f32x4 (&acc)[2][2][4][2], const Unit& u, int wr, int wc, int fr, int fq) const {
        const int row0 = u.pm * BM + wr * 64 + fr, col0 = u.pn * BM + wc * 32 + 4 * fq;
#pragma unroll
        for (int ai = 0; ai < 2; ++ai)
#pragma unroll
            for (int m = 0; m < 4; ++m) { float* rowp = C + (size_t)(row0 + ai * HALF + m * 16) * ldc + col0;
#pragma unroll
                for (int bj = 0; bj < 2; ++bj)
#pragma unroll
                    for (int n = 0; n < 2; ++n) *(f32x4*)(rowp + bj * HALF + n * 16) = acc[ai][bj][m][n]; }
    }
};

template <class Epi, class Sched>
__device__ __forceinline__ void gemm_phase(PG8_LAS unsigned char* lds, const Gemm g, const Sched& S, const Epi& E) {
    const int tid = fresh_tid(), wid = __builtin_amdgcn_readfirstlane(tid >> 6), lane = tid & 63, wr = wid >> 2, wc = wid & 3, fr = lane & 15, fq = lane >> 4;
    const int K = g.ldk, nt = g.nt;
    unsigned voffA[2], voffB[2];
#pragma unroll
    for (int i = 0; i < 2; ++i) { int R, C; stage_rc(tid * 16 + i * 8192, R, C); const int Rb = Epi::PERM ? ((R & ~31) + perm32(R & 31)) : R;
        voffA[i] = (unsigned)(R * K + C) * 2u; voffB[i] = (unsigned)(Rb * K + C) * 2u; }
    const size_t kstep = (size_t)(BK * 2);
    const size_t hstep = (size_t)HALF * K * 2;
    const size_t tstep = 2 * hstep;
    const size_t khb = (size_t)nt * BK * 2;
    const unsigned ldsw = (unsigned)wid * 1024u;
    const int aoff = lds_byte(wr * 64 + fr, fq * 8), boff = lds_byte(wc * 32 + fr, fq * 8);
#define PG8_SA(b, h) (((b) * 2 + (h)) * HTB)
#define PG8_SB(b, h) ((4 + (b) * 2 + (h)) * HTB)
#define PG8_STAGE(bufoff, gbase, voff) do { _Pragma("unroll") for (int _i = 0; _i < 2; ++_i) \
        __builtin_amdgcn_global_load_lds((const unsigned*)((const char*)(gbase) + (voff)[_i]), (PG8_LAS unsigned*)(lds + (bufoff) + ldsw + _i * 8192), 16, 0, 0); } while (0)
#define PG8_LDA(dst, b, h) do { _Pragma("unroll") for (int m = 0; m < 4; ++m) _Pragma("unroll") for (int k = 0; k < 2; ++k) dst[m][k] = *(const PG8_LAS bf16x8*)(lds + PG8_SA(b, h) + aoff + m * 2048 + k * 1024); } while (0)
#define PG8_LDB(dst, b, h) do { _Pragma("unroll") for (int n = 0; n < 2; ++n) _Pragma("unroll") for (int k = 0; k < 2; ++k) dst[n][k] = *(const PG8_LAS bf16x8*)(lds + PG8_SB(b, h) + boff + n * 2048 + k * 1024); } while (0)
#define PG8_MMA(ai, bj, At, Bt) do { __builtin_amdgcn_s_setprio(1); _Pragma("unroll") for (int m = 0; m < 4; ++m) _Pragma("unroll") for (int n = 0; n < 2; ++n) _Pragma("unroll") for (int k = 0; k < 2; ++k) \
        acc[ai][bj][m][n] = __builtin_amdgcn_mfma_f32_16x16x32_bf16(Bt[n][k], At[m][k], acc[ai][bj][m][n], 0, 0, 0); __builtin_amdgcn_s_setprio(0); } while (0)
#define PG8_WAIT_V(n) asm volatile("s_waitcnt vmcnt(" #n ")" ::: "memory")
#define PG8_WAIT_L(n) asm volatile("s_waitcnt lgkmcnt(" #n ")" ::: "memory")
#define PG8_BAR __builtin_amdgcn_s_barrier()
#define PG8_SCHED __builtin_amdgcn_sched_barrier(0)
    Unit cur, nxt; int ui = 0;
    if (!S.next(0, cur)) return;
    f32x4 acc[2][2][4][2];
#pragma unroll
    for (int a = 0; a < 2; ++a)
#pragma unroll
        for (int b = 0; b < 2; ++b)
#pragma unroll
            for (int m = 0; m < 4; ++m)
#pragma unroll
                for (int n = 0; n < 2; ++n) acc[a][b][m][n] = (f32x4){0.f, 0.f, 0.f, 0.f};
    bf16x8 At[4][2], B0[2][2], B1[2][2];
    const char* cA = (const char*)g.A + (size_t)cur.pm * tstep + (size_t)cur.kh * khb; const char* cB = (const char*)g.Bt + (size_t)cur.pn * tstep + (size_t)cur.kh * khb;
    PG8_STAGE(PG8_SB(0, 0), cB, voffB); PG8_STAGE(PG8_SB(0, 1), cB + hstep, voffB); PG8_STAGE(PG8_SA(0, 0), cA, voffA); PG8_STAGE(PG8_SA(0, 1), cA + hstep, voffA);
    if (wr == 1) PG8_BAR;
    PG8_WAIT_V(2); PG8_BAR;
    PG8_STAGE(PG8_SB(1, 0), cB + kstep, voffB); PG8_STAGE(PG8_SA(1, 0), cA + kstep, voffA); PG8_STAGE(PG8_SB(1, 1), cB + hstep + kstep, voffB);
    PG8_WAIT_V(6); PG8_BAR;
    for (;;) {
        const bool has_next = S.next(ui + 1, nxt);
        const char* nA = has_next ? (const char*)g.A + (size_t)nxt.pm * tstep + (size_t)nxt.kh * khb : cA; const char* nB = has_next ? (const char*)g.Bt + (size_t)nxt.pn * tstep + (size_t)nxt.kh * khb : cB;
        for (int t = 0; t < nt; t += 2) {
            const bool last = (t == nt - 2);
            const char* a1 = cA + (size_t)(t + 1) * kstep;
            const char* a2 = last ? nA : cA + (size_t)(t + 2) * kstep; const char* b2 = last ? nB : cB + (size_t)(t + 2) * kstep;
            const char* a3 = a2 + kstep; const char* b3 = b2 + kstep;
            PG8_LDB(B0, 0, 0); PG8_LDB(B1, 0, 1); PG8_SCHED; PG8_LDA(At, 0, 0); PG8_STAGE(PG8_SA(1, 1), a1 + hstep, voffA);
            PG8_WAIT_V(8); PG8_WAIT_L(0); PG8_BAR; PG8_MMA(0, 0, At, B0); PG8_MMA(0, 1, At, B1); PG8_BAR; PG8_SCHED;
            PG8_LDA(At, 0, 1); PG8_STAGE(PG8_SB(0, 0), b2, voffB); PG8_STAGE(PG8_SB(0, 1), b2 + hstep, voffB); PG8_STAGE(PG8_SA(0, 0), a2, voffA);
            PG8_WAIT_V(8); PG8_WAIT_L(0); PG8_BAR; PG8_MMA(1, 0, At, B0); PG8_MMA(1, 1, At, B1); PG8_BAR; PG8_SCHED;
            PG8_LDB(B0, 1, 0); PG8_LDB(B1, 1, 1); PG8_SCHED; PG8_LDA(At, 1, 0); PG8_STAGE(PG8_SA(0, 1), a2 + hstep, voffA);
            PG8_WAIT_V(8); PG8_WAIT_L(0); PG8_BAR; PG8_MMA(0, 0, At, B0); PG8_MMA(0, 1, At, B1); PG8_BAR; PG8_SCHED;
            PG8_LDA(At, 1, 1); PG8_STAGE(PG8_SB(1, 0), b3, voffB); PG8_STAGE(PG8_SB(1, 1), b3 + hstep, voffB); PG8_STAGE(PG8_SA(1, 0), a3, voffA);
            PG8_WAIT_V(8); PG8_WAIT_L(0); PG8_BAR; PG8_MMA(1, 0, At, B0); PG8_MMA(1, 1, At, B1); PG8_BAR; PG8_SCHED;
        }
        if (wr == 0) PG8_BAR;
        E(acc, cur, wr, wc, fr, fq);
        if (!has_next) break;
        if (!E.keep(cur)) {
#pragma unroll
            for (int a = 0; a < 2; ++a)
#pragma unroll
                for (int b = 0; b < 2; ++b)
#pragma unroll
                    for (int m = 0; m < 4; ++m)
#pragma unroll
                        for (int n = 0; n < 2; ++n) acc[a][b][m][n] = (f32x4){0.f, 0.f, 0.f, 0.f};
        }
        cur = nxt; cA = nA; cB = nB; ++ui;
        if (wr == 1) PG8_BAR;
    }
    PG8_WAIT_V(0);
    PG8_BAR;
#undef PG8_SA
#undef PG8_SB
#undef PG8_STAGE
#undef PG8_LDA
#undef PG8_LDB
#undef PG8_MMA
#undef PG8_WAIT_V
#undef PG8_WAIT_L
#undef PG8_BAR
#undef PG8_SCHED
}
}

#define XB_TMO      128
#define XB_XCNT(j)  (256  + 64 * (j))
#define XB_XSUB(j)  (1280 + 64 * (j))
#define XB_XGEN(j)  (2304 + 64 * (j))
#define XB_TOP      3328
#define XB_TOPGEN   3392
#define XCD_BAR_WORDS 3456
#define XB_SPIN_CAP (1u << 18)
__device__ __forceinline__ unsigned xb_ld(unsigned* p)              { return __hip_atomic_load(p, __ATOMIC_RELAXED, __HIP_MEMORY_SCOPE_AGENT); }
__device__ __forceinline__ unsigned xb_add(unsigned* p, unsigned v) { return __hip_atomic_fetch_add(p, v, __ATOMIC_RELAXED, __HIP_MEMORY_SCOPE_AGENT); }
__device__ __forceinline__ unsigned xb_xcc_id() { return (unsigned)__builtin_amdgcn_s_getreg((3 << 11) | 20) & 0xFu; }
#define XB_SPIN(cond, bar) do { unsigned _sp = 0; while (cond) { __builtin_amdgcn_s_sleep(1); \
    if ((++_sp & 255u) == 0u) { if (xb_ld(&(bar)[XB_TMO])) break; if (_sp > XB_SPIN_CAP) { atomicAdd(&(bar)[XB_TMO], 1u); break; } } } } while (0)
struct XcdBarrier { unsigned* bar; unsigned x; volatile LAS unsigned* st; };
__device__ __forceinline__ XcdBarrier xcd_barrier_post(unsigned* bar, volatile LAS unsigned* st) {
    XcdBarrier b; b.bar = bar; b.x = xb_xcc_id(); b.st = st;
    if (threadIdx.x == 0) (void)xb_add(&bar[XB_XCNT(b.x)], 1u);
    return b;
}
__device__ __forceinline__ void xcd_barrier_complete(unsigned* bar, unsigned x, unsigned& nloc, unsigned& nx) {
    const unsigned G = gridDim.x * gridDim.y * gridDim.z;
    unsigned sum, cnt, mine, sp = 0u;
    for (;;) {
        sum = 0u; cnt = 0u; mine = 0u;
#pragma unroll
        for (unsigned j = 0; j < 16; ++j) { const unsigned c = xb_ld(&bar[XB_XCNT(j)]); sum += c; cnt += (c > 0u) ? 1u : 0u; mine = (j == x) ? c : mine; }
        if (sum == G) break;
        __builtin_amdgcn_s_sleep(1);
        if ((++sp & 255u) == 0u) { if (xb_ld(&bar[XB_TMO])) break; if (sp > XB_SPIN_CAP) { atomicAdd(&bar[XB_TMO], 1u); break; } }
    }
    nloc = mine > 0u ? mine : 1u; nx = cnt > 0u ? cnt : 1u;
}
__device__ __forceinline__ void xcd_barrier(const XcdBarrier& b) {
    asm volatile("s_waitcnt vmcnt(0)" ::: "memory");
    __syncthreads();
    if (threadIdx.x == 0) {
        unsigned* bar = b.bar;
        __builtin_amdgcn_s_waitcnt(0);
        unsigned nloc = b.st[0], nx = b.st[1];
        if (nloc == 0u) { xcd_barrier_complete(bar, b.x, nloc, nx); b.st[0] = nloc; b.st[1] = nx; }
        const unsigned old = xb_add(&bar[XB_XSUB(b.x)], 1u);
        const unsigned gen = old / nloc;
        if (old + 1u == (gen + 1u) * nloc) {
            __builtin_amdgcn_fence(__ATOMIC_RELEASE, "agent");
            asm volatile("s_waitcnt vmcnt(0)" ::: "memory");
            const unsigned og = xb_add(&bar[XB_TOP], 1u);
            const unsigned tg = og / nx;
            if (og + 1u == (tg + 1u) * nx) xb_add(&bar[XB_TOPGEN], 1u);
            else XB_SPIN(xb_ld(&bar[XB_TOPGEN]) == tg, bar);
            __builtin_amdgcn_fence(__ATOMIC_ACQUIRE, "agent");
            xb_add(&bar[XB_XGEN(b.x)], 1u);
            asm volatile("s_waitcnt vmcnt(0)" ::: "memory");
        } else {
            XB_SPIN(xb_ld(&bar[XB_XGEN(b.x)]) == gen, bar);
            __builtin_amdgcn_fence(__ATOMIC_ACQUIRE, "agent");
            asm volatile("s_waitcnt vmcnt(0)" ::: "memory");
        }
    }
    __syncthreads();
}

struct Args { const float* in[15]; float* out; unsigned char* ws; };

__device__ __forceinline__ float wave_sum(float v) {
#pragma unroll
    for (int o = 1; o < 64; o <<= 1) v += __shfl_xor(v, o);
    return v;
}
__device__ __forceinline__ float wave_max(float v) {
#pragma unroll
    for (int o = 1; o < 64; o <<= 1) v = fmaxf(v, __shfl_xor(v, o));
    return v;
}

__device__ __forceinline__ void p0_transpose_item(const float* W, int ldw, int csrc, bf16* WT, int ldt, int kdst, int nrow0, LAS float* scr, int k0, int lane) {
#pragma unroll 8
    for (int i = 0; i < 32; ++i) { const int kk = 2 * i + (lane >> 5); scr[kk * 33 + (lane & 31)] = W[(size_t)(k0 + kk) * ldw + csrc + (lane & 31)]; }
    asm volatile("s_waitcnt lgkmcnt(0)" ::: "memory");
    const int c = lane & 7;
#pragma unroll
    for (int j = 0; j < 4; ++j) { const int n = (lane >> 3) + 8 * j; const LAS float* s = scr + (8 * c) * 33 + n;
        v4u o; o.x = cvtpk(s[0 * 33], s[1 * 33]); o.y = cvtpk(s[2 * 33], s[3 * 33]); o.z = cvtpk(s[4 * 33], s[5 * 33]); o.w = cvtpk(s[6 * 33], s[7 * 33]);
        *(GAS v4u*)(WT + (size_t)(nrow0 + n) * ldt + kdst + k0 + 8 * c) = o; }
    asm volatile("s_waitcnt lgkmcnt(0)" ::: "memory");
}

namespace att {
typedef LAS const unsigned char* ldsc;
__device__ __forceinline__ int crow(int r, int hi) { return (r & 3) + 8 * (r >> 2) + 4 * hi; }
#define MFMA32(a, b, c) __builtin_amdgcn_mfma_f32_32x32x16_bf16(a, b, c, 0, 0, 0)
__device__ __forceinline__ s16x4 vtr(ldsc p) { return __builtin_bit_cast(s16x4, __builtin_amdgcn_ds_read_tr16_b64_v4i16((LAS v4i16_t*)p)); }

__device__ __forceinline__ void qkt(f32x16& p0, f32x16& p1, ldsc Kslot, const bf16x8* qr, const f32x16& c0, const f32x16& c1, int r32, int hi) {
    ldsc kb = Kslot + hi * 1024 + r32 * 16;
#pragma unroll
    for (int d0 = 0; d0 < 4; ++d0) {
        const bf16x8 b0 = *(LAS const bf16x8*)(kb + d0 * 2048);
        const bf16x8 b1 = *(LAS const bf16x8*)(kb + d0 * 2048 + 512);
        if (d0 == 0) { p0 = MFMA32(b0, qr[0], c0); p1 = MFMA32(b1, qr[0], c1); }
        else { p0 = MFMA32(b0, qr[d0], p0); p1 = MFMA32(b1, qr[d0], p1); } }
}
__device__ __forceinline__ float rowmax(const f32x16& p0, const f32x16& p1) {
    float a = fmaxf(p0[0], p1[0]);
#pragma unroll
    for (int r = 1; r < 16; ++r) a = fmaxf(a, fmaxf(p0[r], p1[r]));
    auto rr = __builtin_amdgcn_permlane32_swap(__float_as_uint(a), __float_as_uint(a), false, false);
    return fmaxf(__uint_as_float(rr[0]), __uint_as_float(rr[1]));
}
__device__ __forceinline__ float halfsum(float a) {
    auto rr = __builtin_amdgcn_permlane32_swap(__float_as_uint(a), __float_as_uint(a), false, false);
    return __uint_as_float(rr[0]) + __uint_as_float(rr[1]);
}
__device__ __forceinline__ void softmax_pv(f32x16& p0, f32x16& p1, f32x16 (&o)[2], float& m_run, float& l_run, LAS float* wsf, ldsc Vslot, int lane, int r32, int hi) {
    const float rm = rowmax(p0, p1);
    const float mn = fmaxf(m_run, rm); const float alpha = fexp2(m_run - mn); m_run = mn;
    float s = 0.f;
#pragma unroll
    for (int r = 0; r < 16; ++r) { p0[r] = fexp2(p0[r] - mn); p1[r] = fexp2(p1[r] - mn); s += p0[r] + p1[r]; }
    l_run = l_run * alpha + s;
    if (hi == 0) wsf[r32] = alpha;
#pragma unroll
    for (int g = 0; g < 4; ++g) { const f32x4 a4 = *(LAS const f32x4*)(wsf + 8 * g + 4 * hi);
#pragma unroll
        for (int j = 0; j < 4; ++j) { o[0][4 * g + j] *= a4[j]; o[1][4 * g + j] *= a4[j]; } }
    bf16x8 pa[4];
    { v4u w;
      w.x = cvtpk(p0[0], p0[1]); w.y = cvtpk(p0[2], p0[3]); w.z = cvtpk(p0[4], p0[5]); w.w = cvtpk(p0[6], p0[7]); pa[0] = __builtin_bit_cast(bf16x8, w);
      w.x = cvtpk(p0[8], p0[9]); w.y = cvtpk(p0[10], p0[11]); w.z = cvtpk(p0[12], p0[13]); w.w = cvtpk(p0[14], p0[15]); pa[1] = __builtin_bit_cast(bf16x8, w);
      w.x = cvtpk(p1[0], p1[1]); w.y = cvtpk(p1[2], p1[3]); w.z = cvtpk(p1[4], p1[5]); w.w = cvtpk(p1[6], p1[7]); pa[2] = __builtin_bit_cast(bf16x8, w);
      w.x = cvtpk(p1[8], p1[9]); w.y = cvtpk(p1[10], p1[11]); w.z = cvtpk(p1[12], p1[13]); w.w = cvtpk(p1[14], p1[15]); pa[3] = __builtin_bit_cast(bf16x8, w); }
    ldsc vp = Vslot + ((lane >> 4) & 1) * 32 + (lane & 3) * 8 + (4 * hi + ((lane & 15) >> 2)) * 64;
#pragma unroll
    for (int d0 = 0; d0 < 2; ++d0)
#pragma unroll
        for (int ks = 0; ks < 4; ++ks) { const s16x4 lo = vtr(vp + d0 * 4096 + ks * 1024), hh = vtr(vp + d0 * 4096 + ks * 1024 + 512);
            const bf16x8 vb = (bf16x8){lo[0], lo[1], lo[2], lo[3], hh[0], hh[1], hh[2], hh[3]};
            o[d0] = MFMA32(pa[ks], vb, o[d0]); }
}
__device__ __forceinline__ v4u mul8(v4u a, v4u z) {
    v4u r; r.x = cvtpk(bflo(a.x) * bflo(z.x), bfhi(a.x) * bfhi(z.x)); r.y = cvtpk(bflo(a.y) * bflo(z.y), bfhi(a.y) * bfhi(z.y));
    r.z = cvtpk(bflo(a.z) * bflo(z.z), bfhi(a.z) * bfhi(z.z)); r.w = cvtpk(bflo(a.w) * bflo(z.w), bfhi(a.w) * bfhi(z.w)); return r;
}

struct Ctx {
    LAS unsigned char* lds;
    const bf16 *QA, *KA, *VA, *QB, *KB, *VB, *SZA, *SZB; bf16* G;
    const float *Fp, *Fs, *rel; const float *cak, *cav, *cbk, *cbv;
    const unsigned* knorm;
};

constexpr int PL_K = 0, PL_V = 24576, PL_F = 49152, PL_BT = 51200, PL_OST = 77824, SLOTB = 8192;
__device__ __forceinline__ void glds16(const void* gsrc, unsigned lds_dst) { unsigned keep;
    asm volatile("s_mov_b32 %0, m0\n\ts_mov_b32 m0, %2\n\ts_nop 0\n\tglobal_load_lds_dwordx4 %1, off\n\ts_mov_b32 m0, %0" : "=&s"(keep) : "v"(gsrc), "s"(lds_dst) : "memory"); }
__device__ __forceinline__ void glds4(const void* gsrc, unsigned lds_dst) { unsigned keep;
    asm volatile("s_mov_b32 %0, m0\n\ts_mov_b32 m0, %2\n\ts_nop 0\n\tglobal_load_lds_dword %1, off\n\ts_mov_b32 m0, %0" : "=&s"(keep) : "v"(gsrc), "s"(lds_dst) : "memory"); }
typedef LAS const char* lds_cptr;
__device__ __forceinline__ void kload8(bf16x8* kf, lds_cptr kp) {
    kf[0] = *(LAS const bf16x8*)(kp);        kf[1] = *(LAS const bf16x8*)(kp + 512);
    kf[2] = *(LAS const bf16x8*)(kp + 2048); kf[3] = *(LAS const bf16x8*)(kp + 2560);
    kf[4] = *(LAS const bf16x8*)(kp + 4096); kf[5] = *(LAS const bf16x8*)(kp + 4608);
    kf[6] = *(LAS const bf16x8*)(kp + 6144); kf[7] = *(LAS const bf16x8*)(kp + 6656);
}
__device__ __forceinline__ void kload2(bf16x8* kf, lds_cptr kp, int j) { kf[2 * j] = *(LAS const bf16x8*)(kp + j * 2048); kf[2 * j + 1] = *(LAS const bf16x8*)(kp + j * 2048 + 512); }
__device__ __forceinline__ s16x4 vtr2(lds_cptr p) { return __builtin_bit_cast(s16x4, __builtin_amdgcn_ds_read_tr16_b64_v4i16((LAS v4i16_t*)p)); }
#define SBAR() __builtin_amdgcn_sched_barrier(0)
#define PIN(x) asm volatile("" : "+v"(x))
#define WAITB(N) asm volatile("s_waitcnt vmcnt(" #N ") lgkmcnt(0)\n\ts_barrier" ::: "memory")

template <int KIND, int THRL>
__device__ __forceinline__ void prompt_unit(const Ctx& X, int b, int h, int qb) {
    const int tid = fresh_tid(), lane = tid & 63, r32 = lane & 31, hi = lane >> 5; const int wid = __builtin_amdgcn_readfirstlane(tid >> 6);
    LAS unsigned char* lds = X.lds;
    const bf16* Q = KIND ? X.QA : X.QB; const bf16* Kt = KIND ? X.KA : X.KB; const bf16* Vt = KIND ? X.VA : X.VB; const bf16* SZ = KIND ? X.SZA : X.SZB;
    const size_t rowbase = (size_t)b * SEQ; const int q0 = qb * 256;
    const bf16* Qw = Q + (rowbase + q0 + wid * 32) * 512 + h * 64;
    const unsigned lds0 = (unsigned)(uintptr_t)lds;
    LAS float* wsf = (LAS float*)(lds + WSF_OFF) + wid * 64;
    const float* Fbh = X.Fp + (size_t)(b * 8 + h) * SEQ;
    int j_lo; const int j_hi = 4 * qb + 3; float Fq0L = 0.f;
    if (KIND == 0) {
        const float kn = __uint_as_float(__hip_atomic_load(X.knorm + ((b * 8 + h) * 2), RLX_AGENT)) + __uint_as_float(__hip_atomic_load(X.knorm + ((b * 8 + h) * 2) + 1, RLX_AGENT));
        const float qn = __uint_as_float(__hip_atomic_load(X.knorm + 32 + ((b * 8 + h) * 2), RLX_AGENT)) + __uint_as_float(__hip_atomic_load(X.knorm + 32 + ((b * 8 + h) * 2) + 1, RLX_AGENT));
        const float thr = 2.0f * C2 * sqrtf(qn * kn) * 1.02f + 40.0f;
        const float Fq0 = Fbh[q0]; Fq0L = Fq0 * L2E;
        int cnt = 0, base = 4 * qb - 1;
        for (;;) {
            const int jb = base - lane; bool ok = false;
            if (jb >= 0) ok = (Fq0 - Fbh[64 * jb + 63]) * L2E >= -thr;
            const unsigned long long mk = __ballot(ok);
            const int c = (mk == ~0ull) ? 64 : __builtin_ctzll(~mk);
            cnt += c; if (c < 64) break; base -= 64; if (base < 0) break;
        }
        j_lo = 4 * qb - cnt; if (j_lo < 0) j_lo = 0;
        if (((j_hi - j_lo + 1) & 1) && j_lo > 0) --j_lo;
        j_lo = __builtin_amdgcn_readfirstlane(j_lo);
    } else {
        j_lo = 4 * qb - 8; if (j_lo < 0) j_lo = 0;
    }
    const int n = j_hi - j_lo + 1;
    int ta, tb;
    if (KIND == 0) { ta = 0; tb = n - 4 + (wid >> 1); }
    else { const int cw = 4 * qb + (wid >> 1); ta = cw - 8; if (ta < 0) ta = 0; ta -= j_lo; tb = cw - j_lo; }
    const bf16* Kh = Kt + (rowbase + (size_t)j_lo * 64) * 512 + h * 64; const bf16* Vh = Vt + (rowbase + (size_t)j_lo * 64) * 512 + h * 64;
    const float* Fj = Fbh + 64 * j_lo;
    const bf16* ksrc = Kh + (size_t)lane * 512 + wid * 8;
    const bf16* vsrc = Vh + (size_t)(16 * (wid & 3) + (lane >> 2)) * 512 + (wid >> 2) * 32 + (lane & 3) * 8;
    const unsigned kdst = lds0 + PL_K + wid * 1024, vdst = lds0 + PL_V + wid * 1024, fdst = lds0 + PL_F;
#define DMA_K(t, slot) glds16(ksrc + (size_t)(t) * 64 * 512, (unsigned)__builtin_amdgcn_readfirstlane(kdst + (slot)))
#define DMA_V(t, slot) glds16(vsrc + (size_t)(t) * 64 * 512, (unsigned)__builtin_amdgcn_readfirstlane(vdst + (slot)))
#define DMA_F(t) do { if (KIND == 0) glds4(Fj + 64 * (t) + lane, (unsigned)__builtin_amdgcn_readfirstlane(fdst + ((t) & 3) * 256)); } while (0)
    const lds_cptr shm3 = (lds_cptr)lds; const lds_cptr kp0 = shm3 + PL_K + hi * 1024 + r32 * 16;
    const lds_cptr vp0 = shm3 + PL_V + ((lane >> 4) & 1) * 32 + (lane & 3) * 8 + (4 * hi + ((lane & 15) >> 2)) * 64;
    LAS const float* BT = (LAS const float*)(lds + PL_BT);
    float c191 = 0.f;
    if (KIND == 1) {
        const float* relh = X.rel + h * NREL;
#pragma unroll
        for (int k = 0; k < 12; ++k) { const int e = tid + 512 * k, di = e >> 10, ln = (e >> 4) & 63, r = e & 15;
            int idx = (32 * di - 32) + (ln & 31) - crow(r, ln >> 5) + 63; idx = min(max(idx, 0), NREL - 1);
            ((LAS float*)(lds + PL_BT))[e] = relh[idx] * L2E; }
        c191 = relh[NREL - 1] * L2E;
    }
    DMA_K(0, 0); DMA_F(0); DMA_V(0, 0); DMA_K(1, SLOTB); DMA_F(1);
    bf16x8 qr[4];
#pragma unroll
    for (int d0 = 0; d0 < 4; ++d0) qr[d0] = *(const bf16x8*)(Qw + (size_t)r32 * 512 + d0 * 16 + hi * 8);
    DMA_K(2, 2 * SLOTB); DMA_F(2);
    float mhat = 0.f, l_reg = 0.f; f32x16 o[2]; o[0] = f32x16{}; o[1] = f32x16{};
    const int qrel = wid * 32 + r32;
    bool resc = false;
    f32x16 pA0, pA1, pB0, pB1; bf16x8 kf[8];
    s16x4 vlo[8], vhi[8]; v4u pw0, pw1, pw2, pw3;
    int sl_prev = 0, sl_cur = 0, sl_next = SLOTB;
#define ROT() do { sl_prev = sl_cur; sl_cur = sl_next; sl_next = (sl_next == 2 * SLOTB) ? 0 : sl_next + SLOTB; } while (0)
#define CINIT(C0, C1, t) do { \
        if (KIND == 0) { LAS const float* fb_ = (LAS const float*)(lds + PL_F + ((t) & 3) * 256); const float base_ = Fq0L - mhat; \
            _Pragma("unroll") for (int g_ = 0; g_ < 4; ++g_) { const f32x4 f0_ = *(LAS const f32x4*)(fb_ + 8 * g_ + 4 * hi), f1_ = *(LAS const f32x4*)(fb_ + 32 + 8 * g_ + 4 * hi); \
                _Pragma("unroll") for (int e_ = 0; e_ < 4; ++e_) { C0[4 * g_ + e_] = __builtin_fmaf(f0_[e_], -L2E, base_); C1[4 * g_ + e_] = __builtin_fmaf(f1_[e_], -L2E, base_); } } \
        } else { const int dl0_ = 32 * (wid & 1) + 64 * (tb - (t)); \
            if (dl0_ >= 160) { const float cc_ = c191 - mhat; _Pragma("unroll") for (int r_ = 0; r_ < 16; ++r_) C0[r_] = cc_; } \
            else { LAS const float* bp_ = BT + (((dl0_ + 32) >> 5) * 64 + lane) * 16; \
                _Pragma("unroll") for (int g_ = 0; g_ < 4; ++g_) { const f32x4 f0_ = *(LAS const f32x4*)(bp_ + 4 * g_); _Pragma("unroll") for (int e_ = 0; e_ < 4; ++e_) C0[4 * g_ + e_] = f0_[e_] - mhat; } } \
            if (dl0_ - 32 >= 160) { const float cc_ = c191 - mhat; _Pragma("unroll") for (int r_ = 0; r_ < 16; ++r_) C1[r_] = cc_; } \
            else { LAS const float* bp_ = BT + (((dl0_) >> 5) * 64 + lane) * 16; \
                _Pragma("unroll") for (int g_ = 0; g_ < 4; ++g_) { const f32x4 f1_ = *(LAS const f32x4*)(bp_ + 4 * g_); _Pragma("unroll") for (int e_ = 0; e_ < 4; ++e_) C1[4 * g_ + e_] = f1_[e_] - mhat; } } \
        } } while (0)
#define CMASK(P0, P1, t) do { if (KIND == 0) { const int jb_ = (t) - (n - 4); if (jb_ >= 0) { const int kb_ = 64 * jb_ + 4 * hi; \
        _Pragma("unroll") for (int r_ = 0; r_ < 16; ++r_) { const int kv_ = kb_ + (r_ & 3) + 8 * (r_ >> 2); if (kv_ > qrel) P0[r_] = -INFINITY; if (kv_ + 32 > qrel) P1[r_] = -INFINITY; } } } } while (0)
#define MX3(a, b, c) __builtin_fmaxf(__builtin_fmaxf((a), (b)), (c))
#define ROWMAX(C0, C1, rm) do { float a_ = MX3(C0[0], C0[1], C1[0]), b_ = MX3(C0[2], C0[3], C1[1]); a_ = MX3(a_, C1[2], C1[3]); \
        _Pragma("unroll") for (int r_ = 4; r_ < 16; r_ += 4) { a_ = MX3(a_, C0[r_], C0[r_ + 1]); b_ = MX3(b_, C0[r_ + 2], C0[r_ + 3]); a_ = MX3(a_, C1[r_], C1[r_ + 1]); b_ = MX3(b_, C1[r_ + 2], C1[r_ + 3]); } \
        rm = __builtin_fmaxf(a_, b_); { auto rr_ = __builtin_amdgcn_permlane32_swap(__float_as_uint(rm), __float_as_uint(rm), false, false); rm = __builtin_fmaxf(__uint_as_float(rr_[0]), __uint_as_float(rr_[1])); } } while (0)
#define FIRST(C0, C1, t) do { CINIT(C0, C1, t); \
        C0 = MFMA32(kf[0], qr[0], C0); C1 = MFMA32(kf[1], qr[0], C1); C0 = MFMA32(kf[2], qr[1], C0); C1 = MFMA32(kf[3], qr[1], C1); \
        C0 = MFMA32(kf[4], qr[2], C0); C1 = MFMA32(kf[5], qr[2], C1); C0 = MFMA32(kf[6], qr[3], C0); C1 = MFMA32(kf[7], qr[3], C1); \
        CMASK(C0, C1, t); float rm_; ROWMAX(C0, C1, rm_); mhat += rm_; \
        _Pragma("unroll") for (int r_ = 0; r_ < 16; ++r_) { C0[r_] = fexp2(C0[r_] - rm_); C1[r_] = fexp2(C1[r_] - rm_); } } while (0)
#define PKW(P, B) cvtpk(P[B], P[B + 1])
#define PAF(k) __builtin_bit_cast(bf16x8, pw##k)
#define VFR(i) (bf16x8){vlo[i][0], vlo[i][1], vlo[i][2], vlo[i][3], vhi[i][0], vhi[i][1], vhi[i][2], vhi[i][3]}
#define GAPA(MF, A0, A1, A2, A3, W0, W1, PW) do { MF; sacc += A0; sacc += A1; sacc += A2; sacc += A3; PIN(sacc); W0; W1; PIN(PW); SBAR(); } while (0)
#define GAPB(MF, Xv, B) do { MF; Xv[B] = fexp2(Xv[B]); Xv[B + 1] = fexp2(Xv[B + 1]); Xv[B + 2] = fexp2(Xv[B + 2]); Xv[B + 3] = fexp2(Xv[B + 3]); PIN(Xv); SBAR(); } while (0)
#define VRD(i) do { vlo[i] = vtr2(vp_ + (((i) >> 2) * 4096 + ((i) & 3) * 1024)); vhi[i] = vtr2(vp_ + (((i) >> 2) * 4096 + ((i) & 3) * 1024 + 512)); } while (0)
#define KRD(G, j) do { if (G) { kload2(kf, kp0 + sl_next, j); SBAR(); } } while (0)
#define DMA_SLOT(t) do { if ((t) + 3 < n) { DMA_K((t) + 3, sl_cur); DMA_F((t) + 3); } if ((t) + 1 < n) { DMA_V((t) + 1, sl_next); } } while (0)
#define STEP(C0, C1, P0, P1, t, GL) do { CINIT(C0, C1, t); SBAR(); \
        const lds_cptr vp_ = vp0 + sl_prev; \
        VRD(0); SBAR(); float sacc = (P0[0] + P0[1]); \
        GAPA(C0 = MFMA32(kf[0], qr[0], C0), P0[2], P0[3], P0[4], P0[5],     pw0[0] = PKW(P0, 0), pw0[1] = PKW(P0, 2), pw0); \
        VRD(4); SBAR(); GAPA(C1 = MFMA32(kf[1], qr[0], C1), P0[6], P0[7], P0[8], P0[9],     pw0[2] = PKW(P0, 4), pw0[3] = PKW(P0, 6), pw0); \
        VRD(1); SBAR(); GAPA(C0 = MFMA32(kf[2], qr[1], C0), P0[10], P0[11], P0[12], P0[13], pw1[0] = PKW(P0, 8), pw1[1] = PKW(P0, 10), pw1); \
        VRD(5); SBAR(); GAPA(C1 = MFMA32(kf[3], qr[1], C1), P0[14], P0[15], P1[0], P1[1],   pw1[2] = PKW(P0, 12), pw1[3] = PKW(P0, 14), pw1); \
        VRD(2); SBAR(); GAPA(C0 = MFMA32(kf[4], qr[2], C0), P1[2], P1[3], P1[4], P1[5],     pw2[0] = PKW(P1, 0), pw2[1] = PKW(P1, 2), pw2); \
        VRD(6); SBAR(); GAPA(C1 = MFMA32(kf[5], qr[2], C1), P1[6], P1[7], P1[8], P1[9],     pw2[2] = PKW(P1, 4), pw2[3] = PKW(P1, 6), pw2); \
        VRD(3); SBAR(); GAPA(C0 = MFMA32(kf[6], qr[3], C0), P1[10], P1[11], P1[12], P1[13], pw3[0] = PKW(P1, 8), pw3[1] = PKW(P1, 10), pw3); \
        VRD(7); SBAR(); GAPA(C1 = MFMA32(kf[7], qr[3], C1), P1[14], P1[15], 0.f, 0.f,       pw3[2] = PKW(P1, 12), pw3[3] = PKW(P1, 14), pw3); \
        l_reg += sacc; \
        DMA_SLOT(t); \
        CMASK(C0, C1, t); \
        { float rm; ROWMAX(C0, C1, rm); resc = false; \
          if (__builtin_expect(__any(rm > (float)THRL), 0)) { const float dl = __builtin_fmaxf(rm, 0.f); mhat += dl; \
            _Pragma("unroll") for (int r_ = 0; r_ < 16; ++r_) { C0[r_] -= dl; C1[r_] -= dl; } \
            const float f = fexp2(-dl); l_reg *= f; if (hi == 0) wsf[r32] = f; resc = true; } } \
        SBAR(); \
        GAPB(o[0] = MFMA32(PAF(0), VFR(0), o[0]), C0, 0); \
        GAPB(o[1] = MFMA32(PAF(0), VFR(4), o[1]), C0, 4); \
        KRD(GL, 0); GAPB(o[0] = MFMA32(PAF(1), VFR(1), o[0]), C0, 8); \
        KRD(GL, 1); GAPB(o[1] = MFMA32(PAF(1), VFR(5), o[1]), C0, 12); \
        KRD(GL, 2); GAPB(o[0] = MFMA32(PAF(2), VFR(2), o[0]), C1, 0); \
        KRD(GL, 3); GAPB(o[1] = MFMA32(PAF(2), VFR(6), o[1]), C1, 4); \
        GAPB(o[0] = MFMA32(PAF(3), VFR(3), o[0]), C1, 8); \
        GAPB(o[1] = MFMA32(PAF(3), VFR(7), o[1]), C1, 12); \
    } while (0)
#define DRAIN(P0, P1) do { float sacc = P0[0] + P0[1]; _Pragma("unroll") for (int r_ = 2; r_ < 16; ++r_) sacc += P0[r_]; _Pragma("unroll") for (int r_ = 0; r_ < 16; ++r_) sacc += P1[r_]; l_reg += sacc; \
        pw0 = (v4u){PKW(P0, 0), PKW(P0, 2), PKW(P0, 4), PKW(P0, 6)}; pw1 = (v4u){PKW(P0, 8), PKW(P0, 10), PKW(P0, 12), PKW(P0, 14)}; \
        pw2 = (v4u){PKW(P1, 0), PKW(P1, 2), PKW(P1, 4), PKW(P1, 6)}; pw3 = (v4u){PKW(P1, 8), PKW(P1, 10), PKW(P1, 12), PKW(P1, 14)}; \
        const lds_cptr vp_ = vp0 + sl_prev; \
        _Pragma("unroll") for (int i_ = 0; i_ < 8; ++i_) { vlo[i_] = vtr2(vp_ + ((i_ >> 2) * 4096 + (i_ & 3) * 1024)); vhi[i_] = vtr2(vp_ + ((i_ >> 2) * 4096 + (i_ & 3) * 1024 + 512)); } \
        o[0] = MFMA32(PAF(0), VFR(0), o[0]); o[1] = MFMA32(PAF(0), VFR(4), o[1]); o[0] = MFMA32(PAF(1), VFR(1), o[0]); o[1] = MFMA32(PAF(1), VFR(5), o[1]); \
        o[0] = MFMA32(PAF(2), VFR(2), o[0]); o[1] = MFMA32(PAF(2), VFR(6), o[1]); o[0] = MFMA32(PAF(3), VFR(3), o[0]); o[1] = MFMA32(PAF(3), VFR(7), o[1]); } while (0)
#define RESC() do { if (resc) { _Pragma("unroll") for (int g_ = 0; g_ < 4; ++g_) { const f32x4 a4_ = *(LAS const f32x4*)(wsf + 8 * g_ + 4 * hi); \
        _Pragma("unroll") for (int e_ = 0; e_ < 4; ++e_) { o[0][4 * g_ + e_] *= a4_[e_]; o[1][4 * g_ + e_] *= a4_[e_]; } } resc = false; } } while (0)
#define CLOSE(t) do { if ((t) + 3 < n) { if (KIND == 0) WAITB(3); else WAITB(2); } else if ((t) + 1 < n) { WAITB(1); } else { WAITB(0); } } while (0)
#define IDLE(t) do { DMA_SLOT(t); if ((t) + 1 >= ta && (t) + 1 <= tb) kload8(kf, kp0 + sl_next); CLOSE(t); ROT(); } while (0)

    if (KIND == 0) WAITB(4); else WAITB(2);
    if (ta == 0) { kload8(kf, kp0); FIRST(pA0, pA1, 0); }
    WAITB(0);
    DMA_K(3, 0); DMA_F(3); DMA_V(1, SLOTB);
    ROT();
    if (1 >= ta && 1 <= tb) kload8(kf, kp0 + sl_cur);
    if (KIND == 0) WAITB(3); else WAITB(2);
    int t = 1;
    if (ta > 0) {
        for (; t < ta; ++t) IDLE(t);
        DMA_SLOT(t); FIRST(pA0, pA1, t); if (t + 1 <= tb) kload8(kf, kp0 + sl_next); CLOSE(t); ROT(); ++t;
    }
    for (; t + 1 <= tb; t += 2) {
        STEP(pB0, pB1, pA0, pA1, t, true); CLOSE(t); RESC(); ROT();
        const bool gl2 = (t + 2 <= tb);
        STEP(pA0, pA1, pB0, pB1, t + 1, gl2); CLOSE(t + 1); RESC(); ROT();
    }
    if (t <= tb) { STEP(pB0, pB1, pA0, pA1, t, false); CLOSE(t); RESC(); ROT(); ++t;
        DMA_SLOT(t); DRAIN(pB0, pB1); CLOSE(t); ROT(); ++t; }
    else { DMA_SLOT(t); DRAIN(pA0, pA1); CLOSE(t); ROT(); ++t; }
    for (; t <= n; ++t) IDLE(t);
    { const float lt = halfsum(l_reg);
      if (hi == 0) wsf[32 + r32] = lt;
      float rli[16];
#pragma unroll
      for (int g = 0; g < 4; ++g) { const f32x4 a4 = *(LAS const f32x4*)(wsf + 32 + 8 * g + 4 * hi);
#pragma unroll
          for (int e = 0; e < 4; ++e) rli[4 * g + e] = __builtin_amdgcn_rcpf(a4[e]); }
      LAS bf16* stg = (LAS bf16*)(lds + PL_OST + wid * 4096);
#pragma unroll
      for (int r = 0; r < 16; ++r) { const int orow = crow(r, hi);
#pragma unroll
          for (int d0 = 0; d0 < 2; ++d0) stg[orow * 64 + d0 * 32 + r32] = (bf16)(cvtpk(o[d0][r] * rli[r], 0.f) & 0xffffu); }
      const size_t grow0 = rowbase + q0 + wid * 32;
#pragma unroll
      for (int i = 0; i < 4; ++i) { const int row = i * 8 + (lane >> 3), ch = lane & 7;
          const v4u v = *(LAS const v4u*)(stg + row * 64 + ch * 8);
          const v4u z = *(const v4u*)(SZ + (grow0 + row) * 512 + h * 64 + ch * 8);
          *(v4u*)(X.G + (grow0 + row) * 1024 + (KIND ? 0 : 512) + h * 64 + ch * 8) = mul8(v, z); } }
    asm volatile("s_waitcnt vmcnt(0) lgkmcnt(0)\n\ts_barrier" ::: "memory");
#undef DMA_K
#undef DMA_V
#undef DMA_F
#undef ROT
#undef CINIT
#undef CMASK
#undef MX3
#undef ROWMAX
#undef FIRST
#undef PKW
#undef PAF
#undef VFR
#undef GAPA
#undef GAPB
#undef VRD
#undef KRD
#undef DMA_SLOT
#undef STEP
#undef DRAIN
#undef RESC
#undef CLOSE
#undef IDLE
}

template <int KIND>
__device__ __forceinline__ void sample_unit(const Ctx& X, int bs, int h) {
    const int tid = fresh_tid(), lane = tid & 63, r32 = lane & 31, hi = lane >> 5; const int wid = __builtin_amdgcn_readfirstlane(tid >> 6);
    LAS unsigned char* lds = X.lds;
    const int ncache = KIND ? AKEEP : PAST, nct = ncache / 64, ntile = nct + 1;
    const float* Kc = (KIND ? X.cak : X.cbk) + ((size_t)bs * ncache * 8 + h) * 64;
    const float* Vc = (KIND ? X.cav : X.cbv) + ((size_t)bs * ncache * 8 + h) * 64;
    const bf16* Q = KIND ? X.QA : X.QB; const bf16* Kn = KIND ? X.KA : X.KB; const bf16* Vn = KIND ? X.VA : X.VB; const bf16* SZ = KIND ? X.SZA : X.SZB;
    const size_t nrow0 = (size_t)MP + 16 * bs;
    LAS float* wsf = (LAS float*)(lds + WSF_OFF) + wid * 64;
    LAS float* tb = (LAS float*)(lds + TB_OFF);
    if (KIND == 1) { if (tid < NREL) tb[tid] = X.rel[h * NREL + tid] * L2E; }
    __syncthreads();
    bf16x8 qr[4];
#pragma unroll
    for (int d0 = 0; d0 < 4; ++d0) qr[d0] = *(const bf16x8*)(Q + (nrow0 + (r32 & 15)) * 512 + h * 64 + d0 * 16 + hi * 8);
    const float* Fsr = X.Fs + (size_t)(bs * 8 + h) * FS_PITCH;
    const float Fref = (KIND == 0) ? Fsr[PAST - 1] : 0.f;
    LAS unsigned char* kslot = lds + wid * 16384; LAS unsigned char* vslot = kslot + 8192;
    float m_run = -1e30f, l_run = 0.f; f32x16 o[2]; o[0] = f32x16{}; o[1] = f32x16{};
    const int tq = r32 & 15;
    for (int t = wid; t < ntile; t += 8) {
        if (t < nct) {
            const float* kr = Kc + (size_t)(t * 64 + (lane >> 4)) * 512 + (lane & 15) * 4; const float* vr = Vc + (size_t)(t * 64 + (lane >> 4)) * 512 + (lane & 15) * 4;
            f32x4 kq[16], vq[16];
#pragma unroll
            for (int i = 0; i < 16; ++i) kq[i] = *(const f32x4*)(kr + (size_t)i * 4 * 512);
#pragma unroll
            for (int i = 0; i < 16; ++i) vq[i] = *(const f32x4*)(vr + (size_t)i * 4 * 512);
            LAS unsigned char* kw = kslot + ((lane & 15) >> 1) * 1024 + (lane >> 4) * 16 + (lane & 1) * 8;
            LAS unsigned char* vw = vslot + ((lane & 15) >> 3) * 4096 + (lane >> 4) * 64 + (lane & 7) * 8;
#pragma unroll
            for (int i = 0; i < 16; ++i) { v2u w; w.x = cvtpk(kq[i][0], kq[i][1]); w.y = cvtpk(kq[i][2], kq[i][3]); *(LAS v2u*)(kw + i * 64) = w; }
#pragma unroll
            for (int i = 0; i < 16; ++i) { v2u w; w.x = cvtpk(vq[i][0], vq[i][1]); w.y = cvtpk(vq[i][2], vq[i][3]); *(LAS v2u*)(vw + i * 256) = w; }
        } else {
#pragma unroll
            for (int c = 0; c < 8; ++c) { v4u wk = (v4u){0u, 0u, 0u, 0u}, wv = wk;
                if (lane < 16) { wk = *(const v4u*)(Kn + (nrow0 + lane) * 512 + h * 64 + c * 8); wv = *(const v4u*)(Vn + (nrow0 + lane) * 512 + h * 64 + c * 8); }
                *(LAS v4u*)(kslot + c * 1024 + lane * 16) = wk;
                *(LAS v4u*)(vslot + (c >> 2) * 4096 + lane * 64 + (c & 3) * 16) = wv; }
        }
        f32x16 c0, c1, p0, p1;
        if (KIND == 0) {
            const float* fb = Fsr + t * 64;
#pragma unroll
            for (int g = 0; g < 4; ++g) { const f32x4 f0 = *(const f32x4*)(fb + 8 * g + 4 * hi), f1 = *(const f32x4*)(fb + 32 + 8 * g + 4 * hi);
#pragma unroll
                for (int e = 0; e < 4; ++e) { c0[4 * g + e] = (Fref - f0[e]) * L2E; c1[4 * g + e] = (Fref - f1[e]) * L2E; } }
        } else { c0 = f32x16{}; c1 = f32x16{}; }
        qkt(p0, p1, (ldsc)kslot, qr, c0, c1, r32, hi);
        if (KIND == 1) {
            const int dist0 = ncache + tq - (64 * t + 4 * hi) + 63;
#pragma unroll
            for (int r = 0; r < 16; ++r) { const int i0 = dist0 - ((r & 3) + 8 * (r >> 2));
                const int a0 = min(max(i0, 0), NREL - 1), a1 = min(max(i0 - 32, 0), NREL - 1);
                p0[r] += tb[a0]; p1[r] += tb[a1]; }
        }
        if (t == nct) {
#pragma unroll
            for (int r = 0; r < 16; ++r) { const int kv = 4 * hi + (r & 3) + 8 * (r >> 2);
                const bool ok = (kv < 16) && (KIND == 1 || kv <= tq);
                if (!ok) p0[r] = -1e30f; p1[r] = -1e30f; }
        }
        softmax_pv(p0, p1, o, m_run, l_run, wsf, (ldsc)vslot, lane, r32, hi);
    }
    const float lt = halfsum(l_run);
    __syncthreads();
    LAS float* OP = (LAS float*)lds;
    LAS float* ML = (LAS float*)(lds + 32768);
    if (lane < 16) { ML[(wid * 16 + lane) * 2] = m_run; ML[(wid * 16 + lane) * 2 + 1] = lt; }
#pragma unroll
    for (int r = 0; r < 8; ++r) { const int q = crow(r, hi);
#pragma unroll
        for (int d0 = 0; d0 < 2; ++d0) OP[(wid * 16 + q) * 64 + d0 * 32 + r32] = o[d0][r]; }
    __syncthreads();
    { const int q = tid >> 5, d = (tid & 31) * 2;
      float M = -1e30f;
#pragma unroll
      for (int w = 0; w < 8; ++w) M = fmaxf(M, ML[(w * 16 + q) * 2]);
      float L = 0.f, a0 = 0.f, a1 = 0.f;
#pragma unroll
      for (int w = 0; w < 8; ++w) { const float f = fexp2(ML[(w * 16 + q) * 2] - M); L += ML[(w * 16 + q) * 2 + 1] * f;
          const f32x2 ov = *(LAS const f32x2*)(OP + (w * 16 + q) * 64 + d); a0 += ov[0] * f; a1 += ov[1] * f; }
      const float rl = 1.0f / L;
      const unsigned z = *(const unsigned*)(SZ + (nrow0 + q) * 512 + h * 64 + d);
      *(unsigned*)(X.G + (nrow0 + q) * 1024 + (KIND ? 0 : 512) + h * 64 + d) = cvtpk(a0 * rl * bflo(z), a1 * rl * bfhi(z)); }
    __syncthreads();
}
}

#ifndef REP_P0
#define REP_P0 1
#endif
#ifndef REP_P1
#define REP_P1 1
#endif
#ifndef REP_P2
#define REP_P2 1
#endif
#ifndef REP_P3A
#define REP_P3A 1
#endif
#ifndef REP_P3B
#define REP_P3B 1
#endif
#ifndef REP_P4
#define REP_P4 1
#endif
__global__ void __launch_bounds__(512, 2) fwd_kernel(Args args) {
    extern __shared__ __attribute__((aligned(16))) unsigned char lds_raw[];
    LAS unsigned char* lds = (LAS unsigned char*)lds_raw;
    const int G = gridDim.x; const int bx = blockIdx.x; const int vcu = (G % 8 == 0) ? (bx % 8) * (G / 8) + bx / 8 : bx;
    unsigned char* ws = args.ws; float* out = args.out;
    gu32* ctl = (gu32*)(ws + WS_CTL);
    const float* x_p = args.in[0]; const float* x_s = args.in[1];
    const float *cak = args.in[2], *cav = args.in[3], *cbk = args.in[4], *cbv = args.in[5], *cbl = args.in[6];
    const float *g_pre = args.in[7], *w_in = args.in[8], *b_f = args.in[9], *rel = args.in[10], *w_bra = args.in[11], *w_brb = args.in[12], *w_out = args.in[13], *g_post = args.in[14];
    float* Fp = (float*)(ws + WS_FP); float* LFp = (float*)(ws + WS_LFP); float* Fs = (float*)(ws + WS_FS); float* LFn = (float*)(ws + WS_LFN);
    bf16* WIN = (bf16*)(ws + WS_WIN); bf16* WBR = (bf16*)(ws + WS_WBR); bf16* WOUT = (bf16*)(ws + WS_WOUT);
    bf16* XN = (bf16*)(ws + WS_XN);
    bf16 *QA = (bf16*)(ws + WS_QA), *KA = (bf16*)(ws + WS_KA), *VA = (bf16*)(ws + WS_VA), *QB = (bf16*)(ws + WS_QB), *KB = (bf16*)(ws + WS_KB), *VB = (bf16*)(ws + WS_VB);
    bf16 *SZA = (bf16*)(ws + WS_SZA), *SZB = (bf16*)(ws + WS_SZB), *SMA = (bf16*)(ws + WS_SMA), *SMB = (bf16*)(ws + WS_SMB);
    bf16* MG = (bf16*)(ws + WS_MG); float* OUTF = (float*)(ws + WS_OUTF);

    for (int u = threadIdx.x; u < (LDS_BYTES - LDSCTL_OFF) / 4; u += 512) ((LAS unsigned*)(lds + LDSCTL_OFF))[u] = 0u;
    __syncthreads();
    volatile LAS unsigned* MISC = (volatile LAS unsigned*)(lds + MISC_OFF);
    XcdBarrier bar = xcd_barrier_post((unsigned*)(ctl + CW_BAR), MISC + 8);
    const int NGW = G * 8;

#pragma nounroll
    for (int rep = 0; rep < REP_P0; ++rep) {
        const int tid = fresh_tid(), lane = tid & 63; const int wave = __builtin_amdgcn_readfirstlane(tid >> 6); const int gw = vcu * 8 + wave;
        LAS float* wfT = (LAS float*)(lds + 73728);
        for (int k = tid; k < DM; k += 512) { const f32x4 a = *(const f32x4*)(w_in + (size_t)k * NIN + 4096), b = *(const f32x4*)(w_in + (size_t)k * NIN + 4100);
            wfT[0 * DM + k] = a[0]; wfT[1 * DM + k] = a[1]; wfT[2 * DM + k] = a[2]; wfT[3 * DM + k] = a[3];
            wfT[4 * DM + k] = b[0]; wfT[5 * DM + k] = b[1]; wfT[6 * DM + k] = b[2]; wfT[7 * DM + k] = b[3]; }
        __syncthreads();
        LAS float* scr = (LAS float*)(lds + wave * 8704);
        constexpr int I_IN = 16 * 192, I_BR = 8 * 32, I_OUT = 16 * 32, NITEMS = I_IN + 2 * I_BR + I_OUT;
        for (int it = gw; it < NITEMS; it += NGW) {
            int r = it;
            if (r < I_IN) { const int kb = r / 192, nb = r % 192, n0 = 32 * nb; p0_transpose_item(w_in, NIN, n0 + (n0 >= 4096 ? 8 : 0), WIN, DM, 0, n0, scr, 64 * kb, lane); continue; } r -= I_IN;
            if (r < I_BR) { const int kb = r / 32, nb = r % 32; p0_transpose_item(w_bra, DM, 32 * nb, WBR, DM, 0, 32 * nb, scr, 64 * kb, lane); continue; } r -= I_BR;
            if (r < I_BR) { const int kb = r / 32, nb = r % 32; p0_transpose_item(w_brb, DM, 32 * nb, WBR, DM, 512, 32 * nb, scr, 64 * kb, lane); continue; } r -= I_BR;
            { const int kb = r / 32, nb = r % 32; p0_transpose_item(w_out, DM, 32 * nb, WOUT, DM, 0, 32 * nb, scr, 64 * kb, lane); }
        }
        f32x4 gv[4];
#pragma unroll
        for (int j = 0; j < 4; ++j) gv[j] = *((const f32x4*)g_pre + lane + 64 * j);
        for (int m = gw; m < MTOT; m += NGW) {
            GAS unsigned long long* o8 = (GAS unsigned long long*)(XN + (size_t)m * DM) + lane;
            if (m >= MP + MS) {
#pragma unroll
                for (int j = 0; j < 4; ++j) o8[64 * j] = 0ull;
                continue; }
            const float* xrow = (m < MP) ? x_p + (size_t)m * DM : x_s + (size_t)(m - MP) * DM;
            f32x4 v[4]; float ss = 0.f;
#pragma unroll
            for (int j = 0; j < 4; ++j) { v[j] = *((const f32x4*)xrow + lane + 64 * j); ss += (v[j][0] * v[j][0] + v[j][1] * v[j][1]) + (v[j][2] * v[j][2] + v[j][3] * v[j][3]); }
            float dt[8];
#pragma unroll
            for (int hh = 0; hh < 8; ++hh) dt[hh] = 0.f;
#pragma unroll
            for (int j = 0; j < 4; ++j) { v[j] = v[j] * gv[j];
#pragma unroll
                for (int hh = 0; hh < 8; ++hh) { const f32x4 w = *(LAS const f32x4*)(wfT + hh * DM + 256 * j + 4 * lane);
                    dt[hh] += (v[j][0] * w[0] + v[j][1] * w[1]) + (v[j][2] * w[2] + v[j][3] * w[3]); } }
            ss = wave_sum(ss);
            const float rs = 1.0f / sqrtf(ss * (1.0f / DM) + EPS);
            {
                const bool u5 = (lane & 32) != 0, u4 = (lane & 16) != 0, u3 = (lane & 8) != 0;
#pragma unroll
                for (int i = 0; i < 4; ++i) { const float snd = u5 ? dt[i] : dt[i + 4], kp = u5 ? dt[i + 4] : dt[i]; dt[i] = kp + __shfl_xor(snd, 32); }
#pragma unroll
                for (int i = 0; i < 2; ++i) { const float snd = u4 ? dt[i] : dt[i + 2], kp = u4 ? dt[i + 2] : dt[i]; dt[i] = kp + __shfl_xor(snd, 16); }
                { const float snd = u3 ? dt[0] : dt[1], kp = u3 ? dt[1] : dt[0]; dt[0] = kp + __shfl_xor(snd, 8); }
                dt[0] += __shfl_xor(dt[0], 1); dt[0] += __shfl_xor(dt[0], 2); dt[0] += __shfl_xor(dt[0], 4);
            }
            if ((lane & 7) == 0) {
                const int hh = lane >> 3;
                const float val = dt[0] * rs + b_f[hh];
                const float lf = (val >= 0.f) ? -log1pf(expf(-val)) : (val - log1pf(expf(val)));
                if (m < MP) { out[O_BLP + (size_t)m * 8 + hh] = lf; LFp[(size_t)((m >> 14) * 8 + hh) * SEQ + (m & (SEQ - 1))] = lf; }
                else { const int ms = m - MP; out[O_BLS + (size_t)ms * 8 + hh] = lf; LFn[((ms >> 4) * 8 + hh) * 16 + (ms & 15)] = lf; }
            }
#pragma unroll
            for (int j = 0; j < 4; ++j) o8[64 * j] = (unsigned long long)cvtpk(v[j][0] * rs, v[j][1] * rs) | ((unsigned long long)cvtpk(v[j][2] * rs, v[j][3] * rs) << 32);
        }
        { const int gt = vcu * 512 + tid, NT = G * 512; constexpr int PER = 496 * 128;
          for (int i = gt; i < 2 * 8 * PER; i += NT) { const int ten = i / (8 * PER), r = i - ten * 8 * PER, bb = r / PER, off = r - bb * PER;
              const f32x4* src = (const f32x4*)(ten ? cav : cak) + (size_t)bb * 65536 + 2048 + off;
              f32x4* dst = (f32x4*)(out + (ten ? O_AVS : O_AKS)) + (size_t)bb * 65536 + off; *dst = *src; } }
    }
    xcd_barrier(bar);

    if (vcu < 80 && __builtin_amdgcn_readfirstlane(fresh_tid() >> 6) == 0) {
        const int lane = fresh_tid() & 63;
        if (vcu < 16) {
            const float* in = LFp + (size_t)vcu * SEQ + 256 * lane; float* o = Fp + (size_t)vcu * SEQ + 256 * lane;
            float tot = 0.f;
            for (int i = 0; i < 64; ++i) { const f32x4 a = *((const f32x4*)in + i); tot += (a[0] + a[1]) + (a[2] + a[3]); }
            float inc = tot;
#pragma unroll
            for (int ofs = 1; ofs < 64; ofs <<= 1) { const float t = __shfl_up(inc, ofs); if (lane >= ofs) inc += t; }
            float run = inc - tot;
            for (int i = 0; i < 64; ++i) { f32x4 a = *((const f32x4*)in + i); a[0] += run; a[1] += a[0]; a[2] += a[1]; a[3] += a[2]; run = a[3]; *((f32x4*)o + i) = a; }
        } else {
            const int sidx = vcu - 16, bs = sidx >> 3, hh = sidx & 7;
            const float* in = cbl + ((size_t)bs * PAST + 64 * lane) * 8 + hh; float* o = Fs + (size_t)sidx * FS_PITCH + 64 * lane;
            float tot = 0.f;
            for (int i = 0; i < 64; ++i) tot += in[i * 8];
            float inc = tot;
#pragma unroll
            for (int ofs = 1; ofs < 64; ofs <<= 1) { const float t = __shfl_up(inc, ofs); if (lane >= ofs) inc += t; }
            float run = inc - tot;
            for (int i = 0; i < 64; ++i) { run += in[i * 8]; o[i] = run; }
            const float last = __shfl(run, 63);
            if (lane == 0) { float r2 = last; float* on = Fs + (size_t)sidx * FS_PITCH + PAST;
                for (int i = 0; i < 16; ++i) { r2 += LFn[sidx * 16 + i]; on[i] = r2; }
                for (int i = 16; i < 64; ++i) on[i] = r2; }
        }
    }
#pragma nounroll
    for (int rep = 0; rep < REP_P1; ++rep) {
        if (rep) xcd_barrier(bar);
        pg8::Gemm g{XN, WIN, DM, DM / 64}; pg8::StaticOrder S; S.init(MTOT, NG, G, bx, 1);
        pg8::EpiInProj E{QA, KA, VA, SZA, QB, KB, VB, SZB, SMA, SMB, out, (unsigned*)(ctl + CW_KNORM)};
        pg8::gemm_phase<pg8::EpiInProj, pg8::StaticOrder>(lds, g, S, E);
    }
    xcd_barrier(bar);

#pragma nounroll
    for (int rep = 0; rep < REP_P2; ++rep) {
        if (rep) xcd_barrier(bar);
        att::Ctx X; X.lds = lds; X.QA = QA; X.KA = KA; X.VA = VA; X.QB = QB; X.KB = KB; X.VB = VB; X.SZA = SZA; X.SZB = SZB; X.G = XN;
        X.Fp = Fp; X.Fs = Fs; X.rel = rel; X.cak = cak; X.cav = cav; X.cbk = cbk; X.cbv = cbv; X.knorm = (const unsigned*)(ctl + CW_KNORM);
        constexpr int NU = 64 + 1024 + 1024 + 64;
        gu32* qctr = ctl + CW_QUEUE + rep * 64;
        volatile LAS unsigned* qw = (volatile LAS unsigned*)(lds + MISC_OFF) + 16;
        if (threadIdx.x == 0) qw[0] = __hip_atomic_fetch_add(qctr, 1u, RLX_AGENT);
        __syncthreads();
        for (;;) {
            const int u = (int)__builtin_amdgcn_readfirstlane(qw[0]);
            if (u >= NU) break;
            unsigned nxt = 0u;
            if (threadIdx.x == 0) nxt = __hip_atomic_fetch_add(qctr, 1u, RLX_AGENT);

            if (u < 64) att::sample_unit<0>(X, u >> 3, u & 7);
            else if (u < 64 + 2048) { const int kind = (u - 64) >> 10, idx = (u - 64) & 1023;
                const int hh = ((idx & 7) + (idx >> 8)) & 7, bb = (idx >> 3) & 1, qb = 63 - (idx >> 4);
                if (kind == 0) att::prompt_unit<0, 8>(X, bb, hh, qb); else att::prompt_unit<1, 8>(X, bb, hh, qb); }
            else { const int i2 = u - 64 - 2048; att::sample_unit<1>(X, i2 >> 3, i2 & 7); }
            if (threadIdx.x == 0) qw[0] = nxt;
            __syncthreads();
        }
    }
    xcd_barrier(bar);

#pragma nounroll
    for (int rep = 0; rep < REP_P3A; ++rep) {
        if (rep) xcd_barrier(bar);
        pg8::Gemm g{XN, WBR, DM, 8}; pg8::StaticOrder S; S.init(MTOT, DM, G, bx, 2);
        pg8::EpiMerge E{SMA, SMB, MG};
        pg8::gemm_phase<pg8::EpiMerge, pg8::StaticOrder>(lds, g, S, E);
    }
    xcd_barrier(bar);
#pragma nounroll
    for (int rep = 0; rep < REP_P3B; ++rep) {
        if (rep) xcd_barrier(bar);
        pg8::Gemm g{MG, WOUT, DM, DM / 64}; pg8::StaticOrder S; S.init(MTOT, DM, G, bx, 1);
        pg8::EpiF32 E{OUTF, DM};
        pg8::gemm_phase<pg8::EpiF32, pg8::StaticOrder>(lds, g, S, E);
    }
    xcd_barrier(bar);
#pragma nounroll
    for (int rep = 0; rep < REP_P4; ++rep) {
        const int tid = fresh_tid(), lane = tid & 63; const int wave = __builtin_amdgcn_readfirstlane(tid >> 6); const int gw = vcu * 8 + wave;
        f32x4 gv[4];
#pragma unroll
        for (int j = 0; j < 4; ++j) gv[j] = *((const f32x4*)g_post + lane + 64 * j);
        for (int m = gw; m < MP + MS; m += NGW) {
            const float* xrow = (m < MP) ? x_p + (size_t)m * DM : x_s + (size_t)(m - MP) * DM;
            float* yrow = (m < MP) ? out + O_YP + (size_t)m * DM : out + O_YS + (size_t)(m - MP) * DM;
            const float* orow = OUTF + (size_t)m * DM;
            f32x4 v[4], xv[4]; float ss = 0.f;
#pragma unroll
            for (int j = 0; j < 4; ++j) { v[j] = *((const f32x4*)orow + lane + 64 * j); xv[j] = *((const f32x4*)xrow + lane + 64 * j);
                ss += (v[j][0] * v[j][0] + v[j][1] * v[j][1]) + (v[j][2] * v[j][2] + v[j][3] * v[j][3]); }
            ss = wave_sum(ss);
            const float rs = 1.0f / sqrtf(ss * (1.0f / DM) + EPS);
#pragma unroll
            for (int j = 0; j < 4; ++j) *((f32x4*)yrow + lane + 64 * j) = xv[j] + v[j] * rs * gv[j];
        }
    }
}

extern "C" void kernel_launch(void* const* d_in, const int* in_sizes, int n_in, void* d_out, int out_size, void* d_ws, size_t ws_size, hipStream_t stream) {
    static int grid = 0;
    if (grid == 0) {
        if (n_in != 15 || in_sizes[0] != MP * DM || (size_t)out_size != O_END || ws_size < WS_END) {
            fprintf(stderr, "kernel_launch: unexpected shapes: n_in %d in0 %d out %d ws %zu (need %zu)\n", n_in, n_in > 0 ? in_sizes[0] : -1, out_size, ws_size, (size_t)WS_END); grid = -1; return; }
        int dev = 0, cus = 0, per_cu = 0;
        if (hipGetDevice(&dev) != hipSuccess || hipDeviceGetAttribute(&cus, hipDeviceAttributeMultiprocessorCount, dev) != hipSuccess) { fprintf(stderr, "kernel_launch: device query failed\n"); grid = -1; return; }
        if (hipFuncSetAttribute((const void*)fwd_kernel, hipFuncAttributeMaxDynamicSharedMemorySize, LDS_BYTES) != hipSuccess) { fprintf(stderr, "kernel_launch: hipFuncSetAttribute failed\n"); grid = -1; return; }
        if (hipOccupancyMaxActiveBlocksPerMultiprocessor(&per_cu, (const void*)fwd_kernel, 512, LDS_BYTES) != hipSuccess || per_cu < 1) {
            fprintf(stderr, "kernel_launch: occupancy query reports %d blocks per CU\n", per_cu); (void)hipGetLastError(); grid = -1; return; }
        grid = cus;
    }
    if (grid < 0) return;
    if (hipMemsetAsync((char*)d_ws + WS_CTL, 0, CTL_ZERO_BYTES, stream) != hipSuccess) { fprintf(stderr, "kernel_launch: memset failed\n"); return; }
    Args a{};
    for (int i = 0; i < 15; ++i) a.in[i] = (const float*)d_in[i];
    a.out = (float*)d_out; a.ws = (unsigned char*)d_ws;
    hipLaunchKernelGGL(fwd_kernel, dim3(grid), dim3(512), LDS_BYTES, stream, a);
    const hipError_t le = hipPeekAtLastError();
    if (le != hipSuccess) fprintf(stderr, "kernel_launch: launch failed: %s\n", hipGetErrorName(le));
}
```

```cpp
#include <hip/hip_runtime.h>
#include <hip/hip_bf16.h>
#include <cstdio>
#include <cstdint>

constexpr int DM = 1024, NB = 2, SEQ = 16384, DECB = 8, DECS = 16, PAST = 4096, AKEEP = 512;
constexpr int NH = 8, HD = 64, WA = 512;
constexpr int NIN = 6152;
constexpr int NG = 6144;
constexpr int MP = NB * SEQ;
constexpr int MS = DECB * DECS;
constexpr int MTOT = MP + 256;
constexpr int NREL = 192;
constexpr float EPS = 1e-6f;
constexpr float L2E = 1.4426950408889634f;
constexpr float C2 = 0.125f * L2E;
constexpr int FS_PITCH = 4160;

constexpr size_t O_YP = 0, O_YS = 33554432, O_AKP = 33685504, O_AVP = 34209792, O_BKP = 34734080, O_BVP = 51511296, O_BLP = 68288512,
                 O_AKS = 68550656, O_AVS = 70647808, O_BKS = 72744960, O_BVS = 72810496, O_BLS = 72876032, O_END = 72877056;

constexpr size_t MiB = 1u << 20;
constexpr size_t WS_CTL = 0, CTL_ZERO_BYTES = 1 * MiB;
constexpr size_t WS_FP = 1 * MiB;
constexpr size_t WS_LFP = 2 * MiB;
constexpr size_t WS_FS = 3 * MiB;
constexpr size_t WS_LFN = 5 * MiB;
constexpr size_t WS_WIN = 6 * MiB;
constexpr size_t WS_WBR = 18 * MiB;
constexpr size_t WS_WOUT = 20 * MiB;
constexpr size_t WS_XN = 24 * MiB;
constexpr size_t ACT_BYTES = (size_t)MTOT * 512 * 2;
constexpr size_t WS_QA = 89 * MiB, WS_KA = 122 * MiB, WS_VA = 155 * MiB, WS_QB = 188 * MiB, WS_KB = 221 * MiB, WS_VB = 254 * MiB;
constexpr size_t WS_MG = 89 * MiB;
constexpr size_t WS_OUTF = 155 * MiB;
constexpr size_t WS_SZA = 287 * MiB, WS_SZB = 320 * MiB;
constexpr size_t WS_SMA = 353 * MiB, WS_SMB = 418 * MiB;
constexpr size_t WS_END = 483 * MiB;
static_assert(ACT_BYTES <= 33 * MiB && WS_XN + 2 * ACT_BYTES <= WS_QA && WS_OUTF + (size_t)MTOT * 1024 * 4 <= WS_SZA && WS_MG + 2 * ACT_BYTES <= WS_OUTF, "ws map");

constexpr int CW_KNORM = 64;
constexpr int CW_QUEUE = 1024;
constexpr int CW_BAR = 4096;

constexpr int RING_BYTES = 131072;
constexpr int LDSCTL_OFF = RING_BYTES, MISC_OFF = LDSCTL_OFF + 320;
constexpr int TB_OFF = LDSCTL_OFF + 1024;
constexpr int WSF_OFF = LDSCTL_OFF + 2048;
constexpr int QMX_OFF = LDSCTL_OFF + 4096;
constexpr int LDS_BYTES = 147456;

#define GAS __attribute__((address_space(1)))
#define LAS __attribute__((address_space(3)))
typedef unsigned short bf16;
typedef unsigned v4u __attribute__((ext_vector_type(4)));
typedef unsigned v2u __attribute__((ext_vector_type(2)));
typedef float f32x4 __attribute__((ext_vector_type(4)));
typedef float f32x2 __attribute__((ext_vector_type(2)));
typedef float f32x16 __attribute__((ext_vector_type(16)));
typedef short bf16x8 __attribute__((ext_vector_type(8)));
typedef short s16x4 __attribute__((ext_vector_type(4)));
typedef short v4i16_t __attribute__((ext_vector_type(4)));
typedef __bf16 bf16x2_t __attribute__((ext_vector_type(2)));
typedef GAS unsigned gu32;
#define RLX_AGENT __ATOMIC_RELAXED, __HIP_MEMORY_SCOPE_AGENT

__device__ __forceinline__ unsigned cvtpk(float lo, float hi) { f32x2 v = {lo, hi}; bf16x2_t b = __builtin_convertvector(v, bf16x2_t); return __builtin_bit_cast(unsigned, b); }
__device__ __forceinline__ int fresh_tid() { int t = threadIdx.x; asm volatile("" : "+v"(t)); return t; }
__device__ __forceinline__ float bflo(unsigned u) { return __uint_as_float(u << 16); }
__device__ __forceinline__ float bfhi(unsigned u) { return __uint_as_float(u & 0xffff0000u); }
__device__ __forceinline__ float fexp2(float x) { return __builtin_amdgcn_exp2f(x); }
__device__ __forceinline__ float sigmoidf_(float v) { return __builtin_amdgcn_rcpf(1.0f + fexp2(-v * L2E)); }

namespace pg8 {
#define PG8_LAS __attribute__((address_space(3)))
typedef unsigned short bf16_t;
typedef unsigned u32x4 __attribute__((ext_vector_type(4)));
constexpr int BM = 256, BK = 64, HALF = 128, HTB = HALF * BK * 2, STAGE_BYTES = 8 * HTB, NXCD = 8, WGM = 8;

__host__ __device__ __forceinline__ int lds_byte(int r, int c) { const int st = (r >> 4) * 2 + (c >> 5), rr = r & 15, cc = c & 31, ob = rr * 64 + cc * 2; return st * 1024 + (ob ^ (((ob >> 9) & 1) << 5)); }
__host__ __device__ __forceinline__ void stage_rc(int b, int& R, int& C) { const int st = b / 1024, sb = b % 1024, swz = sb ^ (((sb >> 9) & 1) << 5); R = (st >> 1) * 16 + swz / 64; C = (st & 1) * 32 + (swz % 64) / 2; }
__host__ __device__ __forceinline__ int perm32(int rho) { const int n = rho >> 4, i = rho & 15; return 8 * (i >> 2) + 4 * n + (i & 3); }

struct Unit { int pm, pn, kh; };
struct Gemm { const bf16_t* A; const bf16_t* Bt; int ldk; int nt; };

struct StaticOrder {
    int nM, nN, nwg, G, c, nkh;
    __device__ void init(int M, int N, int G_, int c_, int nkh_) { nM = M / BM; nN = N / BM; nwg = nM * nN; G = G_; c = c_; nkh = nkh_; }
    __device__ bool next(int i, Unit& u) const {
        const int ti = i / nkh; u.kh = i - ti * nkh;
        const long L = (long)ti * G + c; if (L >= nwg) return false;
        int wgid = (int)L; { const int q = nwg / NXCD, r = nwg % NXCD, xcd = wgid % NXCD, off = wgid / NXCD; wgid = (xcd < r ? xcd * (q + 1) : r * (q + 1) + (xcd - r) * q) + off; }
        const int nig = WGM * nN, gid = wgid / nig, fm = gid * WGM, gsz = (nM - fm) < WGM ? (nM - fm) : WGM;
        u.pm = fm + ((wgid % nig) % gsz); u.pn = (wgid % nig) / gsz; return true;
    }
};


struct EpiInProj {
    static constexpr bool PERM = true;
    bf16_t *QA, *KA, *VA, *SZA, *QB, *KB, *VB, *SZB, *SMA, *SMB;
    float* out;
    unsigned* knorm;
    __device__ __forceinline__ bool keep(const Unit&) const { return false; }
    __device__ __forceinline__ void operator()(f32x4 (&acc)[2][2][4][2], const Unit& u, int wr, int wc, int fr, int fq) const {
        const int pn = u.pn, pm = u.pm;
        bf16_t* dst; int ldd, dcol, actk; float* f32p = nullptr; int fmode = 0, nvalid = 256; bool dnorm = false; int noff = 0;
        const bool sample = (pm == 128);
        if (pn < 16) {
            const int seg = pn >> 1; dcol = (pn & 1) * 256; ldd = 512;
            if (seg == 0) { dst = QA; actk = 1; }
            else if (seg == 1) { dst = KA; actk = 0; }
            else if (seg == 2) { dst = VA; actk = 0; }
            else if (seg == 3) { dst = SZA; actk = 2; }
            else if (seg == 4) { dst = QB; actk = 1; }
            else if (seg == 5) { dst = KB; actk = 0; }
            else if (seg == 6) { dst = VB; actk = 0; }
            else { dst = SZB; actk = 2; }
            if (seg == 1 || seg == 2) {
                if (!sample) { const int bt = pm & 63; if (bt >= 62) { f32p = out + (seg == 1 ? O_AKP : O_AVP) + ((size_t)((pm >> 6) * 512 + (bt - 62) * 256)) * 512 + dcol; fmode = 1; } }
                else { f32p = out + (seg == 1 ? O_AKS : O_AVS) + dcol; fmode = 2; nvalid = 128; }
            } else if (seg == 4) { if (!sample) { dnorm = true; noff = 32; }
            } else if (seg == 5 || seg == 6) {
                if (!sample) { f32p = out + (seg == 5 ? O_BKP : O_BVP) + (size_t)pm * 256 * 512 + dcol; fmode = 1; dnorm = (seg == 5); }
                else { f32p = out + (seg == 5 ? O_BKS : O_BVS) + dcol; fmode = 1; nvalid = 128; }
            }
        } else { ldd = 1024; actk = 3; if (pn < 20) { dst = SMA; dcol = (pn - 16) * 256; } else { dst = SMB; dcol = (pn - 20) * 256; } }
        const int rl0 = wr * 64 + fr, cl = wc * 32 + 8 * fq;
        if (dnorm) {
#pragma unroll
            for (int bj = 0; bj < 2; ++bj) { float mx = 0.f;
#pragma unroll
                for (int ai = 0; ai < 2; ++ai)
#pragma unroll
                    for (int m = 0; m < 4; ++m) { const f32x4 a = acc[ai][bj][m][0], b = acc[ai][bj][m][1];
                        float s = (a[0] * a[0] + a[1] * a[1]) + (a[2] * a[2] + a[3] * a[3]) + (b[0] * b[0] + b[1] * b[1]) + (b[2] * b[2] + b[3] * b[3]);
                        s += __shfl_xor(s, 16); s += __shfl_xor(s, 32); mx = fmaxf(mx, s); }
                mx = fmaxf(mx, __shfl_xor(mx, 1)); mx = fmaxf(mx, __shfl_xor(mx, 2)); mx = fmaxf(mx, __shfl_xor(mx, 4)); mx = fmaxf(mx, __shfl_xor(mx, 8));
                if (fr == 0 && fq == 0) { const int head = (pn & 1) * 4 + bj * 2 + (wc >> 1);
                    __hip_atomic_fetch_max(knorm + noff + (((pm >> 6) * 8 + head) * 2 + (wc & 1)), __float_as_uint(mx), __ATOMIC_RELAXED, __HIP_MEMORY_SCOPE_AGENT); }
            }
        }
#pragma unroll
        for (int ai = 0; ai < 2; ++ai)
#pragma unroll
            for (int m = 0; m < 4; ++m) { const int rl = rl0 + ai * HALF + m * 16; const size_t grow = (size_t)pm * BM + rl;
#pragma unroll
                for (int bj = 0; bj < 2; ++bj) { f32x4 v0 = acc[ai][bj][m][0], v1 = acc[ai][bj][m][1];
                    if (f32p != nullptr && rl < nvalid) { const size_t ro = (fmode == 1) ? (size_t)rl * 512 : ((size_t)((rl >> 4) * 512 + 496 + (rl & 15))) * 512;
                        *(f32x4*)(f32p + ro + cl + bj * HALF) = v0; *(f32x4*)(f32p + ro + cl + bj * HALF + 4) = v1; }
                    if (actk == 1) { v0 = v0 * C2; v1 = v1 * C2; }
                    else if (actk == 2) {
#pragma unroll
                        for (int e = 0; e < 4; ++e) { v0[e] = v0[e] * sigmoidf_(v0[e]); v1[e] = v1[e] * sigmoidf_(v1[e]); } }
                    else if (actk == 3) {
#pragma unroll
                        for (int e = 0; e < 4; ++e) { v0[e] = sigmoidf_(v0[e]); v1[e] = sigmoidf_(v1[e]); } }
                    u32x4 w; w.x = cvtpk(v0[0], v0[1]); w.y = cvtpk(v0[2], v0[3]); w.z = cvtpk(v1[0], v1[1]); w.w = cvtpk(v1[2], v1[3]);
                    *(u32x4*)(dst + grow * ldd + dcol + cl + bj * HALF) = w; } }
    }
};
struct EpiMerge {
    static constexpr bool PERM = true;
    const bf16_t *SMA, *SMB; bf16_t* MG;
    __device__ __forceinline__ bool keep(const Unit& u) const { return u.kh == 0; }
    __device__ __forceinline__ void operator()(f32x4 (&acc)[2][2][4][2], const Unit& u, int wr, int wc, int fr, int fq) const {
        const int rl0 = wr * 64 + fr, cl = wc * 32 + 8 * fq;
#pragma unroll
        for (int ai = 0; ai < 2; ++ai)
#pragma unroll
            for (int m = 0; m < 4; ++m) { const size_t grow = (size_t)u.pm * BM + rl0 + ai * HALF + m * 16;
#pragma unroll
                for (int bj = 0; bj < 2; ++bj) { const size_t off = grow * 1024 + u.pn * BM + cl + bj * HALF;
                    const u32x4 sb = *(const u32x4*)(SMB + off);
                    float g[8] = {bflo(sb.x), bfhi(sb.x), bflo(sb.y), bfhi(sb.y), bflo(sb.z), bfhi(sb.z), bflo(sb.w), bfhi(sb.w)};
                    if (u.kh == 0) { const u32x4 sa = *(const u32x4*)(SMA + off);
                        const float a[8] = {bflo(sa.x), bfhi(sa.x), bflo(sa.y), bfhi(sa.y), bflo(sa.z), bfhi(sa.z), bflo(sa.w), bfhi(sa.w)};
#pragma unroll
                        for (int e = 0; e < 8; ++e) g[e] = a[e] * __builtin_amdgcn_rcpf(g[e]);
#pragma unroll
                        for (int e = 0; e < 4; ++e) { acc[ai][bj][m][0][e] *= g[e]; acc[ai][bj][m][1][e] *= g[4 + e]; }
                    } else { f32x4 v0 = acc[ai][bj][m][0], v1 = acc[ai][bj][m][1];
#pragma unroll
                        for (int e = 0; e < 4; ++e) { v0[e] *= g[e]; v1[e] *= g[4 + e]; }
                        u32x4 w; w.x = cvtpk(v0[0], v0[1]); w.y = cvtpk(v0[2], v0[3]); w.z = cvtpk(v1[0], v1[1]); w.w = cvtpk(v1[2], v1[3]);
                        *(u32x4*)(MG + off) = w; } } }
    }
};
struct EpiF32 {
    static constexpr bool PERM = false;
    float* C; int ldc;
    __device__ __forceinline__ bool keep(const Unit&) const { return false; }
    __device__ __forceinline__ void operator()(f32x4 (&acc)[2][2][4][2], const Unit& u, int wr, int wc, int fr, int fq) const {
        const int row0 = u.pm * BM + wr * 64 + fr, col0 = u.pn * BM + wc * 32 + 4 * fq;
#pragma unroll
        for (int ai = 0; ai < 2; ++ai)
#pragma unroll
            for (int m = 0; m < 4; ++m) { float* rowp = C + (size_t)(row0 + ai * HALF + m * 16) * ldc + col0;
#pragma unroll
                for (int bj = 0; bj < 2; ++bj)
#pragma unroll
                    for (int n = 0; n < 2; ++n) *(f32x4*)(rowp + bj * HALF + n * 16) = acc[ai][bj][m][n]; }
    }
};

template <class Epi, class Sched>
__device__ __forceinline__ void gemm_phase(PG8_LAS unsigned char* lds, const Gemm g, const Sched& S, const Epi& E) {
    const int tid = fresh_tid(), wid = __builtin_amdgcn_readfirstlane(tid >> 6), lane = tid & 63, wr = wid >> 2, wc = wid & 3, fr = lane & 15, fq = lane >> 4;
    const int K = g.ldk, nt = g.nt;
    unsigned voffA[2], voffB[2];
#pragma unroll
    for (int i = 0; i < 2; ++i) { int R, C; stage_rc(tid * 16 + i * 8192, R, C); const int Rb = Epi::PERM ? ((R & ~31) + perm32(R & 31)) : R;
        voffA[i] = (unsigned)(R * K + C) * 2u; voffB[i] = (unsigned)(Rb * K + C) * 2u; }
    const size_t kstep = (size_t)(BK * 2);
    const size_t hstep = (size_t)HALF * K * 2;
    const size_t tstep = 2 * hstep;
    const size_t khb = (size_t)nt * BK * 2;
    const unsigned ldsw = (unsigned)wid * 1024u;
    const int aoff = lds_byte(wr * 64 + fr, fq * 8), boff = lds_byte(wc * 32 + fr, fq * 8);
#define PG8_SA(b, h) (((b) * 2 + (h)) * HTB)
#define PG8_SB(b, h) ((4 + (b) * 2 + (h)) * HTB)
#define PG8_STAGE(bufoff, gbase, voff) do { _Pragma("unroll") for (int _i = 0; _i < 2; ++_i) \
        __builtin_amdgcn_global_load_lds((const unsigned*)((const char*)(gbase) + (voff)[_i]), (PG8_LAS unsigned*)(lds + (bufoff) + ldsw + _i * 8192), 16, 0, 0); } while (0)
#define PG8_LDA(dst, b, h) do { _Pragma("unroll") for (int m = 0; m < 4; ++m) _Pragma("unroll") for (int k = 0; k < 2; ++k) dst[m][k] = *(const PG8_LAS bf16x8*)(lds + PG8_SA(b, h) + aoff + m * 2048 + k * 1024); } while (0)
#define PG8_LDB(dst, b, h) do { _Pragma("unroll") for (int n = 0; n < 2; ++n) _Pragma("unroll") for (int k = 0; k < 2; ++k) dst[n][k] = *(const PG8_LAS bf16x8*)(lds + PG8_SB(b, h) + boff + n * 2048 + k * 1024); } while (0)
#define PG8_MMA(ai, bj, At, Bt) do { __builtin_amdgcn_s_setprio(1); _Pragma("unroll") for (int m = 0; m < 4; ++m) _Pragma("unroll") for (int n = 0; n < 2; ++n) _Pragma("unroll") for (int k = 0; k < 2; ++k) \
        acc[ai][bj][m][n] = __builtin_amdgcn_mfma_f32_16x16x32_bf16(Bt[n][k], At[m][k], acc[ai][bj][m][n], 0, 0, 0); __builtin_amdgcn_s_setprio(0); } while (0)
#define PG8_WAIT_V(n) asm volatile("s_waitcnt vmcnt(" #n ")" ::: "memory")
#define PG8_WAIT_L(n) asm volatile("s_waitcnt lgkmcnt(" #n ")" ::: "memory")
#define PG8_BAR __builtin_amdgcn_s_barrier()
#define PG8_SCHED __builtin_amdgcn_sched_barrier(0)
    Unit cur, nxt; int ui = 0;
    if (!S.next(0, cur)) return;
    f32x4 acc[2][2][4][2];
#pragma unroll
    for (int a = 0; a < 2; ++a)
#pragma unroll
        for (int b = 0; b < 2; ++b)
#pragma unroll
            for (int m = 0; m < 4; ++m)
#pragma unroll
                for (int n = 0; n < 2; ++n) acc[a][b][m][n] = (f32x4){0.f, 0.f, 0.f, 0.f};
    bf16x8 At[4][2], B0[2][2], B1[2][2];
    const char* cA = (const char*)g.A + (size_t)cur.pm * tstep + (size_t)cur.kh * khb; const char* cB = (const char*)g.Bt + (size_t)cur.pn * tstep + (size_t)cur.kh * khb;
    PG8_STAGE(PG8_SB(0, 0), cB, voffB); PG8_STAGE(PG8_SB(0, 1), cB + hstep, voffB); PG8_STAGE(PG8_SA(0, 0), cA, voffA); PG8_STAGE(PG8_SA(0, 1), cA + hstep, voffA);
    if (wr == 1) PG8_BAR;
    PG8_WAIT_V(2); PG8_BAR;
    PG8_STAGE(PG8_SB(1, 0), cB + kstep, voffB); PG8_STAGE(PG8_SA(1, 0), cA + kstep, voffA); PG8_STAGE(PG8_SB(1, 1), cB + hstep + kstep, voffB);
    PG8_WAIT_V(6); PG8_BAR;
    for (;;) {
        const bool has_next = S.next(ui + 1, nxt);
        const char* nA = has_next ? (const char*)g.A + (size_t)nxt.pm * tstep + (size_t)nxt.kh * khb : cA; const char* nB = has_next ? (const char*)g.Bt + (size_t)nxt.pn * tstep + (size_t)nxt.kh * khb : cB;
        for (int t = 0; t < nt; t += 2) {
            const bool last = (t == nt - 2);
            const char* a1 = cA + (size_t)(t + 1) * kstep;
            const char* a2 = last ? nA : cA + (size_t)(t + 2) * kstep; const char* b2 = last ? nB : cB + (size_t)(t + 2) * kstep;
            const char* a3 = a2 + kstep; const char* b3 = b2 + kstep;
            PG8_LDB(B0, 0, 0); PG8_LDB(B1, 0, 1); PG8_SCHED; PG8_LDA(At, 0, 0); PG8_STAGE(PG8_SA(1, 1), a1 + hstep, voffA);
            PG8_WAIT_V(8); PG8_WAIT_L(0); PG8_BAR; PG8_MMA(0, 0, At, B0); PG8_MMA(0, 1, At, B1); PG8_BAR; PG8_SCHED;
            PG8_LDA(At, 0, 1); PG8_STAGE(PG8_SB(0, 0), b2, voffB); PG8_STAGE(PG8_SB(0, 1), b2 + hstep, voffB); PG8_STAGE(PG8_SA(0, 0), a2, voffA);
            PG8_WAIT_V(8); PG8_WAIT_L(0); PG8_BAR; PG8_MMA(1, 0, At, B0); PG8_MMA(1, 1, At, B1); PG8_BAR; PG8_SCHED;
            PG8_LDB(B0, 1, 0); PG8_LDB(B1, 1, 1); PG8_SCHED; PG8_LDA(At, 1, 0); PG8_STAGE(PG8_SA(0, 1), a2 + hstep, voffA);
            PG8_WAIT_V(8); PG8_WAIT_L(0); PG8_BAR; PG8_MMA(0, 0, At, B0); PG8_MMA(0, 1, At, B1); PG8_BAR; PG8_SCHED;
            PG8_LDA(At, 1, 1); PG8_STAGE(PG8_SB(1, 0), b3, voffB); PG8_STAGE(PG8_SB(1, 1), b3 + hstep, voffB); PG8_STAGE(PG8_SA(1, 0), a3, voffA);
            PG8_WAIT_V(8); PG8_WAIT_L(0); PG8_BAR; PG8_MMA(1, 0, At, B0); PG8_MMA(1, 1, At, B1); PG8_BAR; PG8_SCHED;
        }
        if (wr == 0) PG8_BAR;
        E(acc, cur, wr, wc, fr, fq);
        if (!has_next) break;
        if (!E.keep(cur)) {
#pragma unroll
            for (int a = 0; a < 2; ++a)
#pragma unroll
                for (int b = 0; b < 2; ++b)
#pragma unroll
                    for (int m = 0; m < 4; ++m)
#pragma unroll
                        for (int n = 0; n < 2; ++n) acc[a][b][m][n] = (f32x4){0.f, 0.f, 0.f, 0.f};
        }
        cur = nxt; cA = nA; cB = nB; ++ui;
        if (wr == 1) PG8_BAR;
    }
    PG8_WAIT_V(0);
    PG8_BAR;
#undef PG8_SA
#undef PG8_SB
#undef PG8_STAGE
#undef PG8_LDA
#undef PG8_LDB
#undef PG8_MMA
#undef PG8_WAIT_V
#undef PG8_WAIT_L
#undef PG8_BAR
#undef PG8_SCHED
}
}

#define XB_TMO      128
#define XB_XCNT(j)  (256  + 64 * (j))
#define XB_XSUB(j)  (1280 + 64 * (j))
#define XB_XGEN(j)  (2304 + 64 * (j))
#define XB_TOP      3328
#define XB_TOPGEN   3392
#define XCD_BAR_WORDS 3456
#define XB_SPIN_CAP (1u << 18)
__device__ __forceinline__ unsigned xb_ld(unsigned* p)              { return __hip_atomic_load(p, __ATOMIC_RELAXED, __HIP_MEMORY_SCOPE_AGENT); }
__device__ __forceinline__ unsigned xb_add(unsigned* p, unsigned v) { return __hip_atomic_fetch_add(p, v, __ATOMIC_RELAXED, __HIP_MEMORY_SCOPE_AGENT); }
__device__ __forceinline__ unsigned xb_xcc_id() { return (unsigned)__builtin_amdgcn_s_getreg((3 << 11) | 20) & 0xFu; }
#define XB_SPIN(cond, bar) do { unsigned _sp = 0; while (cond) { __builtin_amdgcn_s_sleep(1); \
    if ((++_sp & 255u) == 0u) { if (xb_ld(&(bar)[XB_TMO])) break; if (_sp > XB_SPIN_CAP) { atomicAdd(&(bar)[XB_TMO], 1u); break; } } } } while (0)
struct XcdBarrier { unsigned* bar; unsigned x; volatile LAS unsigned* st; };
__device__ __forceinline__ XcdBarrier xcd_barrier_post(unsigned* bar, volatile LAS unsigned* st) {
    XcdBarrier b; b.bar = bar; b.x = xb_xcc_id(); b.st = st;
    if (threadIdx.x == 0) (void)xb_add(&bar[XB_XCNT(b.x)], 1u);
    return b;
}
__device__ __forceinline__ void xcd_barrier_complete(unsigned* bar, unsigned x, unsigned& nloc, unsigned& nx) {
    const unsigned G = gridDim.x * gridDim.y * gridDim.z;
    unsigned sum, cnt, mine, sp = 0u;
    for (;;) {
        sum = 0u; cnt = 0u; mine = 0u;
#pragma unroll
        for (unsigned j = 0; j < 16; ++j) { const unsigned c = xb_ld(&bar[XB_XCNT(j)]); sum += c; cnt += (c > 0u) ? 1u : 0u; mine = (j == x) ? c : mine; }
        if (sum == G) break;
        __builtin_amdgcn_s_sleep(1);
        if ((++sp & 255u) == 0u) { if (xb_ld(&bar[XB_TMO])) break; if (sp > XB_SPIN_CAP) { atomicAdd(&bar[XB_TMO], 1u); break; } }
    }
    nloc = mine > 0u ? mine : 1u; nx = cnt > 0u ? cnt : 1u;
}
__device__ __forceinline__ void xcd_barrier(const XcdBarrier& b) {
    asm volatile("s_waitcnt vmcnt(0)" ::: "memory");
    __syncthreads();
    if (threadIdx.x == 0) {
        unsigned* bar = b.bar;
        __builtin_amdgcn_s_waitcnt(0);
        unsigned nloc = b.st[0], nx = b.st[1];
        if (nloc == 0u) { xcd_barrier_complete(bar, b.x, nloc, nx); b.st[0] = nloc; b.st[1] = nx; }
        const unsigned old = xb_add(&bar[XB_XSUB(b.x)], 1u);
        const unsigned gen = old / nloc;
        if (old + 1u == (gen + 1u) * nloc) {
            __builtin_amdgcn_fence(__ATOMIC_RELEASE, "agent");
            asm volatile("s_waitcnt vmcnt(0)" ::: "memory");
            const unsigned og = xb_add(&bar[XB_TOP], 1u);
            const unsigned tg = og / nx;
            if (og + 1u == (tg + 1u) * nx) xb_add(&bar[XB_TOPGEN], 1u);
            else XB_SPIN(xb_ld(&bar[XB_TOPGEN]) == tg, bar);
            __builtin_amdgcn_fence(__ATOMIC_ACQUIRE, "agent");
            xb_add(&bar[XB_XGEN(b.x)], 1u);
            asm volatile("s_waitcnt vmcnt(0)" ::: "memory");
        } else {
            XB_SPIN(xb_ld(&bar[XB_XGEN(b.x)]) == gen, bar);
            __builtin_amdgcn_fence(__ATOMIC_ACQUIRE, "agent");
            asm volatile("s_waitcnt vmcnt(0)" ::: "memory");
        }
    }
    __syncthreads();
}

struct Args { const float* in[15]; float* out; unsigned char* ws; };

__device__ __forceinline__ float wave_sum(float v) {
#pragma unroll
    for (int o = 1; o < 64; o <<= 1) v += __shfl_xor(v, o);
    return v;
}
__device__ __forceinline__ float wave_max(float v) {
#pragma unroll
    for (int o = 1; o < 64; o <<= 1) v = fmaxf(v, __shfl_xor(v, o));
    return v;
}

__device__ __forceinline__ void p0_transpose_item(const float* W, int ldw, int csrc, bf16* WT, int ldt, int kdst, int nrow0, LAS float* scr, int k0, int lane) {
#pragma unroll 8
    for (int i = 0; i < 32; ++i) { const int kk = 2 * i + (lane >> 5); scr[kk * 33 + (lane & 31)] = W[(size_t)(k0 + kk) * ldw + csrc + (lane & 31)]; }
    asm volatile("s_waitcnt lgkmcnt(0)" ::: "memory");
    const int c = lane & 7;
#pragma unroll
    for (int j = 0; j < 4; ++j) { const int n = (lane >> 3) + 8 * j; const LAS float* s = scr + (8 * c) * 33 + n;
        v4u o; o.x = cvtpk(s[0 * 33], s[1 * 33]); o.y = cvtpk(s[2 * 33], s[3 * 33]); o.z = cvtpk(s[4 * 33], s[5 * 33]); o.w = cvtpk(s[6 * 33], s[7 * 33]);
        *(GAS v4u*)(WT + (size_t)(nrow0 + n) * ldt + kdst + k0 + 8 * c) = o; }
    asm volatile("s_waitcnt lgkmcnt(0)" ::: "memory");
}

namespace att {
typedef LAS const unsigned char* ldsc;
__device__ __forceinline__ int crow(int r, int hi) { return (r & 3) + 8 * (r >> 2) + 4 * hi; }
#define MFMA32(a, b, c) __builtin_amdgcn_mfma_f32_32x32x16_bf16(a, b, c, 0, 0, 0)
__device__ __forceinline__ s16x4 vtr(ldsc p) { return __builtin_bit_cast(s16x4, __builtin_amdgcn_ds_read_tr16_b64_v4i16((LAS v4i16_t*)p)); }

__device__ __forceinline__ void qkt(f32x16& p0, f32x16& p1, ldsc Kslot, const bf16x8* qr, const f32x16& c0, const f32x16& c1, int r32, int hi) {
    ldsc kb = Kslot + hi * 1024 + r32 * 16;
#pragma unroll
    for (int d0 = 0; d0 < 4; ++d0) {
        const bf16x8 b0 = *(LAS const bf16x8*)(kb + d0 * 2048);
        const bf16x8 b1 = *(LAS const bf16x8*)(kb + d0 * 2048 + 512);
        if (d0 == 0) { p0 = MFMA32(b0, qr[0], c0); p1 = MFMA32(b1, qr[0], c1); }
        else { p0 = MFMA32(b0, qr[d0], p0); p1 = MFMA32(b1, qr[d0], p1); } }
}
__device__ __forceinline__ float rowmax(const f32x16& p0, const f32x16& p1) {
    float a = fmaxf(p0[0], p1[0]);
#pragma unroll
    for (int r = 1; r < 16; ++r) a = fmaxf(a, fmaxf(p0[r], p1[r]));
    auto rr = __builtin_amdgcn_permlane32_swap(__float_as_uint(a), __float_as_uint(a), false, false);
    return fmaxf(__uint_as_float(rr[0]), __uint_as_float(rr[1]));
}
__device__ __forceinline__ float halfsum(float a) {
    auto rr = __builtin_amdgcn_permlane32_swap(__float_as_uint(a), __float_as_uint(a), false, false);
    return __uint_as_float(rr[0]) + __uint_as_float(rr[1]);
}
__device__ __forceinline__ void softmax_pv(f32x16& p0, f32x16& p1, f32x16 (&o)[2], float& m_run, float& l_run, LAS float* wsf, ldsc Vslot, int lane, int r32, int hi) {
    const float rm = rowmax(p0, p1);
    const float mn = fmaxf(m_run, rm); const float alpha = fexp2(m_run - mn); m_run = mn;
    float s = 0.f;
#pragma unroll
    for (int r = 0; r < 16; ++r) { p0[r] = fexp2(p0[r] - mn); p1[r] = fexp2(p1[r] - mn); s += p0[r] + p1[r]; }
    l_run = l_run * alpha + s;
    if (hi == 0) wsf[r32] = alpha;
#pragma unroll
    for (int g = 0; g < 4; ++g) { const f32x4 a4 = *(LAS const f32x4*)(wsf + 8 * g + 4 * hi);
#pragma unroll
        for (int j = 0; j < 4; ++j) { o[0][4 * g + j] *= a4[j]; o[1][4 * g + j] *= a4[j]; } }
    bf16x8 pa[4];
    { v4u w;
      w.x = cvtpk(p0[0], p0[1]); w.y = cvtpk(p0[2], p0[3]); w.z = cvtpk(p0[4], p0[5]); w.w = cvtpk(p0[6], p0[7]); pa[0] = __builtin_bit_cast(bf16x8, w);
      w.x = cvtpk(p0[8], p0[9]); w.y = cvtpk(p0[10], p0[11]); w.z = cvtpk(p0[12], p0[13]); w.w = cvtpk(p0[14], p0[15]); pa[1] = __builtin_bit_cast(bf16x8, w);
      w.x = cvtpk(p1[0], p1[1]); w.y = cvtpk(p1[2], p1[3]); w.z = cvtpk(p1[4], p1[5]); w.w = cvtpk(p1[6], p1[7]); pa[2] = __builtin_bit_cast(bf16x8, w);
      w.x = cvtpk(p1[8], p1[9]); w.y = cvtpk(p1[10], p1[11]); w.z = cvtpk(p1[12], p1[13]); w.w = cvtpk(p1[14], p1[15]); pa[3] = __builtin_bit_cast(bf16x8, w); }
    ldsc vp = Vslot + ((lane >> 4) & 1) * 32 + (lane & 3) * 8 + (4 * hi + ((lane & 15) >> 2)) * 64;
#pragma unroll
    for (int d0 = 0; d0 < 2; ++d0)
#pragma unroll
        for (int ks = 0; ks < 4; ++ks) { const s16x4 lo = vtr(vp + d0 * 4096 + ks * 1024), hh = vtr(vp + d0 * 4096 + ks * 1024 + 512);
            const bf16x8 vb = (bf16x8){lo[0], lo[1], lo[2], lo[3], hh[0], hh[1], hh[2], hh[3]};
            o[d0] = MFMA32(pa[ks], vb, o[d0]); }
}
__device__ __forceinline__ v4u mul8(v4u a, v4u z) {
    v4u r; r.x = cvtpk(bflo(a.x) * bflo(z.x), bfhi(a.x) * bfhi(z.x)); r.y = cvtpk(bflo(a.y) * bflo(z.y), bfhi(a.y) * bfhi(z.y));
    r.z = cvtpk(bflo(a.z) * bflo(z.z), bfhi(a.z) * bfhi(z.z)); r.w = cvtpk(bflo(a.w) * bflo(z.w), bfhi(a.w) * bfhi(z.w)); return r;
}

struct Ctx {
    LAS unsigned char* lds;
    const bf16 *QA, *KA, *VA, *QB, *KB, *VB, *SZA, *SZB; bf16* G;
    const float *Fp, *Fs, *rel; const float *cak, *cav, *cbk, *cbv;
    const unsigned* knorm;
};

constexpr int PL_K = 0, PL_V = 24576, PL_F = 49152, PL_BT = 51200, PL_OST = 77824, SLOTB = 8192;
__device__ __forceinline__ void glds16(const void* gsrc, unsigned lds_dst) { unsigned keep;
    asm volatile("s_mov_b32 %0, m0\n\ts_mov_b32 m0, %2\n\ts_nop 0\n\tglobal_load_lds_dwordx4 %1, off\n\ts_mov_b32 m0, %0" : "=&s"(keep) : "v"(gsrc), "s"(lds_dst) : "memory"); }
__device__ __forceinline__ void glds4(const void* gsrc, unsigned lds_dst) { unsigned keep;
    asm volatile("s_mov_b32 %0, m0\n\ts_mov_b32 m0, %2\n\ts_nop 0\n\tglobal_load_lds_dword %1, off\n\ts_mov_b32 m0, %0" : "=&s"(keep) : "v"(gsrc), "s"(lds_dst) : "memory"); }
typedef LAS const char* lds_cptr;
__device__ __forceinline__ void kload8(bf16x8* kf, lds_cptr kp) {
    kf[0] = *(LAS const bf16x8*)(kp);        kf[1] = *(LAS const bf16x8*)(kp + 512);
    kf[2] = *(LAS const bf16x8*)(kp + 2048); kf[3] = *(LAS const bf16x8*)(kp + 2560);
    kf[4] = *(LAS const bf16x8*)(kp + 4096); kf[5] = *(LAS const bf16x8*)(kp + 4608);
    kf[6] = *(LAS const bf16x8*)(kp + 6144); kf[7] = *(LAS const bf16x8*)(kp + 6656);
}
__device__ __forceinline__ void kload2(bf16x8* kf, lds_cptr kp, int j) { kf[2 * j] = *(LAS const bf16x8*)(kp + j * 2048); kf[2 * j + 1] = *(LAS const bf16x8*)(kp + j * 2048 + 512); }
__device__ __forceinline__ s16x4 vtr2(lds_cptr p) { return __builtin_bit_cast(s16x4, __builtin_amdgcn_ds_read_tr16_b64_v4i16((LAS v4i16_t*)p)); }
#define SBAR() __builtin_amdgcn_sched_barrier(0)
#define PIN(x) asm volatile("" : "+v"(x))
#define WAITB(N) asm volatile("s_waitcnt vmcnt(" #N ") lgkmcnt(0)\n\ts_barrier" ::: "memory")

template <int KIND, int THRL>
__device__ __forceinline__ void prompt_unit(const Ctx& X, int b, int h, int qb) {
    const int tid = fresh_tid(), lane = tid & 63, r32 = lane & 31, hi = lane >> 5; const int wid = __builtin_amdgcn_readfirstlane(tid >> 6);
    LAS unsigned char* lds = X.lds;
    const bf16* Q = KIND ? X.QA : X.QB; const bf16* Kt = KIND ? X.KA : X.KB; const bf16* Vt = KIND ? X.VA : X.VB; const bf16* SZ = KIND ? X.SZA : X.SZB;
    const size_t rowbase = (size_t)b * SEQ; const int q0 = qb * 256;
    const bf16* Qw = Q + (rowbase + q0 + wid * 32) * 512 + h * 64;
    const unsigned lds0 = (unsigned)(uintptr_t)lds;
    LAS float* wsf = (LAS float*)(lds + WSF_OFF) + wid * 64;
    const float* Fbh = X.Fp + (size_t)(b * 8 + h) * SEQ;
    int j_lo; const int j_hi = 4 * qb + 3; float Fq0L = 0.f;
    if (KIND == 0) {
        const float kn = __uint_as_float(__hip_atomic_load(X.knorm + ((b * 8 + h) * 2), RLX_AGENT)) + __uint_as_float(__hip_atomic_load(X.knorm + ((b * 8 + h) * 2) + 1, RLX_AGENT));
        const float qn = __uint_as_float(__hip_atomic_load(X.knorm + 32 + ((b * 8 + h) * 2), RLX_AGENT)) + __uint_as_float(__hip_atomic_load(X.knorm + 32 + ((b * 8 + h) * 2) + 1, RLX_AGENT));
        const float thr = 2.0f * C2 * sqrtf(qn * kn) * 1.02f + 40.0f;
        const float Fq0 = Fbh[q0]; Fq0L = Fq0 * L2E;
        int cnt = 0, base = 4 * qb - 1;
        for (;;) {
            const int jb = base - lane; bool ok = false;
            if (jb >= 0) ok = (Fq0 - Fbh[64 * jb + 63]) * L2E >= -thr;
            const unsigned long long mk = __ballot(ok);
            const int c = (mk == ~0ull) ? 64 : __builtin_ctzll(~mk);
            cnt += c; if (c < 64) break; base -= 64; if (base < 0) break;
        }
        j_lo = 4 * qb - cnt; if (j_lo < 0) j_lo = 0;
        if (((j_hi - j_lo + 1) & 1) && j_lo > 0) --j_lo;
        j_lo = __builtin_amdgcn_readfirstlane(j_lo);
    } else {
        j_lo = 4 * qb - 8; if (j_lo < 0) j_lo = 0;
    }
    const int n = j_hi - j_lo + 1;
    int ta, tb;
    if (KIND == 0) { ta = 0; tb = n - 4 + (wid >> 1); }
    else { const int cw = 4 * qb + (wid >> 1); ta = cw - 8; if (ta < 0) ta = 0; ta -= j_lo; tb = cw - j_lo; }
    const bf16* Kh = Kt + (rowbase + (size_t)j_lo * 64) * 512 + h * 64; const bf16* Vh = Vt + (rowbase + (size_t)j_lo * 64) * 512 + h * 64;
    const float* Fj = Fbh + 64 * j_lo;
    const bf16* ksrc = Kh + (size_t)lane * 512 + wid * 8;
    const bf16* vsrc = Vh + (size_t)(16 * (wid & 3) + (lane >> 2)) * 512 + (wid >> 2) * 32 + (lane & 3) * 8;
    const unsigned kdst = lds0 + PL_K + wid * 1024, vdst = lds0 + PL_V + wid * 1024, fdst = lds0 + PL_F;
#define DMA_K(t, slot) glds16(ksrc + (size_t)(t) * 64 * 512, (unsigned)__builtin_amdgcn_readfirstlane(kdst + (slot)))
#define DMA_V(t, slot) glds16(vsrc + (size_t)(t) * 64 * 512, (unsigned)__builtin_amdgcn_readfirstlane(vdst + (slot)))
#define DMA_F(t) do { if (KIND == 0) glds4(Fj + 64 * (t) + lane, (unsigned)__builtin_amdgcn_readfirstlane(fdst + ((t) & 3) * 256)); } while (0)
    const lds_cptr shm3 = (lds_cptr)lds; const lds_cptr kp0 = shm3 + PL_K + hi * 1024 + r32 * 16;
    const lds_cptr vp0 = shm3 + PL_V + ((lane >> 4) & 1) * 32 + (lane & 3) * 8 + (4 * hi + ((lane & 15) >> 2)) * 64;
    LAS const float* BT = (LAS const float*)(lds + PL_BT);
    float c191 = 0.f;
    if (KIND == 1) {
        const float* relh = X.rel + h * NREL;
#pragma unroll
        for (int k = 0; k < 12; ++k) { const int e = tid + 512 * k, di = e >> 10, ln = (e >> 4) & 63, r = e & 15;
            int idx = (32 * di - 32) + (ln & 31) - crow(r, ln >> 5) + 63; idx = min(max(idx, 0), NREL - 1);
            ((LAS float*)(lds + PL_BT))[e] = relh[idx] * L2E; }
        c191 = relh[NREL - 1] * L2E;
    }
    DMA_K(0, 0); DMA_F(0); DMA_V(0, 0); DMA_K(1, SLOTB); DMA_F(1);
    bf16x8 qr[4];
#pragma unroll
    for (int d0 = 0; d0 < 4; ++d0) qr[d0] = *(const bf16x8*)(Qw + (size_t)r32 * 512 + d0 * 16 + hi * 8);
    DMA_K(2, 2 * SLOTB); DMA_F(2);
    float mhat = 0.f, l_reg = 0.f; f32x16 o[2]; o[0] = f32x16{}; o[1] = f32x16{};
    const int qrel = wid * 32 + r32;
    bool resc = false;
    f32x16 pA0, pA1, pB0, pB1; bf16x8 kf[8];
    s16x4 vlo[8], vhi[8]; v4u pw0, pw1, pw2, pw3;
    int sl_prev = 0, sl_cur = 0, sl_next = SLOTB;
#define ROT() do { sl_prev = sl_cur; sl_cur = sl_next; sl_next = (sl_next == 2 * SLOTB) ? 0 : sl_next + SLOTB; } while (0)
#define CINIT(C0, C1, t) do { \
        if (KIND == 0) { LAS const float* fb_ = (LAS const float*)(lds + PL_F + ((t) & 3) * 256); const float base_ = Fq0L - mhat; \
            _Pragma("unroll") for (int g_ = 0; g_ < 4; ++g_) { const f32x4 f0_ = *(LAS const f32x4*)(fb_ + 8 * g_ + 4 * hi), f1_ = *(LAS const f32x4*)(fb_ + 32 + 8 * g_ + 4 * hi); \
                _Pragma("unroll") for (int e_ = 0; e_ < 4; ++e_) { C0[4 * g_ + e_] = __builtin_fmaf(f0_[e_], -L2E, base_); C1[4 * g_ + e_] = __builtin_fmaf(f1_[e_], -L2E, base_); } } \
        } else { const int dl0_ = 32 * (wid & 1) + 64 * (tb - (t)); \
            if (dl0_ >= 160) { const float cc_ = c191 - mhat; _Pragma("unroll") for (int r_ = 0; r_ < 16; ++r_) C0[r_] = cc_; } \
            else { LAS const float* bp_ = BT + (((dl0_ + 32) >> 5) * 64 + lane) * 16; \
                _Pragma("unroll") for (int g_ = 0; g_ < 4; ++g_) { const f32x4 f0_ = *(LAS const f32x4*)(bp_ + 4 * g_); _Pragma("unroll") for (int e_ = 0; e_ < 4; ++e_) C0[4 * g_ + e_] = f0_[e_] - mhat; } } \
            if (dl0_ - 32 >= 160) { const float cc_ = c191 - mhat; _Pragma("unroll") for (int r_ = 0; r_ < 16; ++r_) C1[r_] = cc_; } \
            else { LAS const float* bp_ = BT + (((dl0_) >> 5) * 64 + lane) * 16; \
                _Pragma("unroll") for (int g_ = 0; g_ < 4; ++g_) { const f32x4 f1_ = *(LAS const f32x4*)(bp_ + 4 * g_); _Pragma("unroll") for (int e_ = 0; e_ < 4; ++e_) C1[4 * g_ + e_] = f1_[e_] - mhat; } } \
        } } while (0)
#define CMASK(P0, P1, t) do { if (KIND == 0) { const int jb_ = (t) - (n - 4); if (jb_ >= 0) { const int kb_ = 64 * jb_ + 4 * hi; \
        _Pragma("unroll") for (int r_ = 0; r_ < 16; ++r_) { const int kv_ = kb_ + (r_ & 3) + 8 * (r_ >> 2); if (kv_ > qrel) P0[r_] = -INFINITY; if (kv_ + 32 > qrel) P1[r_] = -INFINITY; } } } } while (0)
#define MX3(a, b, c) __builtin_fmaxf(__builtin_fmaxf((a), (b)), (c))
#define ROWMAX(C0, C1, rm) do { float a_ = MX3(C0[0], C0[1], C1[0]), b_ = MX3(C0[2], C0[3], C1[1]); a_ = MX3(a_, C1[2], C1[3]); \
        _Pragma("unroll") for (int r_ = 4; r_ < 16; r_ += 4) { a_ = MX3(a_, C0[r_], C0[r_ + 1]); b_ = MX3(b_, C0[r_ + 2], C0[r_ + 3]); a_ = MX3(a_, C1[r_], C1[r_ + 1]); b_ = MX3(b_, C1[r_ + 2], C1[r_ + 3]); } \
        rm = __builtin_fmaxf(a_, b_); { auto rr_ = __builtin_amdgcn_permlane32_swap(__float_as_uint(rm), __float_as_uint(rm), false, false); rm = __builtin_fmaxf(__uint_as_float(rr_[0]), __uint_as_float(rr_[1])); } } while (0)
#define FIRST(C0, C1, t) do { CINIT(C0, C1, t); \
        C0 = MFMA32(kf[0], qr[0], C0); C1 = MFMA32(kf[1], qr[0], C1); C0 = MFMA32(kf[2], qr[1], C0); C1 = MFMA32(kf[3], qr[1], C1); \
        C0 = MFMA32(kf[4], qr[2], C0); C1 = MFMA32(kf[5], qr[2], C1); C0 = MFMA32(kf[6], qr[3], C0); C1 = MFMA32(kf[7], qr[3], C1); \
        CMASK(C0, C1, t); float rm_; ROWMAX(C0, C1, rm_); mhat += rm_; \
        _Pragma("unroll") for (int r_ = 0; r_ < 16; ++r_) { C0[r_] = fexp2(C0[r_] - rm_); C1[r_] = fexp2(C1[r_] - rm_); } } while (0)
#define PKW(P, B) cvtpk(P[B], P[B + 1])
#define PAF(k) __builtin_bit_cast(bf16x8, pw##k)
#define VFR(i) (bf16x8){vlo[i][0], vlo[i][1], vlo[i][2], vlo[i][3], vhi[i][0], vhi[i][1], vhi[i][2], vhi[i][3]}
#define GAPA(MF, A0, A1, A2, A3, W0, W1, PW) do { MF; sacc += A0; sacc += A1; sacc += A2; sacc += A3; PIN(sacc); W0; W1; PIN(PW); SBAR(); } while (0)
#define GAPB(MF, Xv, B) do { MF; Xv[B] = fexp2(Xv[B]); Xv[B + 1] = fexp2(Xv[B + 1]); Xv[B + 2] = fexp2(Xv[B + 2]); Xv[B + 3] = fexp2(Xv[B + 3]); PIN(Xv); SBAR(); } while (0)
#define VRD(i) do { vlo[i] = vtr2(vp_ + (((i) >> 2) * 4096 + ((i) & 3) * 1024)); vhi[i] = vtr2(vp_ + (((i) >> 2) * 4096 + ((i) & 3) * 1024 + 512)); } while (0)
#define KRD(G, j) do { if (G) { kload2(kf, kp0 + sl_next, j); SBAR(); } } while (0)
#define DMA_SLOT(t) do { if ((t) + 3 < n) { DMA_K((t) + 3, sl_cur); DMA_F((t) + 3); } if ((t) + 1 < n) { DMA_V((t) + 1, sl_next); } } while (0)
#define STEP(C0, C1, P0, P1, t, GL) do { CINIT(C0, C1, t); SBAR(); \
        const lds_cptr vp_ = vp0 + sl_prev; \
        VRD(0); SBAR(); float sacc = (P0[0] + P0[1]); \
        GAPA(C0 = MFMA32(kf[0], qr[0], C0), P0[2], P0[3], P0[4], P0[5],     pw0[0] = PKW(P0, 0), pw0[1] = PKW(P0, 2), pw0); \
        VRD(4); SBAR(); GAPA(C1 = MFMA32(kf[1], qr[0], C1), P0[6], P0[7], P0[8], P0[9],     pw0[2] = PKW(P0, 4), pw0[3] = PKW(P0, 6), pw0); \
        VRD(1); SBAR(); GAPA(C0 = MFMA32(kf[2], qr[1], C0), P0[10], P0[11], P0[12], P0[13], pw1[0] = PKW(P0, 8), pw1[1] = PKW(P0, 10), pw1); \
        VRD(5); SBAR(); GAPA(C1 = MFMA32(kf[3], qr[1], C1), P0[14], P0[15], P1[0], P1[1],   pw1[2] = PKW(P0, 12), pw1[3] = PKW(P0, 14), pw1); \
        VRD(2); SBAR(); GAPA(C0 = MFMA32(kf[4], qr[2], C0), P1[2], P1[3], P1[4], P1[5],     pw2[0] = PKW(P1, 0), pw2[1] = PKW(P1, 2), pw2); \
        VRD(6); SBAR(); GAPA(C1 = MFMA32(kf[5], qr[2], C1), P1[6], P1[7], P1[8], P1[9],     pw2[2] = PKW(P1, 4), pw2[3] = PKW(P1, 6), pw2); \
        VRD(3); SBAR(); GAPA(C0 = MFMA32(kf[6], qr[3], C0), P1[10], P1[11], P1[12], P1[13], pw3[0] = PKW(P1, 8), pw3[1] = PKW(P1, 10), pw3); \
        VRD(7); SBAR(); GAPA(C1 = MFMA32(kf[7], qr[3], C1), P1[14], P1[15], 0.f, 0.f,       pw3[2] = PKW(P1, 12), pw3[3] = PKW(P1, 14), pw3); \
        l_reg += sacc; \
        DMA_SLOT(t); \
        CMASK(C0, C1, t); \
        { float rm; ROWMAX(C0, C1, rm); resc = false; \
          if (__builtin_expect(__any(rm > (float)THRL), 0)) { const float dl = __builtin_fmaxf(rm, 0.f); mhat += dl; \
            _Pragma("unroll") for (int r_ = 0; r_ < 16; ++r_) { C0[r_] -= dl; C1[r_] -= dl; } \
            const float f = fexp2(-dl); l_reg *= f; if (hi == 0) wsf[r32] = f; resc = true; } } \
        SBAR(); \
        GAPB(o[0] = MFMA32(PAF(0), VFR(0), o[0]), C0, 0); \
        GAPB(o[1] = MFMA32(PAF(0), VFR(4), o[1]), C0, 4); \
        KRD(GL, 0); GAPB(o[0] = MFMA32(PAF(1), VFR(1), o[0]), C0, 8); \
        KRD(GL, 1); GAPB(o[1] = MFMA32(PAF(1), VFR(5), o[1]), C0, 12); \
        KRD(GL, 2); GAPB(o[0] = MFMA32(PAF(2), VFR(2), o[0]), C1, 0); \
        KRD(GL, 3); GAPB(o[1] = MFMA32(PAF(2), VFR(6), o[1]), C1, 4); \
        GAPB(o[0] = MFMA32(PAF(3), VFR(3), o[0]), C1, 8); \
        GAPB(o[1] = MFMA32(PAF(3), VFR(7), o[1]), C1, 12); \
    } while (0)
#define DRAIN(P0, P1) do { float sacc = P0[0] + P0[1]; _Pragma("unroll") for (int r_ = 2; r_ < 16; ++r_) sacc += P0[r_]; _Pragma("unroll") for (int r_ = 0; r_ < 16; ++r_) sacc += P1[r_]; l_reg += sacc; \
        pw0 = (v4u){PKW(P0, 0), PKW(P0, 2), PKW(P0, 4), PKW(P0, 6)}; pw1 = (v4u){PKW(P0, 8), PKW(P0, 10), PKW(P0, 12), PKW(P0, 14)}; \
        pw2 = (v4u){PKW(P1, 0), PKW(P1, 2), PKW(P1, 4), PKW(P1, 6)}; pw3 = (v4u){PKW(P1, 8), PKW(P1, 10), PKW(P1, 12), PKW(P1, 14)}; \
        const lds_cptr vp_ = vp0 + sl_prev; \
        _Pragma("unroll") for (int i_ = 0; i_ < 8; ++i_) { vlo[i_] = vtr2(vp_ + ((i_ >> 2) * 4096 + (i_ & 3) * 1024)); vhi[i_] = vtr2(vp_ + ((i_ >> 2) * 4096 + (i_ & 3) * 1024 + 512)); } \
        o[0] = MFMA32(PAF(0), VFR(0), o[0]); o[1] = MFMA32(PAF(0), VFR(4), o[1]); o[0] = MFMA32(PAF(1), VFR(1), o[0]); o[1] = MFMA32(PAF(1), VFR(5), o[1]); \
        o[0] = MFMA32(PAF(2), VFR(2), o[0]); o[1] = MFMA32(PAF(2), VFR(6), o[1]); o[0] = MFMA32(PAF(3), VFR(3), o[0]); o[1] = MFMA32(PAF(3), VFR(7), o[1]); } while (0)
#define RESC() do { if (resc) { _Pragma("unroll") for (int g_ = 0; g_ < 4; ++g_) { const f32x4 a4_ = *(LAS const f32x4*)(wsf + 8 * g_ + 4 * hi); \
        _Pragma("unroll") for (int e_ = 0; e_ < 4; ++e_) { o[0][4 * g_ + e_] *= a4_[e_]; o[1][4 * g_ + e_] *= a4_[e_]; } } resc = false; } } while (0)
#define CLOSE(t) do { if ((t) + 3 < n) { if (KIND == 0) WAITB(3); else WAITB(2); } else if ((t) + 1 < n) { WAITB(1); } else { WAITB(0); } } while (0)
#define IDLE(t) do { DMA_SLOT(t); if ((t) + 1 >= ta && (t) + 1 <= tb) kload8(kf, kp0 + sl_next); CLOSE(t); ROT(); } while (0)

    if (KIND == 0) WAITB(4); else WAITB(2);
    if (ta == 0) { kload8(kf, kp0); FIRST(pA0, pA1, 0); }
    WAITB(0);
    DMA_K(3, 0); DMA_F(3); DMA_V(1, SLOTB);
    ROT();
    if (1 >= ta && 1 <= tb) kload8(kf, kp0 + sl_cur);
    if (KIND == 0) WAITB(3); else WAITB(2);
    int t = 1;
    if (ta > 0) {
        for (; t < ta; ++t) IDLE(t);
        DMA_SLOT(t); FIRST(pA0, pA1, t); if (t + 1 <= tb) kload8(kf, kp0 + sl_next); CLOSE(t); ROT(); ++t;
    }
    for (; t + 1 <= tb; t += 2) {
        STEP(pB0, pB1, pA0, pA1, t, true); CLOSE(t); RESC(); ROT();
        const bool gl2 = (t + 2 <= tb);
        STEP(pA0, pA1, pB0, pB1, t + 1, gl2); CLOSE(t + 1); RESC(); ROT();
    }
    if (t <= tb) { STEP(pB0, pB1, pA0, pA1, t, false); CLOSE(t); RESC(); ROT(); ++t;
        DMA_SLOT(t); DRAIN(pB0, pB1); CLOSE(t); ROT(); ++t; }
    else { DMA_SLOT(t); DRAIN(pA0, pA1); CLOSE(t); ROT(); ++t; }
    for (; t <= n; ++t) IDLE(t);
    { const float lt = halfsum(l_reg);
      if (hi == 0) wsf[32 + r32] = lt;
      float rli[16];
#pragma unroll
      for (int g = 0; g < 4; ++g) { const f32x4 a4 = *(LAS const f32x4*)(wsf + 32 + 8 * g + 4 * hi);
#pragma unroll
          for (int e = 0; e < 4; ++e) rli[4 * g + e] = __builtin_amdgcn_rcpf(a4[e]); }
      LAS bf16* stg = (LAS bf16*)(lds + PL_OST + wid * 4096);
#pragma unroll
      for (int r = 0; r < 16; ++r) { const int orow = crow(r, hi);
#pragma unroll
          for (int d0 = 0; d0 < 2; ++d0) stg[orow * 64 + d0 * 32 + r32] = (bf16)(cvtpk(o[d0][r] * rli[r], 0.f) & 0xffffu); }
      const size_t grow0 = rowbase + q0 + wid * 32;
#pragma unroll
      for (int i = 0; i < 4; ++i) { const int row = i * 8 + (lane >> 3), ch = lane & 7;
          const v4u v = *(LAS const v4u*)(stg + row * 64 + ch * 8);
          const v4u z = *(const v4u*)(SZ + (grow0 + row) * 512 + h * 64 + ch * 8);
          *(v4u*)(X.G + (grow0 + row) * 1024 + (KIND ? 0 : 512) + h * 64 + ch * 8) = mul8(v, z); } }
    asm volatile("s_waitcnt vmcnt(0) lgkmcnt(0)\n\ts_barrier" ::: "memory");
#undef DMA_K
#undef DMA_V
#undef DMA_F
#undef ROT
#undef CINIT
#undef CMASK
#undef MX3
#undef ROWMAX
#undef FIRST
#undef PKW
#undef PAF
#undef VFR
#undef GAPA
#undef GAPB
#undef VRD
#undef KRD
#undef DMA_SLOT
#undef STEP
#undef DRAIN
#undef RESC
#undef CLOSE
#undef IDLE
}

template <int KIND>
__device__ __forceinline__ void sample_unit(const Ctx& X, int bs, int h) {
    const int tid = fresh_tid(), lane = tid & 63, r32 = lane & 31, hi = lane >> 5; const int wid = __builtin_amdgcn_readfirstlane(tid >> 6);
    LAS unsigned char* lds = X.lds;
    const int ncache = KIND ? AKEEP : PAST, nct = ncache / 64, ntile = nct + 1;
    const float* Kc = (KIND ? X.cak : X.cbk) + ((size_t)bs * ncache * 8 + h) * 64;
    const float* Vc = (KIND ? X.cav : X.cbv) + ((size_t)bs * ncache * 8 + h) * 64;
    const bf16* Q = KIND ? X.QA : X.QB; const bf16* Kn = KIND ? X.KA : X.KB; const bf16* Vn = KIND ? X.VA : X.VB; const bf16* SZ = KIND ? X.SZA : X.SZB;
    const size_t nrow0 = (size_t)MP + 16 * bs;
    LAS float* wsf = (LAS float*)(lds + WSF_OFF) + wid * 64;
    LAS float* tb = (LAS float*)(lds + TB_OFF);
    if (KIND == 1) { if (tid < NREL) tb[tid] = X.rel[h * NREL + tid] * L2E; }
    __syncthreads();
    bf16x8 qr[4];
#pragma unroll
    for (int d0 = 0; d0 < 4; ++d0) qr[d0] = *(const bf16x8*)(Q + (nrow0 + (r32 & 15)) * 512 + h * 64 + d0 * 16 + hi * 8);
    const float* Fsr = X.Fs + (size_t)(bs * 8 + h) * FS_PITCH;
    const float Fref = (KIND == 0) ? Fsr[PAST - 1] : 0.f;
    LAS unsigned char* kslot = lds + wid * 16384; LAS unsigned char* vslot = kslot + 8192;
    float m_run = -1e30f, l_run = 0.f; f32x16 o[2]; o[0] = f32x16{}; o[1] = f32x16{};
    const int tq = r32 & 15;
    for (int t = wid; t < ntile; t += 8) {
        if (t < nct) {
            const float* kr = Kc + (size_t)(t * 64 + (lane >> 4)) * 512 + (lane & 15) * 4; const float* vr = Vc + (size_t)(t * 64 + (lane >> 4)) * 512 + (lane & 15) * 4;
            f32x4 kq[16], vq[16];
#pragma unroll
            for (int i = 0; i < 16; ++i) kq[i] = *(const f32x4*)(kr + (size_t)i * 4 * 512);
#pragma unroll
            for (int i = 0; i < 16; ++i) vq[i] = *(const f32x4*)(vr + (size_t)i * 4 * 512);
            LAS unsigned char* kw = kslot + ((lane & 15) >> 1) * 1024 + (lane >> 4) * 16 + (lane & 1) * 8;
            LAS unsigned char* vw = vslot + ((lane & 15) >> 3) * 4096 + (lane >> 4) * 64 + (lane & 7) * 8;
#pragma unroll
            for (int i = 0; i < 16; ++i) { v2u w; w.x = cvtpk(kq[i][0], kq[i][1]); w.y = cvtpk(kq[i][2], kq[i][3]); *(LAS v2u*)(kw + i * 64) = w; }
#pragma unroll
            for (int i = 0; i < 16; ++i) { v2u w; w.x = cvtpk(vq[i][0], vq[i][1]); w.y = cvtpk(vq[i][2], vq[i][3]); *(LAS v2u*)(vw + i * 256) = w; }
        } else {
#pragma unroll
            for (int c = 0; c < 8; ++c) { v4u wk = (v4u){0u, 0u, 0u, 0u}, wv = wk;
                if (lane < 16) { wk = *(const v4u*)(Kn + (nrow0 + lane) * 512 + h * 64 + c * 8); wv = *(const v4u*)(Vn + (nrow0 + lane) * 512 + h * 64 + c * 8); }
                *(LAS v4u*)(kslot + c * 1024 + lane * 16) = wk;
                *(LAS v4u*)(vslot + (c >> 2) * 4096 + lane * 64 + (c & 3) * 16) = wv; }
        }
        f32x16 c0, c1, p0, p1;
        if (KIND == 0) {
            const float* fb = Fsr + t * 64;
#pragma unroll
            for (int g = 0; g < 4; ++g) { const f32x4 f0 = *(const f32x4*)(fb + 8 * g + 4 * hi), f1 = *(const f32x4*)(fb + 32 + 8 * g + 4 * hi);
#pragma unroll
                for (int e = 0; e < 4; ++e) { c0[4 * g + e] = (Fref - f0[e]) * L2E; c1[4 * g + e] = (Fref - f1[e]) * L2E; } }
        } else { c0 = f32x16{}; c1 = f32x16{}; }
        qkt(p0, p1, (ldsc)kslot, qr, c0, c1, r32, hi);
        if (KIND == 1) {
            const int dist0 = ncache + tq - (64 * t + 4 * hi) + 63;
#pragma unroll
            for (int r = 0; r < 16; ++r) { const int i0 = dist0 - ((r & 3) + 8 * (r >> 2));
                const int a0 = min(max(i0, 0), NREL - 1), a1 = min(max(i0 - 32, 0), NREL - 1);
                p0[r] += tb[a0]; p1[r] += tb[a1]; }
        }
        if (t == nct) {
#pragma unroll
            for (int r = 0; r < 16; ++r) { const int kv = 4 * hi + (r & 3) + 8 * (r >> 2);
                const bool ok = (kv < 16) && (KIND == 1 || kv <= tq);
                if (!ok) p0[r] = -1e30f; p1[r] = -1e30f; }
        }
        softmax_pv(p0, p1, o, m_run, l_run, wsf, (ldsc)vslot, lane, r32, hi);
    }
    const float lt = halfsum(l_run);
    __syncthreads();
    LAS float* OP = (LAS float*)lds;
    LAS float* ML = (LAS float*)(lds + 32768);
    if (lane < 16) { ML[(wid * 16 + lane) * 2] = m_run; ML[(wid * 16 + lane) * 2 + 1] = lt; }
#pragma unroll
    for (int r = 0; r < 8; ++r) { const int q = crow(r, hi);
#pragma unroll
        for (int d0 = 0; d0 < 2; ++d0) OP[(wid * 16 + q) * 64 + d0 * 32 + r32] = o[d0][r]; }
    __syncthreads();
    { const int q = tid >> 5, d = (tid & 31) * 2;
      float M = -1e30f;
#pragma unroll
      for (int w = 0; w < 8; ++w) M = fmaxf(M, ML[(w * 16 + q) * 2]);
      float L = 0.f, a0 = 0.f, a1 = 0.f;
#pragma unroll
      for (int w = 0; w < 8; ++w) { const float f = fexp2(ML[(w * 16 + q) * 2] - M); L += ML[(w * 16 + q) * 2 + 1] * f;
          const f32x2 ov = *(LAS const f32x2*)(OP + (w * 16 + q) * 64 + d); a0 += ov[0] * f; a1 += ov[1] * f; }
      const float rl = 1.0f / L;
      const unsigned z = *(const unsigned*)(SZ + (nrow0 + q) * 512 + h * 64 + d);
      *(unsigned*)(X.G + (nrow0 + q) * 1024 + (KIND ? 0 : 512) + h * 64 + d) = cvtpk(a0 * rl * bflo(z), a1 * rl * bfhi(z)); }
    __syncthreads();
}
}

#ifndef REP_FP
#define REP_FP 1
#endif
#ifndef REP_BP
#define REP_BP 1
#endif
#ifndef REP_S
#define REP_S 1
#endif
#ifndef REP_P0
#define REP_P0 1
#endif
#ifndef REP_P1
#define REP_P1 1
#endif
#ifndef REP_P2
#define REP_P2 1
#endif
#ifndef REP_P3A
#define REP_P3A 1
#endif
#ifndef REP_P3B
#define REP_P3B 1
#endif
#ifndef REP_P4
#define REP_P4 1
#endif
__global__ void __launch_bounds__(512, 2) fwd_kernel(Args args) {
    extern __shared__ __attribute__((aligned(16))) unsigned char lds_raw[];
    LAS unsigned char* lds = (LAS unsigned char*)lds_raw;
    const int G = gridDim.x; const int bx = blockIdx.x; const int vcu = (G % 8 == 0) ? (bx % 8) * (G / 8) + bx / 8 : bx;
    unsigned char* ws = args.ws; float* out = args.out;
    gu32* ctl = (gu32*)(ws + WS_CTL);
    const float* x_p = args.in[0]; const float* x_s = args.in[1];
    const float *cak = args.in[2], *cav = args.in[3], *cbk = args.in[4], *cbv = args.in[5], *cbl = args.in[6];
    const float *g_pre = args.in[7], *w_in = args.in[8], *b_f = args.in[9], *rel = args.in[10], *w_bra = args.in[11], *w_brb = args.in[12], *w_out = args.in[13], *g_post = args.in[14];
    float* Fp = (float*)(ws + WS_FP); float* LFp = (float*)(ws + WS_LFP); float* Fs = (float*)(ws + WS_FS); float* LFn = (float*)(ws + WS_LFN);
    bf16* WIN = (bf16*)(ws + WS_WIN); bf16* WBR = (bf16*)(ws + WS_WBR); bf16* WOUT = (bf16*)(ws + WS_WOUT);
    bf16* XN = (bf16*)(ws + WS_XN);
    bf16 *QA = (bf16*)(ws + WS_QA), *KA = (bf16*)(ws + WS_KA), *VA = (bf16*)(ws + WS_VA), *QB = (bf16*)(ws + WS_QB), *KB = (bf16*)(ws + WS_KB), *VB = (bf16*)(ws + WS_VB);
    bf16 *SZA = (bf16*)(ws + WS_SZA), *SZB = (bf16*)(ws + WS_SZB), *SMA = (bf16*)(ws + WS_SMA), *SMB = (bf16*)(ws + WS_SMB);
    bf16* MG = (bf16*)(ws + WS_MG); float* OUTF = (float*)(ws + WS_OUTF);

    for (int u = threadIdx.x; u < (LDS_BYTES - LDSCTL_OFF) / 4; u += 512) ((LAS unsigned*)(lds + LDSCTL_OFF))[u] = 0u;
    __syncthreads();
    volatile LAS unsigned* MISC = (volatile LAS unsigned*)(lds + MISC_OFF);
    XcdBarrier bar = xcd_barrier_post((unsigned*)(ctl + CW_BAR), MISC + 8);
    const int NGW = G * 8;

#pragma nounroll
    for (int rep = 0; rep < REP_P0; ++rep) {
        const int tid = fresh_tid(), lane = tid & 63; const int wave = __builtin_amdgcn_readfirstlane(tid >> 6); const int gw = vcu * 8 + wave;
        LAS float* wfT = (LAS float*)(lds + 73728);
        for (int k = tid; k < DM; k += 512) { const f32x4 a = *(const f32x4*)(w_in + (size_t)k * NIN + 4096), b = *(const f32x4*)(w_in + (size_t)k * NIN + 4100);
            wfT[0 * DM + k] = a[0]; wfT[1 * DM + k] = a[1]; wfT[2 * DM + k] = a[2]; wfT[3 * DM + k] = a[3];
            wfT[4 * DM + k] = b[0]; wfT[5 * DM + k] = b[1]; wfT[6 * DM + k] = b[2]; wfT[7 * DM + k] = b[3]; }
        __syncthreads();
        LAS float* scr = (LAS float*)(lds + wave * 8704);
        constexpr int I_IN = 16 * 192, I_BR = 8 * 32, I_OUT = 16 * 32, NITEMS = I_IN + 2 * I_BR + I_OUT;
        for (int it = gw; it < NITEMS; it += NGW) {
            int r = it;
            if (r < I_IN) { const int kb = r / 192, nb = r % 192, n0 = 32 * nb; p0_transpose_item(w_in, NIN, n0 + (n0 >= 4096 ? 8 : 0), WIN, DM, 0, n0, scr, 64 * kb, lane); continue; } r -= I_IN;
            if (r < I_BR) { const int kb = r / 32, nb = r % 32; p0_transpose_item(w_bra, DM, 32 * nb, WBR, DM, 0, 32 * nb, scr, 64 * kb, lane); continue; } r -= I_BR;
            if (r < I_BR) { const int kb = r / 32, nb = r % 32; p0_transpose_item(w_brb, DM, 32 * nb, WBR, DM, 512, 32 * nb, scr, 64 * kb, lane); continue; } r -= I_BR;
            { const int kb = r / 32, nb = r % 32; p0_transpose_item(w_out, DM, 32 * nb, WOUT, DM, 0, 32 * nb, scr, 64 * kb, lane); }
        }
        f32x4 gv[4];
#pragma unroll
        for (int j = 0; j < 4; ++j) gv[j] = *((const f32x4*)g_pre + lane + 64 * j);
        for (int m = gw; m < MTOT; m += NGW) {
            GAS unsigned long long* o8 = (GAS unsigned long long*)(XN + (size_t)m * DM) + lane;
            if (m >= MP + MS) {
#pragma unroll
                for (int j = 0; j < 4; ++j) o8[64 * j] = 0ull;
                continue; }
            const float* xrow = (m < MP) ? x_p + (size_t)m * DM : x_s + (size_t)(m - MP) * DM;
            f32x4 v[4]; float ss = 0.f;
#pragma unroll
            for (int j = 0; j < 4; ++j) { v[j] = *((const f32x4*)xrow + lane + 64 * j); ss += (v[j][0] * v[j][0] + v[j][1] * v[j][1]) + (v[j][2] * v[j][2] + v[j][3] * v[j][3]); }
            float dt[8];
#pragma unroll
            for (int hh = 0; hh < 8; ++hh) dt[hh] = 0.f;
#pragma unroll
            for (int j = 0; j < 4; ++j) { v[j] = v[j] * gv[j];
#pragma unroll
                for (int hh = 0; hh < 8; ++hh) { const f32x4 w = *(LAS const f32x4*)(wfT + hh * DM + 256 * j + 4 * lane);
                    dt[hh] += (v[j][0] * w[0] + v[j][1] * w[1]) + (v[j][2] * w[2] + v[j][3] * w[3]); } }
            ss = wave_sum(ss);
            const float rs = 1.0f / sqrtf(ss * (1.0f / DM) + EPS);
            {
                const bool u5 = (lane & 32) != 0, u4 = (lane & 16) != 0, u3 = (lane & 8) != 0;
#pragma unroll
                for (int i = 0; i < 4; ++i) { const float snd = u5 ? dt[i] : dt[i + 4], kp = u5 ? dt[i + 4] : dt[i]; dt[i] = kp + __shfl_xor(snd, 32); }
#pragma unroll
                for (int i = 0; i < 2; ++i) { const float snd = u4 ? dt[i] : dt[i + 2], kp = u4 ? dt[i + 2] : dt[i]; dt[i] = kp + __shfl_xor(snd, 16); }
                { const float snd = u3 ? dt[0] : dt[1], kp = u3 ? dt[1] : dt[0]; dt[0] = kp + __shfl_xor(snd, 8); }
                dt[0] += __shfl_xor(dt[0], 1); dt[0] += __shfl_xor(dt[0], 2); dt[0] += __shfl_xor(dt[0], 4);
            }
            if ((lane & 7) == 0) {
                const int hh = lane >> 3;
                const float val = dt[0] * rs + b_f[hh];
                const float lf = (val >= 0.f) ? -log1pf(expf(-val)) : (val - log1pf(expf(val)));
                if (m < MP) { out[O_BLP + (size_t)m * 8 + hh] = lf; LFp[(size_t)((m >> 14) * 8 + hh) * SEQ + (m & (SEQ - 1))] = lf; }
                else { const int ms = m - MP; out[O_BLS + (size_t)ms * 8 + hh] = lf; LFn[((ms >> 4) * 8 + hh) * 16 + (ms & 15)] = lf; }
            }
#pragma unroll
            for (int j = 0; j < 4; ++j) o8[64 * j] = (unsigned long long)cvtpk(v[j][0] * rs, v[j][1] * rs) | ((unsigned long long)cvtpk(v[j][2] * rs, v[j][3] * rs) << 32);
        }
        { const int gt = vcu * 512 + tid, NT = G * 512; constexpr int PER = 496 * 128;
          for (int i = gt; i < 2 * 8 * PER; i += NT) { const int ten = i / (8 * PER), r = i - ten * 8 * PER, bb = r / PER, off = r - bb * PER;
              const f32x4* src = (const f32x4*)(ten ? cav : cak) + (size_t)bb * 65536 + 2048 + off;
              f32x4* dst = (f32x4*)(out + (ten ? O_AVS : O_AKS)) + (size_t)bb * 65536 + off; *dst = *src; } }
    }
    xcd_barrier(bar);

    if (vcu < 24) {
        const int tid = fresh_tid(), lane = tid & 63; const int wave = __builtin_amdgcn_readfirstlane(tid >> 6);
        LAS float* wtot = (LAS float*)(lds + QMX_OFF);
        if (vcu < 16) {
            const float* in = LFp + (size_t)vcu * SEQ + wave * 2048 + lane * 32; float* o = Fp + (size_t)vcu * SEQ + wave * 2048 + lane * 32;
            f32x4 v[8];
#pragma unroll
            for (int i = 0; i < 8; ++i) v[i] = *((const f32x4*)in + i);
            float run = 0.f;
#pragma unroll
            for (int i = 0; i < 8; ++i) { v[i][0] += run; v[i][1] += v[i][0]; v[i][2] += v[i][1]; v[i][3] += v[i][2]; run = v[i][3]; }
            float inc = run;
#pragma unroll
            for (int ofs = 1; ofs < 64; ofs <<= 1) { const float t = __shfl_up(inc, ofs); if (lane >= ofs) inc += t; }
            if (lane == 63) wtot[wave] = inc;
            __syncthreads();
            float carry = inc - run;
#pragma unroll
            for (int w = 0; w < 8; ++w) if (w < wave) carry += wtot[w];
#pragma unroll
            for (int i = 0; i < 8; ++i) { v[i] = v[i] + carry; *((f32x4*)o + i) = v[i]; }
        } else {
            const int sidx = (vcu - 16) * 8 + wave, bs = vcu - 16, hh = wave;
            const float* in = cbl + ((size_t)bs * PAST + 64 * lane) * 8 + hh; float* o = Fs + (size_t)sidx * FS_PITCH + 64 * lane;
            float v[64];
#pragma unroll
            for (int i = 0; i < 64; ++i) v[i] = in[i * 8];
            float run = 0.f;
#pragma unroll
            for (int i = 0; i < 64; ++i) { run += v[i]; v[i] = run; }
            float inc = run;
#pragma unroll
            for (int ofs = 1; ofs < 64; ofs <<= 1) { const float t = __shfl_up(inc, ofs); if (lane >= ofs) inc += t; }
            const float carry = inc - run;
#pragma unroll
            for (int i = 0; i < 16; ++i) { f32x4 q4 = {v[4 * i] + carry, v[4 * i + 1] + carry, v[4 * i + 2] + carry, v[4 * i + 3] + carry}; *((f32x4*)o + i) = q4; }
            const float last = __shfl(inc, 63);
            if (lane == 0) { float r2 = last; float* on = Fs + (size_t)sidx * FS_PITCH + PAST;
                for (int i = 0; i < 16; ++i) { r2 += LFn[sidx * 16 + i]; on[i] = r2; }
                for (int i = 16; i < 64; ++i) on[i] = r2; }
            __syncthreads();
        }
    }
#pragma nounroll
    for (int rep = 0; rep < REP_P1; ++rep) {
        if (rep) xcd_barrier(bar);
        pg8::Gemm g{XN, WIN, DM, DM / 64}; pg8::StaticOrder S; S.init(MTOT, NG, G, bx, 1);
        pg8::EpiInProj E{QA, KA, VA, SZA, QB, KB, VB, SZB, SMA, SMB, out, (unsigned*)(ctl + CW_KNORM)};
        pg8::gemm_phase<pg8::EpiInProj, pg8::StaticOrder>(lds, g, S, E);
    }
    xcd_barrier(bar);

#pragma nounroll
    for (int rep = 0; rep < REP_P2; ++rep) {
        if (rep) xcd_barrier(bar);
        att::Ctx X; X.lds = lds; X.QA = QA; X.KA = KA; X.VA = VA; X.QB = QB; X.KB = KB; X.VB = VB; X.SZA = SZA; X.SZB = SZB; X.G = XN;
        X.Fp = Fp; X.Fs = Fs; X.rel = rel; X.cak = cak; X.cav = cav; X.cbk = cbk; X.cbv = cbv; X.knorm = (const unsigned*)(ctl + CW_KNORM);
        constexpr int NU = 64 + 1024 + 1024 + 64;
        gu32* qctr = ctl + CW_QUEUE + rep * 64;
        volatile LAS unsigned* qw = (volatile LAS unsigned*)(lds + MISC_OFF) + 16;
        if (threadIdx.x == 0) qw[0] = __hip_atomic_fetch_add(qctr, 1u, RLX_AGENT);
        __syncthreads();
        for (;;) {
            const int u = (int)__builtin_amdgcn_readfirstlane(qw[0]);
            if (u >= NU) break;
            unsigned nxt = 0u;
            if (threadIdx.x == 0) nxt = __hip_atomic_fetch_add(qctr, 1u, RLX_AGENT);

            if (u < 64) { for (int r2 = 0; r2 < REP_S; ++r2) att::sample_unit<0>(X, u >> 3, u & 7); }
            else if (u < 64 + 2048) { const int kind = (u - 64) >> 10, idx = (u - 64) & 1023;
                const int hh = ((idx & 7) + (idx >> 8)) & 7, bb = (idx >> 3) & 1, qb = 63 - (idx >> 4);
                if (kind == 0) { for (int r2 = 0; r2 < REP_FP; ++r2) att::prompt_unit<0, 8>(X, bb, hh, qb); } else { for (int r2 = 0; r2 < REP_BP; ++r2) att::prompt_unit<1, 8>(X, bb, hh, qb); } }
            else { const int i2 = u - 64 - 2048; for (int r2 = 0; r2 < REP_S; ++r2) att::sample_unit<1>(X, i2 >> 3, i2 & 7); }
            if (threadIdx.x == 0) qw[0] = nxt;
            __syncthreads();
        }
    }
    xcd_barrier(bar);

#pragma nounroll
    for (int rep = 0; rep < REP_P3A; ++rep) {
        if (rep) xcd_barrier(bar);
        pg8::Gemm g{XN, WBR, DM, 8}; pg8::StaticOrder S; S.init(MTOT, DM, G, bx, 2);
        pg8::EpiMerge E{SMA, SMB, MG};
        pg8::gemm_phase<pg8::EpiMerge, pg8::StaticOrder>(lds, g, S, E);
    }
    xcd_barrier(bar);
#pragma nounroll
    for (int rep = 0; rep < REP_P3B; ++rep) {
        if (rep) xcd_barrier(bar);
        pg8::Gemm g{MG, WOUT, DM, DM / 64}; pg8::StaticOrder S; S.init(MTOT, DM, G, bx, 1);
        pg8::EpiF32 E{OUTF, DM};
        pg8::gemm_phase<pg8::EpiF32, pg8::StaticOrder>(lds, g, S, E);
    }
    xcd_barrier(bar);
#pragma nounroll
    for (int rep = 0; rep < REP_P4; ++rep) {
        const int tid = fresh_tid(), lane = tid & 63; const int wave = __builtin_amdgcn_readfirstlane(tid >> 6); const int gw = vcu * 8 + wave;
        f32x4 gv[4];
#pragma unroll
        for (int j = 0; j < 4; ++j) gv[j] = *((const f32x4*)g_post + lane + 64 * j);
        for (int m = gw; m < MP + MS; m += NGW) {
            const float* xrow = (m < MP) ? x_p + (size_t)m * DM : x_s + (size_t)(m - MP) * DM;
            float* yrow = (m < MP) ? out + O_YP + (size_t)m * DM : out + O_YS + (size_t)(m - MP) * DM;
            const float* orow = OUTF + (size_t)m * DM;
            f32x4 v[4], xv[4]; float ss = 0.f;
#pragma unroll
            for (int j = 0; j < 4; ++j) { v[j] = *((const f32x4*)orow + lane + 64 * j); xv[j] = *((const f32x4*)xrow + lane + 64 * j);
                ss += (v[j][0] * v[j][0] + v[j][1] * v[j][1]) + (v[j][2] * v[j][2] + v[j][3] * v[j][3]); }
            ss = wave_sum(ss);
            const float rs = 1.0f / sqrtf(ss * (1.0f / DM) + EPS);
#pragma unroll
            for (int j = 0; j < 4; ++j) *((f32x4*)yrow + lane + 64 * j) = xv[j] + v[j] * rs * gv[j];
        }
    }
}

extern "C" void kernel_launch(void* const* d_in, const int* in_sizes, int n_in, void* d_out, int out_size, void* d_ws, size_t ws_size, hipStream_t stream) {
    static int grid = 0;
    if (grid == 0) {
        if (n_in != 15 || in_sizes[0] != MP * DM || (size_t)out_size != O_END || ws_size < WS_END) {
            fprintf(stderr, "kernel_launch: unexpected shapes: n_in %d in0 %d out %d ws %zu (need %zu)\n", n_in, n_in > 0 ? in_sizes[0] : -1, out_size, ws_size, (size_t)WS_END); grid = -1; return; }
        int dev = 0, cus = 0, per_cu = 0;
        if (hipGetDevice(&dev) != hipSuccess || hipDeviceGetAttribute(&cus, hipDeviceAttributeMultiprocessorCount, dev) != hipSuccess) { fprintf(stderr, "kernel_launch: device query failed\n"); grid = -1; return; }
        if (hipFuncSetAttribute((const void*)fwd_kernel, hipFuncAttributeMaxDynamicSharedMemorySize, LDS_BYTES) != hipSuccess) { fprintf(stderr, "kernel_launch: hipFuncSetAttribute failed\n"); grid = -1; return; }
        if (hipOccupancyMaxActiveBlocksPerMultiprocessor(&per_cu, (const void*)fwd_kernel, 512, LDS_BYTES) != hipSuccess || per_cu < 1) {
            fprintf(stderr, "kernel_launch: occupancy query reports %d blocks per CU\n", per_cu); (void)hipGetLastError(); grid = -1; return; }
        grid = cus;
    }
    if (grid < 0) return;
    if (hipMemsetAsync((char*)d_ws + WS_CTL, 0, CTL_ZERO_BYTES, stream) != hipSuccess) { fprintf(stderr, "kernel_launch: memset failed\n"); return; }
    Args a{};
    for (int i = 0; i < 15; ++i) a.in[i] = (const float*)d_in[i];
    a.out = (float*)d_out; a.ws = (unsigned char*)d_ws;
    hipLaunchKernelGGL(fwd_kernel, dim3(grid), dim3(512), LDS_BYTES, stream, a);
    const hipError_t le = hipPeekAtLastError();
    if (le != hipSuccess) fprintf(stderr, "kernel_launch: launch failed: %s\n", hipGetErrorName(le));
}
```

```cpp
#include <hip/hip_runtime.h>
#include <hip/hip_bf16.h>
#include <cstdio>
#include <cstdint>

constexpr int DM = 1024, NB = 2, SEQ = 16384, DECB = 8, DECS = 16, PAST = 4096, AKEEP = 512;
constexpr int NH = 8, HD = 64, WA = 512;
constexpr int NIN = 6152;
constexpr int NG = 6144;
constexpr int MP = NB * SEQ;
constexpr int MS = DECB * DECS;
constexpr int MTOT = MP + 256;
constexpr int NREL = 192;
constexpr float EPS = 1e-6f;
constexpr float L2E = 1.4426950408889634f;
constexpr float C2 = 0.125f * L2E;
constexpr int FS_PITCH = 4160;

constexpr size_t O_YP = 0, O_YS = 33554432, O_AKP = 33685504, O_AVP = 34209792, O_BKP = 34734080, O_BVP = 51511296, O_BLP = 68288512,
                 O_AKS = 68550656, O_AVS = 70647808, O_BKS = 72744960, O_BVS = 72810496, O_BLS = 72876032, O_END = 72877056;

constexpr size_t MiB = 1u << 20;
constexpr size_t WS_CTL = 0, CTL_ZERO_BYTES = 1 * MiB;
constexpr size_t WS_FP = 1 * MiB;
constexpr size_t WS_LFP = 2 * MiB;
constexpr size_t WS_FS = 3 * MiB;
constexpr size_t WS_LFN = 5 * MiB;
constexpr size_t WS_WIN = 6 * MiB;
constexpr size_t WS_WBR = 18 * MiB;
constexpr size_t WS_WOUT = 20 * MiB;
constexpr size_t WS_XN = 24 * MiB;
constexpr size_t ACT_BYTES = (size_t)MTOT * 512 * 2;
constexpr size_t WS_QA = 89 * MiB, WS_KA = 122 * MiB, WS_VA = 155 * MiB, WS_QB = 188 * MiB, WS_KB = 221 * MiB, WS_VB = 254 * MiB;
constexpr size_t WS_MG = 89 * MiB;
constexpr size_t WS_OUTF = 155 * MiB;
constexpr size_t WS_SZA = 287 * MiB, WS_SZB = 320 * MiB;
constexpr size_t WS_SMA = 353 * MiB, WS_SMB = 418 * MiB;
constexpr size_t WS_END = 483 * MiB;
static_assert(ACT_BYTES <= 33 * MiB && WS_XN + 2 * ACT_BYTES <= WS_QA && WS_OUTF + (size_t)MTOT * 1024 * 4 <= WS_SZA && WS_MG + 2 * ACT_BYTES <= WS_OUTF, "ws map");

constexpr int CW_KNORM = 64;
constexpr int CW_QUEUE = 1024;
constexpr int CW_BAR = 4096;

constexpr int RING_BYTES = 131072;
constexpr int LDSCTL_OFF = RING_BYTES, MISC_OFF = LDSCTL_OFF + 320;
constexpr int TB_OFF = LDSCTL_OFF + 1024;
constexpr int WSF_OFF = LDSCTL_OFF + 2048;
constexpr int QMX_OFF = LDSCTL_OFF + 4096;
constexpr int LDS_BYTES = 147456;

#define GAS __attribute__((address_space(1)))
#define LAS __attribute__((address_space(3)))
typedef unsigned short bf16;
typedef unsigned v4u __attribute__((ext_vector_type(4)));
typedef unsigned v2u __attribute__((ext_vector_type(2)));
typedef float f32x4 __attribute__((ext_vector_type(4)));
typedef float f32x2 __attribute__((ext_vector_type(2)));
typedef float f32x16 __attribute__((ext_vector_type(16)));
typedef short bf16x8 __attribute__((ext_vector_type(8)));
typedef short s16x4 __attribute__((ext_vector_type(4)));
typedef short v4i16_t __attribute__((ext_vector_type(4)));
typedef __bf16 bf16x2_t __attribute__((ext_vector_type(2)));
typedef GAS unsigned gu32;
#define RLX_AGENT __ATOMIC_RELAXED, __HIP_MEMORY_SCOPE_AGENT

__device__ __forceinline__ unsigned cvtpk(float lo, float hi) { f32x2 v = {lo, hi}; bf16x2_t b = __builtin_convertvector(v, bf16x2_t); return __builtin_bit_cast(unsigned, b); }
__device__ __forceinline__ int fresh_tid() { int t = threadIdx.x; asm volatile("" : "+v"(t)); return t; }
__device__ __forceinline__ float bflo(unsigned u) { return __uint_as_float(u << 16); }
__device__ __forceinline__ float bfhi(unsigned u) { return __uint_as_float(u & 0xffff0000u); }
__device__ __forceinline__ float fexp2(float x) { return __builtin_amdgcn_exp2f(x); }
__device__ __forceinline__ float sigmoidf_(float v) { return __builtin_amdgcn_rcpf(1.0f + fexp2(-v * L2E)); }

namespace pg8 {
#define PG8_LAS __attribute__((address_space(3)))
typedef unsigned short bf16_t;
typedef unsigned u32x4 __attribute__((ext_vector_type(4)));
constexpr int BM = 256, BK = 64, HALF = 128, HTB = HALF * BK * 2, STAGE_BYTES = 8 * HTB, NXCD = 8, WGM = 8;

__host__ __device__ __forceinline__ int lds_byte(int r, int c) { const int st = (r >> 4) * 2 + (c >> 5), rr = r & 15, cc = c & 31, ob = rr * 64 + cc * 2; return st * 1024 + (ob ^ (((ob >> 9) & 1) << 5)); }
__host__ __device__ __forceinline__ void stage_rc(int b, int& R, int& C) { const int st = b / 1024, sb = b % 1024, swz = sb ^ (((sb >> 9) & 1) << 5); R = (st >> 1) * 16 + swz / 64; C = (st & 1) * 32 + (swz % 64) / 2; }
__host__ __device__ __forceinline__ int perm32(int rho) { const int n = rho >> 4, i = rho & 15; return 8 * (i >> 2) + 4 * n + (i & 3); }

struct Unit { int pm, pn, kh; };
struct Gemm { const bf16_t* A; const bf16_t* Bt; int ldk; int nt; };

struct StaticOrder {
    int nM, nN, nwg, G, c, nkh;
    __device__ void init(int M, int N, int G_, int c_, int nkh_) { nM = M / BM; nN = N / BM; nwg = nM * nN; G = G_; c = c_; nkh = nkh_; }
    __device__ bool next(int i, Unit& u) const {
        const int ti = i / nkh; u.kh = i - ti * nkh;
        const long L = (long)ti * G + c; if (L >= nwg) return false;
        int wgid = (int)L; { const int q = nwg / NXCD, r = nwg % NXCD, xcd = wgid % NXCD, off = wgid / NXCD; wgid = (xcd < r ? xcd * (q + 1) : r * (q + 1) + (xcd - r) * q) + off; }
        const int nig = WGM * nN, gid = wgid / nig, fm = gid * WGM, gsz = (nM - fm) < WGM ? (nM - fm) : WGM;
        u.pm = fm + ((wgid % nig) % gsz); u.pn = (wgid % nig) / gsz; return true;
    }
};


struct EpiInProj {
    static constexpr bool PERM = true;
    bf16_t *QA, *KA, *VA, *SZA, *QB, *KB, *VB, *SZB, *SMA, *SMB;
    float* out;
    unsigned* knorm;
    __device__ __forceinline__ bool keep(const Unit&) const { return false; }
    __device__ __forceinline__ void operator()(f32x4 (&acc)[2][2][4][2], const Unit& u, int wr, int wc, int fr, int fq) const {
        const int pn = u.pn, pm = u.pm;
        bf16_t* dst; int ldd, dcol, actk; float* f32p = nullptr; int fmode = 0, nvalid = 256; bool dnorm = false; int noff = 0;
        const bool sample = (pm == 128);
        if (pn < 16) {
            const int seg = pn >> 1; dcol = (pn & 1) * 256; ldd = 512;
            if (seg == 0) { dst = QA; actk = 1; }
            else if (seg == 1) { dst = KA; actk = 0; }
            else if (seg == 2) { dst = VA; actk = 0; }
            else if (seg == 3) { dst = SZA; actk = 2; }
            else if (seg == 4) { dst = QB; actk = 1; }
            else if (seg == 5) { dst = KB; actk = 0; }
            else if (seg == 6) { dst = VB; actk = 0; }
            else { dst = SZB; actk = 2; }
            if (seg == 1 || seg == 2) {
                if (!sample) { const int bt = pm & 63; if (bt >= 62) { f32p = out + (seg == 1 ? O_AKP : O_AVP) + ((size_t)((pm >> 6) * 512 + (bt - 62) * 256)) * 512 + dcol; fmode = 1; } }
                else { f32p = out + (seg == 1 ? O_AKS : O_AVS) + dcol; fmode = 2; nvalid = 128; }
            } else if (seg == 4) { if (!sample) { dnorm = true; noff = 32; }
            } else if (seg == 5 || seg == 6) {
                if (!sample) { f32p = out + (seg == 5 ? O_BKP : O_BVP) + (size_t)pm * 256 * 512 + dcol; fmode = 1; dnorm = (seg == 5); }
                else { f32p = out + (seg == 5 ? O_BKS : O_BVS) + dcol; fmode = 1; nvalid = 128; }
            }
        } else { ldd = 1024; actk = 3; if (pn < 20) { dst = SMA; dcol = (pn - 16) * 256; } else { dst = SMB; dcol = (pn - 20) * 256; } }
        const int rl0 = wr * 64 + fr, cl = wc * 32 + 8 * fq;
        if (dnorm) {
#pragma unroll
            for (int bj = 0; bj < 2; ++bj) { float mx = 0.f;
#pragma unroll
                for (int ai = 0; ai < 2; ++ai)
#pragma unroll
                    for (int m = 0; m < 4; ++m) { const f32x4 a = acc[ai][bj][m][0], b = acc[ai][bj][m][1];
                        float s = (a[0] * a[0] + a[1] * a[1]) + (a[2] * a[2] + a[3] * a[3]) + (b[0] * b[0] + b[1] * b[1]) + (b[2] * b[2] + b[3] * b[3]);
                        s += __shfl_xor(s, 16); s += __shfl_xor(s, 32); mx = fmaxf(mx, s); }
                mx = fmaxf(mx, __shfl_xor(mx, 1)); mx = fmaxf(mx, __shfl_xor(mx, 2)); mx = fmaxf(mx, __shfl_xor(mx, 4)); mx = fmaxf(mx, __shfl_xor(mx, 8));
                if (fr == 0 && fq == 0) { const int head = (pn & 1) * 4 + bj * 2 + (wc >> 1);
                    __hip_atomic_fetch_max(knorm + noff + (((pm >> 6) * 8 + head) * 2 + (wc & 1)), __float_as_uint(mx), __ATOMIC_RELAXED, __HIP_MEMORY_SCOPE_AGENT); }
            }
        }
#pragma unroll
        for (int ai = 0; ai < 2; ++ai)
#pragma unroll
            for (int m = 0; m < 4; ++m) { const int rl = rl0 + ai * HALF + m * 16; const size_t grow = (size_t)pm * BM + rl;
#pragma unroll
                for (int bj = 0; bj < 2; ++bj) { f32x4 v0 = acc[ai][bj][m][0], v1 = acc[ai][bj][m][1];
                    if (f32p != nullptr && rl < nvalid) { const size_t ro = (fmode == 1) ? (size_t)rl * 512 : ((size_t)((rl >> 4) * 512 + 496 + (rl & 15))) * 512;
                        *(f32x4*)(f32p + ro + cl + bj * HALF) = v0; *(f32x4*)(f32p + ro + cl + bj * HALF + 4) = v1; }
                    if (actk == 1) { v0 = v0 * C2; v1 = v1 * C2; }
                    else if (actk == 2) {
#pragma unroll
                        for (int e = 0; e < 4; ++e) { v0[e] = v0[e] * sigmoidf_(v0[e]); v1[e] = v1[e] * sigmoidf_(v1[e]); } }
                    else if (actk == 3) {
#pragma unroll
                        for (int e = 0; e < 4; ++e) { v0[e] = sigmoidf_(v0[e]); v1[e] = sigmoidf_(v1[e]); } }
                    u32x4 w; w.x = cvtpk(v0[0], v0[1]); w.y = cvtpk(v0[2], v0[3]); w.z = cvtpk(v1[0], v1[1]); w.w = cvtpk(v1[2], v1[3]);
                    *(u32x4*)(dst + grow * ldd + dcol + cl + bj * HALF) = w; } }
    }
};
struct EpiMerge {
    static constexpr bool PERM = true;
    const bf16_t *SMA, *SMB; bf16_t* MG;
    __device__ __forceinline__ bool keep(const Unit& u) const { return u.kh == 0; }
    __device__ __forceinline__ void operator()(f32x4 (&acc)[2][2][4][2], const Unit& u, int wr, int wc, int fr, int fq) const {
        const int rl0 = wr * 64 + fr, cl = wc * 32 + 8 * fq;
        const size_t off0 = ((size_t)u.pm * BM + rl0) * 1024 + u.pn * BM + cl;
#pragma unroll
        for (int ai = 0; ai < 2; ++ai) {
            u32x4 sb[4][2], sa[4][2];
#pragma unroll
            for (int m = 0; m < 4; ++m)
#pragma unroll
                for (int bj = 0; bj < 2; ++bj) { const size_t off = off0 + (size_t)(ai * HALF + m * 16) * 1024 + bj * HALF;
                    sb[m][bj] = *(const u32x4*)(SMB + off); if (u.kh == 0) sa[m][bj] = *(const u32x4*)(SMA + off); }
#pragma unroll
            for (int m = 0; m < 4; ++m)
#pragma unroll
                for (int bj = 0; bj < 2; ++bj) { const size_t off = off0 + (size_t)(ai * HALF + m * 16) * 1024 + bj * HALF;
                    const u32x4 b4 = sb[m][bj];
                    float g[8] = {bflo(b4.x), bfhi(b4.x), bflo(b4.y), bfhi(b4.y), bflo(b4.z), bfhi(b4.z), bflo(b4.w), bfhi(b4.w)};
                    if (u.kh == 0) { const u32x4 a4 = sa[m][bj];
                        const float a[8] = {bflo(a4.x), bfhi(a4.x), bflo(a4.y), bfhi(a4.y), bflo(a4.z), bfhi(a4.z), bflo(a4.w), bfhi(a4.w)};
#pragma unroll
                        for (int e = 0; e < 8; ++e) g[e] = a[e] * __builtin_amdgcn_rcpf(g[e]);
#pragma unroll
                        for (int e = 0; e < 4; ++e) { acc[ai][bj][m][0][e] *= g[e]; acc[ai][bj][m][1][e] *= g[4 + e]; }
                    } else { f32x4 v0 = acc[ai][bj][m][0], v1 = acc[ai][bj][m][1];
#pragma unroll
                        for (int e = 0; e < 4; ++e) { v0[e] *= g[e]; v1[e] *= g[4 + e]; }
                        u32x4 w; w.x = cvtpk(v0[0], v0[1]); w.y = cvtpk(v0[2], v0[3]); w.z = cvtpk(v1[0], v1[1]); w.w = cvtpk(v1[2], v1[3]);
                        *(u32x4*)(MG + off) = w; } }
        }
    }
};
struct EpiF32 {
    static constexpr bool PERM = false;
    float* C; int ldc;
    __device__ __forceinline__ bool keep(const Unit&) const { return false; }
    __device__ __forceinline__ void operator()(f32x4 (&acc)[2][2][4][2], const Unit& u, int wr, int wc, int fr, int fq) const {
        const int row0 = u.pm * BM + wr * 64 + fr, col0 = u.pn * BM + wc * 32 + 4 * fq;
#pragma unroll
        for (int ai = 0; ai < 2; ++ai)
#pragma unroll
            for (int m = 0; m < 4; ++m) { float* rowp = C + (size_t)(row0 + ai * HALF + m * 16) * ldc + col0;
#pragma unroll
                for (int bj = 0; bj < 2; ++bj)
#pragma unroll
                    for (int n = 0; n < 2; ++n) *(f32x4*)(rowp + bj * HALF + n * 16) = acc[ai][bj][m][n]; }
    }
};

template <class Epi, class Sched>
__device__ __forceinline__ void gemm_phase(PG8_LAS unsigned char* lds, const Gemm g, const Sched& S, const Epi& E) {
    const int tid = fresh_tid(), wid = __builtin_amdgcn_readfirstlane(tid >> 6), lane = tid & 63, wr = wid >> 2, wc = wid & 3, fr = lane & 15, fq = lane >> 4;
    const int K = g.ldk, nt = g.nt;
    unsigned voffA[2], voffB[2];
#pragma unroll
    for (int i = 0; i < 2; ++i) { int R, C; stage_rc(tid * 16 + i * 8192, R, C); const int Rb = Epi::PERM ? ((R & ~31) + perm32(R & 31)) : R;
        voffA[i] = (unsigned)(R * K + C) * 2u; voffB[i] = (unsigned)(Rb * K + C) * 2u; }
    const size_t kstep = (size_t)(BK * 2);
    const size_t hstep = (size_t)HALF * K * 2;
    const size_t tstep = 2 * hstep;
    const size_t khb = (size_t)nt * BK * 2;
    const unsigned ldsw = (unsigned)wid * 1024u;
    const int aoff = lds_byte(wr * 64 + fr, fq * 8), boff = lds_byte(wc * 32 + fr, fq * 8);
#define PG8_SA(b, h) (((b) * 2 + (h)) * HTB)
#define PG8_SB(b, h) ((4 + (b) * 2 + (h)) * HTB)
#define PG8_STAGE(bufoff, gbase, voff) do { _Pragma("unroll") for (int _i = 0; _i < 2; ++_i) \
        __builtin_amdgcn_global_load_lds((const unsigned*)((const char*)(gbase) + (voff)[_i]), (PG8_LAS unsigned*)(lds + (bufoff) + ldsw + _i * 8192), 16, 0, 0); } while (0)
#define PG8_LDA(dst, b, h) do { _Pragma("unroll") for (int m = 0; m < 4; ++m) _Pragma("unroll") for (int k = 0; k < 2; ++k) dst[m][k] = *(const PG8_LAS bf16x8*)(lds + PG8_SA(b, h) + aoff + m * 2048 + k * 1024); } while (0)
#define PG8_LDB(dst, b, h) do { _Pragma("unroll") for (int n = 0; n < 2; ++n) _Pragma("unroll") for (int k = 0; k < 2; ++k) dst[n][k] = *(const PG8_LAS bf16x8*)(lds + PG8_SB(b, h) + boff + n * 2048 + k * 1024); } while (0)
#define PG8_MMA(ai, bj, At, Bt) do { __builtin_amdgcn_s_setprio(1); _Pragma("unroll") for (int m = 0; m < 4; ++m) _Pragma("unroll") for (int n = 0; n < 2; ++n) _Pragma("unroll") for (int k = 0; k < 2; ++k) \
        acc[ai][bj][m][n] = __builtin_amdgcn_mfma_f32_16x16x32_bf16(Bt[n][k], At[m][k], acc[ai][bj][m][n], 0, 0, 0); __builtin_amdgcn_s_setprio(0); } while (0)
#define PG8_WAIT_V(n) asm volatile("s_waitcnt vmcnt(" #n ")" ::: "memory")
#define PG8_WAIT_L(n) asm volatile("s_waitcnt lgkmcnt(" #n ")" ::: "memory")
#define PG8_BAR __builtin_amdgcn_s_barrier()
#define PG8_SCHED __builtin_amdgcn_sched_barrier(0)
    Unit cur, nxt; int ui = 0;
    if (!S.next(0, cur)) return;
    f32x4 acc[2][2][4][2];
#pragma unroll
    for (int a = 0; a < 2; ++a)
#pragma unroll
        for (int b = 0; b < 2; ++b)
#pragma unroll
            for (int m = 0; m < 4; ++m)
#pragma unroll
                for (int n = 0; n < 2; ++n) acc[a][b][m][n] = (f32x4){0.f, 0.f, 0.f, 0.f};
    bf16x8 At[4][2], B0[2][2], B1[2][2];
    const char* cA = (const char*)g.A + (size_t)cur.pm * tstep + (size_t)cur.kh * khb; const char* cB = (const char*)g.Bt + (size_t)cur.pn * tstep + (size_t)cur.kh * khb;
    PG8_STAGE(PG8_SB(0, 0), cB, voffB); PG8_STAGE(PG8_SB(0, 1), cB + hstep, voffB); PG8_STAGE(PG8_SA(0, 0), cA, voffA); PG8_STAGE(PG8_SA(0, 1), cA + hstep, voffA);
    if (wr == 1) PG8_BAR;
    PG8_WAIT_V(2); PG8_BAR;
    PG8_STAGE(PG8_SB(1, 0), cB + kstep, voffB); PG8_STAGE(PG8_SA(1, 0), cA + kstep, voffA); PG8_STAGE(PG8_SB(1, 1), cB + hstep + kstep, voffB);
    PG8_WAIT_V(6); PG8_BAR;
    for (;;) {
        const bool has_next = S.next(ui + 1, nxt);
        const char* nA = has_next ? (const char*)g.A + (size_t)nxt.pm * tstep + (size_t)nxt.kh * khb : cA; const char* nB = has_next ? (const char*)g.Bt + (size_t)nxt.pn * tstep + (size_t)nxt.kh * khb : cB;
        for (int t = 0; t < nt; t += 2) {
            const bool last = (t == nt - 2);
            const char* a1 = cA + (size_t)(t + 1) * kstep;
            const char* a2 = last ? nA : cA + (size_t)(t + 2) * kstep; const char* b2 = last ? nB : cB + (size_t)(t + 2) * kstep;
            const char* a3 = a2 + kstep; const char* b3 = b2 + kstep;
            PG8_LDB(B0, 0, 0); PG8_LDB(B1, 0, 1); PG8_SCHED; PG8_LDA(At, 0, 0); PG8_STAGE(PG8_SA(1, 1), a1 + hstep, voffA);
            PG8_WAIT_V(8); PG8_WAIT_L(0); PG8_BAR; PG8_MMA(0, 0, At, B0); PG8_MMA(0, 1, At, B1); PG8_BAR; PG8_SCHED;
            PG8_LDA(At, 0, 1); PG8_STAGE(PG8_SB(0, 0), b2, voffB); PG8_STAGE(PG8_SB(0, 1), b2 + hstep, voffB); PG8_STAGE(PG8_SA(0, 0), a2, voffA);
            PG8_WAIT_V(8); PG8_WAIT_L(0); PG8_BAR; PG8_MMA(1, 0, At, B0); PG8_MMA(1, 1, At, B1); PG8_BAR; PG8_SCHED;
            PG8_LDB(B0, 1, 0); PG8_LDB(B1, 1, 1); PG8_SCHED; PG8_LDA(At, 1, 0); PG8_STAGE(PG8_SA(0, 1), a2 + hstep, voffA);
            PG8_WAIT_V(8); PG8_WAIT_L(0); PG8_BAR; PG8_MMA(0, 0, At, B0); PG8_MMA(0, 1, At, B1); PG8_BAR; PG8_SCHED;
            PG8_LDA(At, 1, 1); PG8_STAGE(PG8_SB(1, 0), b3, voffB); PG8_STAGE(PG8_SB(1, 1), b3 + hstep, voffB); PG8_STAGE(PG8_SA(1, 0), a3, voffA);
            PG8_WAIT_V(8); PG8_WAIT_L(0); PG8_BAR; PG8_MMA(1, 0, At, B0); PG8_MMA(1, 1, At, B1); PG8_BAR; PG8_SCHED;
        }
        if (wr == 0) PG8_BAR;
        E(acc, cur, wr, wc, fr, fq);
        if (!has_next) break;
        if (!E.keep(cur)) {
#pragma unroll
            for (int a = 0; a < 2; ++a)
#pragma unroll
                for (int b = 0; b < 2; ++b)
#pragma unroll
                    for (int m = 0; m < 4; ++m)
#pragma unroll
                        for (int n = 0; n < 2; ++n) acc[a][b][m][n] = (f32x4){0.f, 0.f, 0.f, 0.f};
        }
        cur = nxt; cA = nA; cB = nB; ++ui;
        if (wr == 1) PG8_BAR;
    }
    PG8_WAIT_V(0);
    PG8_BAR;
#undef PG8_SA
#undef PG8_SB
#undef PG8_STAGE
#undef PG8_LDA
#undef PG8_LDB
#undef PG8_MMA
#undef PG8_WAIT_V
#undef PG8_WAIT_L
#undef PG8_BAR
#undef PG8_SCHED
}
}

#define XB_TMO      128
#define XB_XCNT(j)  (256  + 64 * (j))
#define XB_XSUB(j)  (1280 + 64 * (j))
#define XB_XGEN(j)  (2304 + 64 * (j))
#define XB_TOP      3328
#define XB_TOPGEN   3392
#define XCD_BAR_WORDS 3456
#define XB_SPIN_CAP (1u << 18)
__device__ __forceinline__ unsigned xb_ld(unsigned* p)              { return __hip_atomic_load(p, __ATOMIC_RELAXED, __HIP_MEMORY_SCOPE_AGENT); }
__device__ __forceinline__ unsigned xb_add(unsigned* p, unsigned v) { return __hip_atomic_fetch_add(p, v, __ATOMIC_RELAXED, __HIP_MEMORY_SCOPE_AGENT); }
__device__ __forceinline__ unsigned xb_xcc_id() { return (unsigned)__builtin_amdgcn_s_getreg((3 << 11) | 20) & 0xFu; }
#define XB_SPIN(cond, bar) do { unsigned _sp = 0; while (cond) { __builtin_amdgcn_s_sleep(1); \
    if ((++_sp & 255u) == 0u) { if (xb_ld(&(bar)[XB_TMO])) break; if (_sp > XB_SPIN_CAP) { atomicAdd(&(bar)[XB_TMO], 1u); break; } } } } while (0)
struct XcdBarrier { unsigned* bar; unsigned x; volatile LAS unsigned* st; };
__device__ __forceinline__ XcdBarrier xcd_barrier_post(unsigned* bar, volatile LAS unsigned* st) {
    XcdBarrier b; b.bar = bar; b.x = xb_xcc_id(); b.st = st;
    if (threadIdx.x == 0) (void)xb_add(&bar[XB_XCNT(b.x)], 1u);
    return b;
}
__device__ __forceinline__ void xcd_barrier_complete(unsigned* bar, unsigned x, unsigned& nloc, unsigned& nx) {
    const unsigned G = gridDim.x * gridDim.y * gridDim.z;
    unsigned sum, cnt, mine, sp = 0u;
    for (;;) {
        sum = 0u; cnt = 0u; mine = 0u;
#pragma unroll
        for (unsigned j = 0; j < 16; ++j) { const unsigned c = xb_ld(&bar[XB_XCNT(j)]); sum += c; cnt += (c > 0u) ? 1u : 0u; mine = (j == x) ? c : mine; }
        if (sum == G) break;
        __builtin_amdgcn_s_sleep(1);
        if ((++sp & 255u) == 0u) { if (xb_ld(&bar[XB_TMO])) break; if (sp > XB_SPIN_CAP) { atomicAdd(&bar[XB_TMO], 1u); break; } }
    }
    nloc = mine > 0u ? mine : 1u; nx = cnt > 0u ? cnt : 1u;
}
__device__ __forceinline__ void xcd_barrier(const XcdBarrier& b) {
    asm volatile("s_waitcnt vmcnt(0)" ::: "memory");
    __syncthreads();
    if (threadIdx.x == 0) {
        unsigned* bar = b.bar;
        __builtin_amdgcn_s_waitcnt(0);
        unsigned nloc = b.st[0], nx = b.st[1];
        if (nloc == 0u) { xcd_barrier_complete(bar, b.x, nloc, nx); b.st[0] = nloc; b.st[1] = nx; }
        const unsigned old = xb_add(&bar[XB_XSUB(b.x)], 1u);
        const unsigned gen = old / nloc;
        if (old + 1u == (gen + 1u) * nloc) {
            __builtin_amdgcn_fence(__ATOMIC_RELEASE, "agent");
            asm volatile("s_waitcnt vmcnt(0)" ::: "memory");
            const unsigned og = xb_add(&bar[XB_TOP], 1u);
            const unsigned tg = og / nx;
            if (og + 1u == (tg + 1u) * nx) xb_add(&bar[XB_TOPGEN], 1u);
            else XB_SPIN(xb_ld(&bar[XB_TOPGEN]) == tg, bar);
            __builtin_amdgcn_fence(__ATOMIC_ACQUIRE, "agent");
            xb_add(&bar[XB_XGEN(b.x)], 1u);
            asm volatile("s_waitcnt vmcnt(0)" ::: "memory");
        } else {
            XB_SPIN(xb_ld(&bar[XB_XGEN(b.x)]) == gen, bar);
            __builtin_amdgcn_fence(__ATOMIC_ACQUIRE, "agent");
            asm volatile("s_waitcnt vmcnt(0)" ::: "memory");
        }
    }
    __syncthreads();
}

struct Args { const float* in[15]; float* out; unsigned char* ws; };

__device__ __forceinline__ float wave_sum(float v) {
#pragma unroll
    for (int o = 1; o < 64; o <<= 1) v += __shfl_xor(v, o);
    return v;
}
__device__ __forceinline__ float wave_max(float v) {
#pragma unroll
    for (int o = 1; o < 64; o <<= 1) v = fmaxf(v, __shfl_xor(v, o));
    return v;
}

__device__ __forceinline__ void p0_transpose_item(const float* W, int ldw, int csrc, bf16* WT, int ldt, int kdst, int nrow0, LAS float* scr, int k0, int lane) {
#pragma unroll 8
    for (int i = 0; i < 32; ++i) { const int kk = 2 * i + (lane >> 5); scr[kk * 33 + (lane & 31)] = W[(size_t)(k0 + kk) * ldw + csrc + (lane & 31)]; }
    asm volatile("s_waitcnt lgkmcnt(0)" ::: "memory");
    const int c = lane & 7;
#pragma unroll
    for (int j = 0; j < 4; ++j) { const int n = (lane >> 3) + 8 * j; const LAS float* s = scr + (8 * c) * 33 + n;
        v4u o; o.x = cvtpk(s[0 * 33], s[1 * 33]); o.y = cvtpk(s[2 * 33], s[3 * 33]); o.z = cvtpk(s[4 * 33], s[5 * 33]); o.w = cvtpk(s[6 * 33], s[7 * 33]);
        *(GAS v4u*)(WT + (size_t)(nrow0 + n) * ldt + kdst + k0 + 8 * c) = o; }
    asm volatile("s_waitcnt lgkmcnt(0)" ::: "memory");
}

namespace att {
typedef LAS const unsigned char* ldsc;
__device__ __forceinline__ int crow(int r, int hi) { return (r & 3) + 8 * (r >> 2) + 4 * hi; }
#define MFMA32(a, b, c) __builtin_amdgcn_mfma_f32_32x32x16_bf16(a, b, c, 0, 0, 0)
__device__ __forceinline__ s16x4 vtr(ldsc p) { return __builtin_bit_cast(s16x4, __builtin_amdgcn_ds_read_tr16_b64_v4i16((LAS v4i16_t*)p)); }

__device__ __forceinline__ void qkt(f32x16& p0, f32x16& p1, ldsc Kslot, const bf16x8* qr, const f32x16& c0, const f32x16& c1, int r32, int hi) {
    ldsc kb = Kslot + hi * 1024 + r32 * 16;
#pragma unroll
    for (int d0 = 0; d0 < 4; ++d0) {
        const bf16x8 b0 = *(LAS const bf16x8*)(kb + d0 * 2048);
        const bf16x8 b1 = *(LAS const bf16x8*)(kb + d0 * 2048 + 512);
        if (d0 == 0) { p0 = MFMA32(b0, qr[0], c0); p1 = MFMA32(b1, qr[0], c1); }
        else { p0 = MFMA32(b0, qr[d0], p0); p1 = MFMA32(b1, qr[d0], p1); } }
}
__device__ __forceinline__ float rowmax(const f32x16& p0, const f32x16& p1) {
    float a = fmaxf(p0[0], p1[0]);
#pragma unroll
    for (int r = 1; r < 16; ++r) a = fmaxf(a, fmaxf(p0[r], p1[r]));
    auto rr = __builtin_amdgcn_permlane32_swap(__float_as_uint(a), __float_as_uint(a), false, false);
    return fmaxf(__uint_as_float(rr[0]), __uint_as_float(rr[1]));
}
__device__ __forceinline__ float halfsum(float a) {
    auto rr = __builtin_amdgcn_permlane32_swap(__float_as_uint(a), __float_as_uint(a), false, false);
    return __uint_as_float(rr[0]) + __uint_as_float(rr[1]);
}
__device__ __forceinline__ void softmax_pv(f32x16& p0, f32x16& p1, f32x16 (&o)[2], float& m_run, float& l_run, LAS float* wsf, ldsc Vslot, int lane, int r32, int hi) {
    const float rm = rowmax(p0, p1);
    const float mn = fmaxf(m_run, rm); const float alpha = fexp2(m_run - mn); m_run = mn;
    float s = 0.f;
#pragma unroll
    for (int r = 0; r < 16; ++r) { p0[r] = fexp2(p0[r] - mn); p1[r] = fexp2(p1[r] - mn); s += p0[r] + p1[r]; }
    l_run = l_run * alpha + s;
    if (hi == 0) wsf[r32] = alpha;
#pragma unroll
    for (int g = 0; g < 4; ++g) { const f32x4 a4 = *(LAS const f32x4*)(wsf + 8 * g + 4 * hi);
#pragma unroll
        for (int j = 0; j < 4; ++j) { o[0][4 * g + j] *= a4[j]; o[1][4 * g + j] *= a4[j]; } }
    bf16x8 pa[4];
    { v4u w;
      w.x = cvtpk(p0[0], p0[1]); w.y = cvtpk(p0[2], p0[3]); w.z = cvtpk(p0[4], p0[5]); w.w = cvtpk(p0[6], p0[7]); pa[0] = __builtin_bit_cast(bf16x8, w);
      w.x = cvtpk(p0[8], p0[9]); w.y = cvtpk(p0[10], p0[11]); w.z = cvtpk(p0[12], p0[13]); w.w = cvtpk(p0[14], p0[15]); pa[1] = __builtin_bit_cast(bf16x8, w);
      w.x = cvtpk(p1[0], p1[1]); w.y = cvtpk(p1[2], p1[3]); w.z = cvtpk(p1[4], p1[5]); w.w = cvtpk(p1[6], p1[7]); pa[2] = __builtin_bit_cast(bf16x8, w);
      w.x = cvtpk(p1[8], p1[9]); w.y = cvtpk(p1[10], p1[11]); w.z = cvtpk(p1[12], p1[13]); w.w = cvtpk(p1[14], p1[15]); pa[3] = __builtin_bit_cast(bf16x8, w); }
    ldsc vp = Vslot + ((lane >> 4) & 1) * 32 + (lane & 3) * 8 + (4 * hi + ((lane & 15) >> 2)) * 64;
#pragma unroll
    for (int d0 = 0; d0 < 2; ++d0)
#pragma unroll
        for (int ks = 0; ks < 4; ++ks) { const s16x4 lo = vtr(vp + d0 * 4096 + ks * 1024), hh = vtr(vp + d0 * 4096 + ks * 1024 + 512);
            const bf16x8 vb = (bf16x8){lo[0], lo[1], lo[2], lo[3], hh[0], hh[1], hh[2], hh[3]};
            o[d0] = MFMA32(pa[ks], vb, o[d0]); }
}
__device__ __forceinline__ v4u mul8(v4u a, v4u z) {
    v4u r; r.x = cvtpk(bflo(a.x) * bflo(z.x), bfhi(a.x) * bfhi(z.x)); r.y = cvtpk(bflo(a.y) * bflo(z.y), bfhi(a.y) * bfhi(z.y));
    r.z = cvtpk(bflo(a.z) * bflo(z.z), bfhi(a.z) * bfhi(z.z)); r.w = cvtpk(bflo(a.w) * bflo(z.w), bfhi(a.w) * bfhi(z.w)); return r;
}

struct Ctx {
    LAS unsigned char* lds;
    const bf16 *QA, *KA, *VA, *QB, *KB, *VB, *SZA, *SZB; bf16* G;
    const float *Fp, *Fs, *rel; const float *cak, *cav, *cbk, *cbv;
    const unsigned* knorm;
};

constexpr int PL_K = 0, PL_V = 24576, PL_F = 49152, PL_BT = 51200, PL_OST = 77824, SLOTB = 8192;
__device__ __forceinline__ void glds16(const void* gsrc, unsigned lds_dst) { unsigned keep;
    asm volatile("s_mov_b32 %0, m0\n\ts_mov_b32 m0, %2\n\ts_nop 0\n\tglobal_load_lds_dwordx4 %1, off\n\ts_mov_b32 m0, %0" : "=&s"(keep) : "v"(gsrc), "s"(lds_dst) : "memory"); }
__device__ __forceinline__ void glds4(const void* gsrc, unsigned lds_dst) { unsigned keep;
    asm volatile("s_mov_b32 %0, m0\n\ts_mov_b32 m0, %2\n\ts_nop 0\n\tglobal_load_lds_dword %1, off\n\ts_mov_b32 m0, %0" : "=&s"(keep) : "v"(gsrc), "s"(lds_dst) : "memory"); }
typedef LAS const char* lds_cptr;
__device__ __forceinline__ void kload8(bf16x8* kf, lds_cptr kp) {
    kf[0] = *(LAS const bf16x8*)(kp);        kf[1] = *(LAS const bf16x8*)(kp + 512);
    kf[2] = *(LAS const bf16x8*)(kp + 2048); kf[3] = *(LAS const bf16x8*)(kp + 2560);
    kf[4] = *(LAS const bf16x8*)(kp + 4096); kf[5] = *(LAS const bf16x8*)(kp + 4608);
    kf[6] = *(LAS const bf16x8*)(kp + 6144); kf[7] = *(LAS const bf16x8*)(kp + 6656);
}
__device__ __forceinline__ void kload2(bf16x8* kf, lds_cptr kp, int j) { kf[2 * j] = *(LAS const bf16x8*)(kp + j * 2048); kf[2 * j + 1] = *(LAS const bf16x8*)(kp + j * 2048 + 512); }
__device__ __forceinline__ s16x4 vtr2(lds_cptr p) { return __builtin_bit_cast(s16x4, __builtin_amdgcn_ds_read_tr16_b64_v4i16((LAS v4i16_t*)p)); }
#define SBAR() __builtin_amdgcn_sched_barrier(0)
#define PIN(x) asm volatile("" : "+v"(x))
#define WAITB(N) asm volatile("s_waitcnt vmcnt(" #N ") lgkmcnt(0)\n\ts_barrier" ::: "memory")

template <int KIND, int THRL>
__device__ __forceinline__ void prompt_unit(const Ctx& X, int b, int h, int qb) {
    const int tid = fresh_tid(), lane = tid & 63, r32 = lane & 31, hi = lane >> 5; const int wid = __builtin_amdgcn_readfirstlane(tid >> 6);
    LAS unsigned char* lds = X.lds;
    const bf16* Q = KIND ? X.QA : X.QB; const bf16* Kt = KIND ? X.KA : X.KB; const bf16* Vt = KIND ? X.VA : X.VB; const bf16* SZ = KIND ? X.SZA : X.SZB;
    const size_t rowbase = (size_t)b * SEQ; const int q0 = qb * 256;
    const bf16* Qw = Q + (rowbase + q0 + wid * 32) * 512 + h * 64;
    const unsigned lds0 = (unsigned)(uintptr_t)lds;
    LAS float* wsf = (LAS float*)(lds + WSF_OFF) + wid * 64;
    const float* Fbh = X.Fp + (size_t)(b * 8 + h) * SEQ;
    int j_lo; const int j_hi = 4 * qb + 3; float Fq0L = 0.f;
    if (KIND == 0) {
        const float kn = __uint_as_float(__hip_atomic_load(X.knorm + ((b * 8 + h) * 2), RLX_AGENT)) + __uint_as_float(__hip_atomic_load(X.knorm + ((b * 8 + h) * 2) + 1, RLX_AGENT));
        const float qn = __uint_as_float(__hip_atomic_load(X.knorm + 32 + ((b * 8 + h) * 2), RLX_AGENT)) + __uint_as_float(__hip_atomic_load(X.knorm + 32 + ((b * 8 + h) * 2) + 1, RLX_AGENT));
        const float thr = 2.0f * C2 * sqrtf(qn * kn) * 1.02f + 40.0f;
        const float Fq0 = Fbh[q0]; Fq0L = Fq0 * L2E;
        int cnt = 0, base = 4 * qb - 1;
        for (;;) {
            const int jb = base - lane; bool ok = false;
            if (jb >= 0) ok = (Fq0 - Fbh[64 * jb + 63]) * L2E >= -thr;
            const unsigned long long mk = __ballot(ok);
            const int c = (mk == ~0ull) ? 64 : __builtin_ctzll(~mk);
            cnt += c; if (c < 64) break; base -= 64; if (base < 0) break;
        }
        j_lo = 4 * qb - cnt; if (j_lo < 0) j_lo = 0;
        if (((j_hi - j_lo + 1) & 1) && j_lo > 0) --j_lo;
        j_lo = __builtin_amdgcn_readfirstlane(j_lo);
    } else {
        j_lo = 4 * qb - 8; if (j_lo < 0) j_lo = 0;
    }
    const int n = j_hi - j_lo + 1;
    int ta, tb;
    if (KIND == 0) { ta = 0; tb = n - 4 + (wid >> 1); }
    else { const int cw = 4 * qb + (wid >> 1); ta = cw - 8; if (ta < 0) ta = 0; ta -= j_lo; tb = cw - j_lo; }
    const bf16* Kh = Kt + (rowbase + (size_t)j_lo * 64) * 512 + h * 64; const bf16* Vh = Vt + (rowbase + (size_t)j_lo * 64) * 512 + h * 64;
    const float* Fj = Fbh + 64 * j_lo;
    const bf16* ksrc = Kh + (size_t)lane * 512 + wid * 8;
    const bf16* vsrc = Vh + (size_t)(16 * (wid & 3) + (lane >> 2)) * 512 + (wid >> 2) * 32 + (lane & 3) * 8;
    const unsigned kdst = lds0 + PL_K + wid * 1024, vdst = lds0 + PL_V + wid * 1024, fdst = lds0 + PL_F;
#define DMA_K(t, slot) glds16(ksrc + (size_t)(t) * 64 * 512, (unsigned)__builtin_amdgcn_readfirstlane(kdst + (slot)))
#define DMA_V(t, slot) glds16(vsrc + (size_t)(t) * 64 * 512, (unsigned)__builtin_amdgcn_readfirstlane(vdst + (slot)))
#define DMA_F(t) do { if (KIND == 0) glds4(Fj + 64 * (t) + lane, (unsigned)__builtin_amdgcn_readfirstlane(fdst + ((t) & 3) * 256)); } while (0)
    const lds_cptr shm3 = (lds_cptr)lds; const lds_cptr kp0 = shm3 + PL_K + hi * 1024 + r32 * 16;
    const lds_cptr vp0 = shm3 + PL_V + ((lane >> 4) & 1) * 32 + (lane & 3) * 8 + (4 * hi + ((lane & 15) >> 2)) * 64;
    LAS const float* BT = (LAS const float*)(lds + PL_BT);
    float c191 = 0.f;
    if (KIND == 1) {
        const float* relh = X.rel + h * NREL;
#pragma unroll
        for (int k = 0; k < 12; ++k) { const int e = tid + 512 * k, di = e >> 10, ln = (e >> 4) & 63, r = e & 15;
            int idx = (32 * di - 32) + (ln & 31) - crow(r, ln >> 5) + 63; idx = min(max(idx, 0), NREL - 1);
            ((LAS float*)(lds + PL_BT))[e] = relh[idx] * L2E; }
        c191 = relh[NREL - 1] * L2E;
    }
    DMA_K(0, 0); DMA_F(0); DMA_V(0, 0); DMA_K(1, SLOTB); DMA_F(1);
    bf16x8 qr[4];
#pragma unroll
    for (int d0 = 0; d0 < 4; ++d0) qr[d0] = *(const bf16x8*)(Qw + (size_t)r32 * 512 + d0 * 16 + hi * 8);
    DMA_K(2, 2 * SLOTB); DMA_F(2);
    float mhat = 0.f, l_reg = 0.f; f32x16 o[2]; o[0] = f32x16{}; o[1] = f32x16{};
    const int qrel = wid * 32 + r32;
    bool resc = false;
    f32x16 pA0, pA1, pB0, pB1; bf16x8 kf[8];
    s16x4 vlo[8], vhi[8]; v4u pw0, pw1, pw2, pw3;
    int sl_prev = 0, sl_cur = 0, sl_next = SLOTB;
#define ROT() do { sl_prev = sl_cur; sl_cur = sl_next; sl_next = (sl_next == 2 * SLOTB) ? 0 : sl_next + SLOTB; } while (0)
#define CINIT(C0, C1, t) do { \
        if (KIND == 0) { LAS const float* fb_ = (LAS const float*)(lds + PL_F + ((t) & 3) * 256); const float base_ = Fq0L - mhat; \
            _Pragma("unroll") for (int g_ = 0; g_ < 4; ++g_) { const f32x4 f0_ = *(LAS const f32x4*)(fb_ + 8 * g_ + 4 * hi), f1_ = *(LAS const f32x4*)(fb_ + 32 + 8 * g_ + 4 * hi); \
                _Pragma("unroll") for (int e_ = 0; e_ < 4; ++e_) { C0[4 * g_ + e_] = __builtin_fmaf(f0_[e_], -L2E, base_); C1[4 * g_ + e_] = __builtin_fmaf(f1_[e_], -L2E, base_); } } \
        } else { const int dl0_ = 32 * (wid & 1) + 64 * (tb - (t)); \
            if (dl0_ >= 160) { const float cc_ = c191 - mhat; _Pragma("unroll") for (int r_ = 0; r_ < 16; ++r_) C0[r_] = cc_; } \
            else { LAS const float* bp_ = BT + (((dl0_ + 32) >> 5) * 64 + lane) * 16; \
                _Pragma("unroll") for (int g_ = 0; g_ < 4; ++g_) { const f32x4 f0_ = *(LAS const f32x4*)(bp_ + 4 * g_); _Pragma("unroll") for (int e_ = 0; e_ < 4; ++e_) C0[4 * g_ + e_] = f0_[e_] - mhat; } } \
            if (dl0_ - 32 >= 160) { const float cc_ = c191 - mhat; _Pragma("unroll") for (int r_ = 0; r_ < 16; ++r_) C1[r_] = cc_; } \
            else { LAS const float* bp_ = BT + (((dl0_) >> 5) * 64 + lane) * 16; \
                _Pragma("unroll") for (int g_ = 0; g_ < 4; ++g_) { const f32x4 f1_ = *(LAS const f32x4*)(bp_ + 4 * g_); _Pragma("unroll") for (int e_ = 0; e_ < 4; ++e_) C1[4 * g_ + e_] = f1_[e_] - mhat; } } \
        } } while (0)
#define CMASK(P0, P1, t) do { if (KIND == 0) { const int jb_ = (t) - (n - 4); if (jb_ >= 0) { const int kb_ = 64 * jb_ + 4 * hi; \
        _Pragma("unroll") for (int r_ = 0; r_ < 16; ++r_) { const int kv_ = kb_ + (r_ & 3) + 8 * (r_ >> 2); if (kv_ > qrel) P0[r_] = -INFINITY; if (kv_ + 32 > qrel) P1[r_] = -INFINITY; } } } } while (0)
#define MX3(a, b, c) __builtin_fmaxf(__builtin_fmaxf((a), (b)), (c))
#define ROWMAX(C0, C1, rm) do { float a_ = MX3(C0[0], C0[1], C1[0]), b_ = MX3(C0[2], C0[3], C1[1]); a_ = MX3(a_, C1[2], C1[3]); \
        _Pragma("unroll") for (int r_ = 4; r_ < 16; r_ += 4) { a_ = MX3(a_, C0[r_], C0[r_ + 1]); b_ = MX3(b_, C0[r_ + 2], C0[r_ + 3]); a_ = MX3(a_, C1[r_], C1[r_ + 1]); b_ = MX3(b_, C1[r_ + 2], C1[r_ + 3]); } \
        rm = __builtin_fmaxf(a_, b_); { auto rr_ = __builtin_amdgcn_permlane32_swap(__float_as_uint(rm), __float_as_uint(rm), false, false); rm = __builtin_fmaxf(__uint_as_float(rr_[0]), __uint_as_float(rr_[1])); } } while (0)
#define FIRST(C0, C1, t) do { CINIT(C0, C1, t); \
        C0 = MFMA32(kf[0], qr[0], C0); C1 = MFMA32(kf[1], qr[0], C1); C0 = MFMA32(kf[2], qr[1], C0); C1 = MFMA32(kf[3], qr[1], C1); \
        C0 = MFMA32(kf[4], qr[2], C0); C1 = MFMA32(kf[5], qr[2], C1); C0 = MFMA32(kf[6], qr[3], C0); C1 = MFMA32(kf[7], qr[3], C1); \
        CMASK(C0, C1, t); float rm_; ROWMAX(C0, C1, rm_); mhat += rm_; \
        _Pragma("unroll") for (int r_ = 0; r_ < 16; ++r_) { C0[r_] = fexp2(C0[r_] - rm_); C1[r_] = fexp2(C1[r_] - rm_); } } while (0)
#define PKW(P, B) cvtpk(P[B], P[B + 1])
#define PAF(k) __builtin_bit_cast(bf16x8, pw##k)
#define VFR(i) (bf16x8){vlo[i][0], vlo[i][1], vlo[i][2], vlo[i][3], vhi[i][0], vhi[i][1], vhi[i][2], vhi[i][3]}
#define GAPA(MF, A0, A1, A2, A3, W0, W1, PW) do { MF; sacc += A0; sacc += A1; sacc += A2; sacc += A3; PIN(sacc); W0; W1; PIN(PW); SBAR(); } while (0)
#define GAPB(MF, Xv, B) do { MF; Xv[B] = fexp2(Xv[B]); Xv[B + 1] = fexp2(Xv[B + 1]); Xv[B + 2] = fexp2(Xv[B + 2]); Xv[B + 3] = fexp2(Xv[B + 3]); PIN(Xv); SBAR(); } while (0)
#define VRD(i) do { vlo[i] = vtr2(vp_ + (((i) >> 2) * 4096 + ((i) & 3) * 1024)); vhi[i] = vtr2(vp_ + (((i) >> 2) * 4096 + ((i) & 3) * 1024 + 512)); } while (0)
#define KRD(G, j) do { if (G) { kload2(kf, kp0 + sl_next, j); SBAR(); } } while (0)
#define DMA_SLOT(t) do { if ((t) + 3 < n) { DMA_K((t) + 3, sl_cur); DMA_F((t) + 3); } if ((t) + 1 < n) { DMA_V((t) + 1, sl_next); } } while (0)
#define STEP(C0, C1, P0, P1, t, GL) do { CINIT(C0, C1, t); SBAR(); \
        const lds_cptr vp_ = vp0 + sl_prev; \
        VRD(0); SBAR(); float sacc = (P0[0] + P0[1]); \
        GAPA(C0 = MFMA32(kf[0], qr[0], C0), P0[2], P0[3], P0[4], P0[5],     pw0[0] = PKW(P0, 0), pw0[1] = PKW(P0, 2), pw0); \
        VRD(4); SBAR(); GAPA(C1 = MFMA32(kf[1], qr[0], C1), P0[6], P0[7], P0[8], P0[9],     pw0[2] = PKW(P0, 4), pw0[3] = PKW(P0, 6), pw0); \
        VRD(1); SBAR(); GAPA(C0 = MFMA32(kf[2], qr[1], C0), P0[10], P0[11], P0[12], P0[13], pw1[0] = PKW(P0, 8), pw1[1] = PKW(P0, 10), pw1); \
        VRD(5); SBAR(); GAPA(C1 = MFMA32(kf[3], qr[1], C1), P0[14], P0[15], P1[0], P1[1],   pw1[2] = PKW(P0, 12), pw1[3] = PKW(P0, 14), pw1); \
        VRD(2); SBAR(); GAPA(C0 = MFMA32(kf[4], qr[2], C0), P1[2], P1[3], P1[4], P1[5],     pw2[0] = PKW(P1, 0), pw2[1] = PKW(P1, 2), pw2); \
        VRD(6); SBAR(); GAPA(C1 = MFMA32(kf[5], qr[2], C1), P1[6], P1[7], P1[8], P1[9],     pw2[2] = PKW(P1, 4), pw2[3] = PKW(P1, 6), pw2); \
        VRD(3); SBAR(); GAPA(C0 = MFMA32(kf[6], qr[3], C0), P1[10], P1[11], P1[12], P1[13], pw3[0] = PKW(P1, 8), pw3[1] = PKW(P1, 10), pw3); \
        VRD(7); SBAR(); GAPA(C1 = MFMA32(kf[7], qr[3], C1), P1[14], P1[15], 0.f, 0.f,       pw3[2] = PKW(P1, 12), pw3[3] = PKW(P1, 14), pw3); \
        l_reg += sacc; \
        DMA_SLOT(t); \
        CMASK(C0, C1, t); \
        { float rm; ROWMAX(C0, C1, rm); resc = false; \
          if (__builtin_expect(__any(rm > (float)THRL), 0)) { const float dl = __builtin_fmaxf(rm, 0.f); mhat += dl; \
            _Pragma("unroll") for (int r_ = 0; r_ < 16; ++r_) { C0[r_] -= dl; C1[r_] -= dl; } \
            const float f = fexp2(-dl); l_reg *= f; if (hi == 0) wsf[r32] = f; resc = true; } } \
        SBAR(); \
        GAPB(o[0] = MFMA32(PAF(0), VFR(0), o[0]), C0, 0); \
        GAPB(o[1] = MFMA32(PAF(0), VFR(4), o[1]), C0, 4); \
        KRD(GL, 0); GAPB(o[0] = MFMA32(PAF(1), VFR(1), o[0]), C0, 8); \
        KRD(GL, 1); GAPB(o[1] = MFMA32(PAF(1), VFR(5), o[1]), C0, 12); \
        KRD(GL, 2); GAPB(o[0] = MFMA32(PAF(2), VFR(2), o[0]), C1, 0); \
        KRD(GL, 3); GAPB(o[1] = MFMA32(PAF(2), VFR(6), o[1]), C1, 4); \
        GAPB(o[0] = MFMA32(PAF(3), VFR(3), o[0]), C1, 8); \
        GAPB(o[1] = MFMA32(PAF(3), VFR(7), o[1]), C1, 12); \
    } while (0)
#define DRAIN(P0, P1) do { float sacc = P0[0] + P0[1]; _Pragma("unroll") for (int r_ = 2; r_ < 16; ++r_) sacc += P0[r_]; _Pragma("unroll") for (int r_ = 0; r_ < 16; ++r_) sacc += P1[r_]; l_reg += sacc; \
        pw0 = (v4u){PKW(P0, 0), PKW(P0, 2), PKW(P0, 4), PKW(P0, 6)}; pw1 = (v4u){PKW(P0, 8), PKW(P0, 10), PKW(P0, 12), PKW(P0, 14)}; \
        pw2 = (v4u){PKW(P1, 0), PKW(P1, 2), PKW(P1, 4), PKW(P1, 6)}; pw3 = (v4u){PKW(P1, 8), PKW(P1, 10), PKW(P1, 12), PKW(P1, 14)}; \
        const lds_cptr vp_ = vp0 + sl_prev; \
        _Pragma("unroll") for (int i_ = 0; i_ < 8; ++i_) { vlo[i_] = vtr2(vp_ + ((i_ >> 2) * 4096 + (i_ & 3) * 1024)); vhi[i_] = vtr2(vp_ + ((i_ >> 2) * 4096 + (i_ & 3) * 1024 + 512)); } \
        o[0] = MFMA32(PAF(0), VFR(0), o[0]); o[1] = MFMA32(PAF(0), VFR(4), o[1]); o[0] = MFMA32(PAF(1), VFR(1), o[0]); o[1] = MFMA32(PAF(1), VFR(5), o[1]); \
        o[0] = MFMA32(PAF(2), VFR(2), o[0]); o[1] = MFMA32(PAF(2), VFR(6), o[1]); o[0] = MFMA32(PAF(3), VFR(3), o[0]); o[1] = MFMA32(PAF(3), VFR(7), o[1]); } while (0)
#define RESC() do { if (resc) { _Pragma("unroll") for (int g_ = 0; g_ < 4; ++g_) { const f32x4 a4_ = *(LAS const f32x4*)(wsf + 8 * g_ + 4 * hi); \
        _Pragma("unroll") for (int e_ = 0; e_ < 4; ++e_) { o[0][4 * g_ + e_] *= a4_[e_]; o[1][4 * g_ + e_] *= a4_[e_]; } } resc = false; } } while (0)
#define CLOSE(t) do { if ((t) + 3 < n) { if (KIND == 0) WAITB(3); else WAITB(2); } else if ((t) + 1 < n) { WAITB(1); } else { WAITB(0); } } while (0)
#define IDLE(t) do { DMA_SLOT(t); if ((t) + 1 >= ta && (t) + 1 <= tb) kload8(kf, kp0 + sl_next); CLOSE(t); ROT(); } while (0)

    if (KIND == 0) WAITB(4); else WAITB(2);
    if (ta == 0) { kload8(kf, kp0); FIRST(pA0, pA1, 0); }
    WAITB(0);
    DMA_K(3, 0); DMA_F(3); DMA_V(1, SLOTB);
    ROT();
    if (1 >= ta && 1 <= tb) kload8(kf, kp0 + sl_cur);
    if (KIND == 0) WAITB(3); else WAITB(2);
    int t = 1;
    if (ta > 0) {
        for (; t < ta; ++t) IDLE(t);
        DMA_SLOT(t); FIRST(pA0, pA1, t); if (t + 1 <= tb) kload8(kf, kp0 + sl_next); CLOSE(t); ROT(); ++t;
    }
    for (; t + 1 <= tb; t += 2) {
        STEP(pB0, pB1, pA0, pA1, t, true); CLOSE(t); RESC(); ROT();
        const bool gl2 = (t + 2 <= tb);
        STEP(pA0, pA1, pB0, pB1, t + 1, gl2); CLOSE(t + 1); RESC(); ROT();
    }
    if (t <= tb) { STEP(pB0, pB1, pA0, pA1, t, false); CLOSE(t); RESC(); ROT(); ++t;
        DMA_SLOT(t); DRAIN(pB0, pB1); CLOSE(t); ROT(); ++t; }
    else { DMA_SLOT(t); DRAIN(pA0, pA1); CLOSE(t); ROT(); ++t; }
    for (; t <= n; ++t) IDLE(t);
    { const float lt = halfsum(l_reg);
      if (hi == 0) wsf[32 + r32] = lt;
      float rli[16];
#pragma unroll
      for (int g = 0; g < 4; ++g) { const f32x4 a4 = *(LAS const f32x4*)(wsf + 32 + 8 * g + 4 * hi);
#pragma unroll
          for (int e = 0; e < 4; ++e) rli[4 * g + e] = __builtin_amdgcn_rcpf(a4[e]); }
      LAS bf16* stg = (LAS bf16*)(lds + PL_OST + wid * 4096);
#pragma unroll
      for (int r = 0; r < 16; ++r) { const int orow = crow(r, hi);
#pragma unroll
          for (int d0 = 0; d0 < 2; ++d0) stg[orow * 64 + d0 * 32 + r32] = (bf16)(cvtpk(o[d0][r] * rli[r], 0.f) & 0xffffu); }
      const size_t grow0 = rowbase + q0 + wid * 32;
#pragma unroll
      for (int i = 0; i < 4; ++i) { const int row = i * 8 + (lane >> 3), ch = lane & 7;
          const v4u v = *(LAS const v4u*)(stg + row * 64 + ch * 8);
          const v4u z = *(const v4u*)(SZ + (grow0 + row) * 512 + h * 64 + ch * 8);
          *(v4u*)(X.G + (grow0 + row) * 1024 + (KIND ? 0 : 512) + h * 64 + ch * 8) = mul8(v, z); } }
    asm volatile("s_waitcnt vmcnt(0) lgkmcnt(0)\n\ts_barrier" ::: "memory");
#undef DMA_K
#undef DMA_V
#undef DMA_F
#undef ROT
#undef CINIT
#undef CMASK
#undef MX3
#undef ROWMAX
#undef FIRST
#undef PKW
#undef PAF
#undef VFR
#undef GAPA
#undef GAPB
#undef VRD
#undef KRD
#undef DMA_SLOT
#undef STEP
#undef DRAIN
#undef RESC
#undef CLOSE
#undef IDLE
}

template <int KIND>
__device__ __forceinline__ void sample_unit(const Ctx& X, int bs, int h) {
    const int tid = fresh_tid(), lane = tid & 63, r32 = lane & 31, hi = lane >> 5; const int wid = __builtin_amdgcn_readfirstlane(tid >> 6);
    LAS unsigned char* lds = X.lds;
    const int ncache = KIND ? AKEEP : PAST, nct = ncache / 64, ntile = nct + 1;
    const float* Kc = (KIND ? X.cak : X.cbk) + ((size_t)bs * ncache * 8 + h) * 64;
    const float* Vc = (KIND ? X.cav : X.cbv) + ((size_t)bs * ncache * 8 + h) * 64;
    const bf16* Q = KIND ? X.QA : X.QB; const bf16* Kn = KIND ? X.KA : X.KB; const bf16* Vn = KIND ? X.VA : X.VB; const bf16* SZ = KIND ? X.SZA : X.SZB;
    const size_t nrow0 = (size_t)MP + 16 * bs;
    LAS float* wsf = (LAS float*)(lds + WSF_OFF) + wid * 64;
    LAS float* tb = (LAS float*)(lds + TB_OFF);
    if (KIND == 1) { if (tid < NREL) tb[tid] = X.rel[h * NREL + tid] * L2E; }
    __syncthreads();
    bf16x8 qr[4];
#pragma unroll
    for (int d0 = 0; d0 < 4; ++d0) qr[d0] = *(const bf16x8*)(Q + (nrow0 + (r32 & 15)) * 512 + h * 64 + d0 * 16 + hi * 8);
    const float* Fsr = X.Fs + (size_t)(bs * 8 + h) * FS_PITCH;
    const float Fref = (KIND == 0) ? Fsr[PAST - 1] : 0.f;
    LAS unsigned char* kslot = lds + wid * 16384; LAS unsigned char* vslot = kslot + 8192;
    float m_run = -1e30f, l_run = 0.f; f32x16 o[2]; o[0] = f32x16{}; o[1] = f32x16{};
    const int tq = r32 & 15;
    for (int t = wid; t < ntile; t += 8) {
        if (t < nct) {
            const float* kr = Kc + (size_t)(t * 64 + (lane >> 4)) * 512 + (lane & 15) * 4; const float* vr = Vc + (size_t)(t * 64 + (lane >> 4)) * 512 + (lane & 15) * 4;
            f32x4 kq[16], vq[16];
#pragma unroll
            for (int i = 0; i < 16; ++i) kq[i] = *(const f32x4*)(kr + (size_t)i * 4 * 512);
#pragma unroll
            for (int i = 0; i < 16; ++i) vq[i] = *(const f32x4*)(vr + (size_t)i * 4 * 512);
            LAS unsigned char* kw = kslot + ((lane & 15) >> 1) * 1024 + (lane >> 4) * 16 + (lane & 1) * 8;
            LAS unsigned char* vw = vslot + ((lane & 15) >> 3) * 4096 + (lane >> 4) * 64 + (lane & 7) * 8;
#pragma unroll
            for (int i = 0; i < 16; ++i) { v2u w; w.x = cvtpk(kq[i][0], kq[i][1]); w.y = cvtpk(kq[i][2], kq[i][3]); *(LAS v2u*)(kw + i * 64) = w; }
#pragma unroll
            for (int i = 0; i < 16; ++i) { v2u w; w.x = cvtpk(vq[i][0], vq[i][1]); w.y = cvtpk(vq[i][2], vq[i][3]); *(LAS v2u*)(vw + i * 256) = w; }
        } else {
#pragma unroll
            for (int c = 0; c < 8; ++c) { v4u wk = (v4u){0u, 0u, 0u, 0u}, wv = wk;
                if (lane < 16) { wk = *(const v4u*)(Kn + (nrow0 + lane) * 512 + h * 64 + c * 8); wv = *(const v4u*)(Vn + (nrow0 + lane) * 512 + h * 64 + c * 8); }
                *(LAS v4u*)(kslot + c * 1024 + lane * 16) = wk;
                *(LAS v4u*)(vslot + (c >> 2) * 4096 + lane * 64 + (c & 3) * 16) = wv; }
        }
        f32x16 c0, c1, p0, p1;
        if (KIND == 0) {
            const float* fb = Fsr + t * 64;
#pragma unroll
            for (int g = 0; g < 4; ++g) { const f32x4 f0 = *(const f32x4*)(fb + 8 * g + 4 * hi), f1 = *(const f32x4*)(fb + 32 + 8 * g + 4 * hi);
#pragma unroll
                for (int e = 0; e < 4; ++e) { c0[4 * g + e] = (Fref - f0[e]) * L2E; c1[4 * g + e] = (Fref - f1[e]) * L2E; } }
        } else { c0 = f32x16{}; c1 = f32x16{}; }
        qkt(p0, p1, (ldsc)kslot, qr, c0, c1, r32, hi);
        if (KIND == 1) {
            const int dist0 = ncache + tq - (64 * t + 4 * hi) + 63;
#pragma unroll
            for (int r = 0; r < 16; ++r) { const int i0 = dist0 - ((r & 3) + 8 * (r >> 2));
                const int a0 = min(max(i0, 0), NREL - 1), a1 = min(max(i0 - 32, 0), NREL - 1);
                p0[r] += tb[a0]; p1[r] += tb[a1]; }
        }
        if (t == nct) {
#pragma unroll
            for (int r = 0; r < 16; ++r) { const int kv = 4 * hi + (r & 3) + 8 * (r >> 2);
                const bool ok = (kv < 16) && (KIND == 1 || kv <= tq);
                if (!ok) p0[r] = -1e30f; p1[r] = -1e30f; }
        }
        softmax_pv(p0, p1, o, m_run, l_run, wsf, (ldsc)vslot, lane, r32, hi);
    }
    const float lt = halfsum(l_run);
    __syncthreads();
    LAS float* OP = (LAS float*)lds;
    LAS float* ML = (LAS float*)(lds + 32768);
    if (lane < 16) { ML[(wid * 16 + lane) * 2] = m_run; ML[(wid * 16 + lane) * 2 + 1] = lt; }
#pragma unroll
    for (int r = 0; r < 8; ++r) { const int q = crow(r, hi);
#pragma unroll
        for (int d0 = 0; d0 < 2; ++d0) OP[(wid * 16 + q) * 64 + d0 * 32 + r32] = o[d0][r]; }
    __syncthreads();
    { const int q = tid >> 5, d = (tid & 31) * 2;
      float M = -1e30f;
#pragma unroll
      for (int w = 0; w < 8; ++w) M = fmaxf(M, ML[(w * 16 + q) * 2]);
      float L = 0.f, a0 = 0.f, a1 = 0.f;
#pragma unroll
      for (int w = 0; w < 8; ++w) { const float f = fexp2(ML[(w * 16 + q) * 2] - M); L += ML[(w * 16 + q) * 2 + 1] * f;
          const f32x2 ov = *(LAS const f32x2*)(OP + (w * 16 + q) * 64 + d); a0 += ov[0] * f; a1 += ov[1] * f; }
      const float rl = 1.0f / L;
      const unsigned z = *(const unsigned*)(SZ + (nrow0 + q) * 512 + h * 64 + d);
      *(unsigned*)(X.G + (nrow0 + q) * 1024 + (KIND ? 0 : 512) + h * 64 + d) = cvtpk(a0 * rl * bflo(z), a1 * rl * bfhi(z)); }
    __syncthreads();
}
}

#ifndef REP_FP
#define REP_FP 1
#endif
#ifndef REP_BP
#define REP_BP 1
#endif
#ifndef REP_S
#define REP_S 1
#endif
#ifndef REP_P0
#define REP_P0 1
#endif
#ifndef REP_P1
#define REP_P1 1
#endif
#ifndef REP_P2
#define REP_P2 1
#endif
#ifndef REP_P3A
#define REP_P3A 1
#endif
#ifndef REP_P3B
#define REP_P3B 1
#endif
#ifndef REP_P4
#define REP_P4 1
#endif
__global__ void __launch_bounds__(512, 2) fwd_kernel(Args args) {
    extern __shared__ __attribute__((aligned(16))) unsigned char lds_raw[];
    LAS unsigned char* lds = (LAS unsigned char*)lds_raw;
    const int G = gridDim.x; const int bx = blockIdx.x; const int vcu = (G % 8 == 0) ? (bx % 8) * (G / 8) + bx / 8 : bx;
    unsigned char* ws = args.ws; float* out = args.out;
    gu32* ctl = (gu32*)(ws + WS_CTL);
    const float* x_p = args.in[0]; const float* x_s = args.in[1];
    const float *cak = args.in[2], *cav = args.in[3], *cbk = args.in[4], *cbv = args.in[5], *cbl = args.in[6];
    const float *g_pre = args.in[7], *w_in = args.in[8], *b_f = args.in[9], *rel = args.in[10], *w_bra = args.in[11], *w_brb = args.in[12], *w_out = args.in[13], *g_post = args.in[14];
    float* Fp = (float*)(ws + WS_FP); float* LFp = (float*)(ws + WS_LFP); float* Fs = (float*)(ws + WS_FS); float* LFn = (float*)(ws + WS_LFN);
    bf16* WIN = (bf16*)(ws + WS_WIN); bf16* WBR = (bf16*)(ws + WS_WBR); bf16* WOUT = (bf16*)(ws + WS_WOUT);
    bf16* XN = (bf16*)(ws + WS_XN);
    bf16 *QA = (bf16*)(ws + WS_QA), *KA = (bf16*)(ws + WS_KA), *VA = (bf16*)(ws + WS_VA), *QB = (bf16*)(ws + WS_QB), *KB = (bf16*)(ws + WS_KB), *VB = (bf16*)(ws + WS_VB);
    bf16 *SZA = (bf16*)(ws + WS_SZA), *SZB = (bf16*)(ws + WS_SZB), *SMA = (bf16*)(ws + WS_SMA), *SMB = (bf16*)(ws + WS_SMB);
    bf16* MG = (bf16*)(ws + WS_MG); float* OUTF = (float*)(ws + WS_OUTF);

    for (int u = threadIdx.x; u < (LDS_BYTES - LDSCTL_OFF) / 4; u += 512) ((LAS unsigned*)(lds + LDSCTL_OFF))[u] = 0u;
    __syncthreads();
    volatile LAS unsigned* MISC = (volatile LAS unsigned*)(lds + MISC_OFF);
    XcdBarrier bar = xcd_barrier_post((unsigned*)(ctl + CW_BAR), MISC + 8);
    const int NGW = G * 8;

#pragma nounroll
    for (int rep = 0; rep < REP_P0; ++rep) {
        const int tid = fresh_tid(), lane = tid & 63; const int wave = __builtin_amdgcn_readfirstlane(tid >> 6); const int gw = vcu * 8 + wave;
        LAS float* wfT = (LAS float*)(lds + 73728);
        for (int k = tid; k < DM; k += 512) { const f32x4 a = *(const f32x4*)(w_in + (size_t)k * NIN + 4096), b = *(const f32x4*)(w_in + (size_t)k * NIN + 4100);
            wfT[0 * DM + k] = a[0]; wfT[1 * DM + k] = a[1]; wfT[2 * DM + k] = a[2]; wfT[3 * DM + k] = a[3];
            wfT[4 * DM + k] = b[0]; wfT[5 * DM + k] = b[1]; wfT[6 * DM + k] = b[2]; wfT[7 * DM + k] = b[3]; }
        __syncthreads();
        LAS float* scr = (LAS float*)(lds + wave * 8704);
        constexpr int I_IN = 16 * 192, I_BR = 8 * 32, I_OUT = 16 * 32, NITEMS = I_IN + 2 * I_BR + I_OUT;
        for (int it = gw; it < NITEMS; it += NGW) {
            int r = it;
            if (r < I_IN) { const int kb = r / 192, nb = r % 192, n0 = 32 * nb; p0_transpose_item(w_in, NIN, n0 + (n0 >= 4096 ? 8 : 0), WIN, DM, 0, n0, scr, 64 * kb, lane); continue; } r -= I_IN;
            if (r < I_BR) { const int kb = r / 32, nb = r % 32; p0_transpose_item(w_bra, DM, 32 * nb, WBR, DM, 0, 32 * nb, scr, 64 * kb, lane); continue; } r -= I_BR;
            if (r < I_BR) { const int kb = r / 32, nb = r % 32; p0_transpose_item(w_brb, DM, 32 * nb, WBR, DM, 512, 32 * nb, scr, 64 * kb, lane); continue; } r -= I_BR;
            { const int kb = r / 32, nb = r % 32; p0_transpose_item(w_out, DM, 32 * nb, WOUT, DM, 0, 32 * nb, scr, 64 * kb, lane); }
        }
        f32x4 gv[4];
#pragma unroll
        for (int j = 0; j < 4; ++j) gv[j] = *((const f32x4*)g_pre + lane + 64 * j);
        for (int m = gw; m < MTOT; m += NGW) {
            GAS unsigned long long* o8 = (GAS unsigned long long*)(XN + (size_t)m * DM) + lane;
            if (m >= MP + MS) {
#pragma unroll
                for (int j = 0; j < 4; ++j) o8[64 * j] = 0ull;
                continue; }
            const float* xrow = (m < MP) ? x_p + (size_t)m * DM : x_s + (size_t)(m - MP) * DM;
            f32x4 v[4]; float ss = 0.f;
#pragma unroll
            for (int j = 0; j < 4; ++j) { v[j] = *((const f32x4*)xrow + lane + 64 * j); ss += (v[j][0] * v[j][0] + v[j][1] * v[j][1]) + (v[j][2] * v[j][2] + v[j][3] * v[j][3]); }
            float dt[8];
#pragma unroll
            for (int hh = 0; hh < 8; ++hh) dt[hh] = 0.f;
#pragma unroll
            for (int j = 0; j < 4; ++j) { v[j] = v[j] * gv[j];
#pragma unroll
                for (int hh = 0; hh < 8; ++hh) { const f32x4 w = *(LAS const f32x4*)(wfT + hh * DM + 256 * j + 4 * lane);
                    dt[hh] += (v[j][0] * w[0] + v[j][1] * w[1]) + (v[j][2] * w[2] + v[j][3] * w[3]); } }
            ss = wave_sum(ss);
            const float rs = 1.0f / sqrtf(ss * (1.0f / DM) + EPS);
            {
                const bool u5 = (lane & 32) != 0, u4 = (lane & 16) != 0, u3 = (lane & 8) != 0;
#pragma unroll
                for (int i = 0; i < 4; ++i) { const float snd = u5 ? dt[i] : dt[i + 4], kp = u5 ? dt[i + 4] : dt[i]; dt[i] = kp + __shfl_xor(snd, 32); }
#pragma unroll
                for (int i = 0; i < 2; ++i) { const float snd = u4 ? dt[i] : dt[i + 2], kp = u4 ? dt[i + 2] : dt[i]; dt[i] = kp + __shfl_xor(snd, 16); }
                { const float snd = u3 ? dt[0] : dt[1], kp = u3 ? dt[1] : dt[0]; dt[0] = kp + __shfl_xor(snd, 8); }
                dt[0] += __shfl_xor(dt[0], 1); dt[0] += __shfl_xor(dt[0], 2); dt[0] += __shfl_xor(dt[0], 4);
            }
            if ((lane & 7) == 0) {
                const int hh = lane >> 3;
                const float val = dt[0] * rs + b_f[hh];
                const float lf = (val >= 0.f) ? -log1pf(expf(-val)) : (val - log1pf(expf(val)));
                if (m < MP) { out[O_BLP + (size_t)m * 8 + hh] = lf; LFp[(size_t)((m >> 14) * 8 + hh) * SEQ + (m & (SEQ - 1))] = lf; }
                else { const int ms = m - MP; out[O_BLS + (size_t)ms * 8 + hh] = lf; LFn[((ms >> 4) * 8 + hh) * 16 + (ms & 15)] = lf; }
            }
#pragma unroll
            for (int j = 0; j < 4; ++j) o8[64 * j] = (unsigned long long)cvtpk(v[j][0] * rs, v[j][1] * rs) | ((unsigned long long)cvtpk(v[j][2] * rs, v[j][3] * rs) << 32);
        }
        { const int gt = vcu * 512 + tid, NT = G * 512; constexpr int PER = 496 * 128;
          for (int i = gt; i < 2 * 8 * PER; i += NT) { const int ten = i / (8 * PER), r = i - ten * 8 * PER, bb = r / PER, off = r - bb * PER;
              const f32x4* src = (const f32x4*)(ten ? cav : cak) + (size_t)bb * 65536 + 2048 + off;
              f32x4* dst = (f32x4*)(out + (ten ? O_AVS : O_AKS)) + (size_t)bb * 65536 + off; *dst = *src; } }
    }
    xcd_barrier(bar);

    if (vcu < 24) {
        const int tid = fresh_tid(), lane = tid & 63; const int wave = __builtin_amdgcn_readfirstlane(tid >> 6);
        LAS float* wtot = (LAS float*)(lds + QMX_OFF);
        if (vcu < 16) {
            const float* in = LFp + (size_t)vcu * SEQ + wave * 2048 + lane * 32; float* o = Fp + (size_t)vcu * SEQ + wave * 2048 + lane * 32;
            f32x4 v[8];
#pragma unroll
            for (int i = 0; i < 8; ++i) v[i] = *((const f32x4*)in + i);
            float run = 0.f;
#pragma unroll
            for (int i = 0; i < 8; ++i) { v[i][0] += run; v[i][1] += v[i][0]; v[i][2] += v[i][1]; v[i][3] += v[i][2]; run = v[i][3]; }
            float inc = run;
#pragma unroll
            for (int ofs = 1; ofs < 64; ofs <<= 1) { const float t = __shfl_up(inc, ofs); if (lane >= ofs) inc += t; }
            if (lane == 63) wtot[wave] = inc;
            __syncthreads();
            float carry = inc - run;
#pragma unroll
            for (int w = 0; w < 8; ++w) if (w < wave) carry += wtot[w];
#pragma unroll
            for (int i = 0; i < 8; ++i) { v[i] = v[i] + carry; *((f32x4*)o + i) = v[i]; }
        } else {
            const int sidx = (vcu - 16) * 8 + wave, bs = vcu - 16, hh = wave;
            const float* in = cbl + ((size_t)bs * PAST + 64 * lane) * 8 + hh; float* o = Fs + (size_t)sidx * FS_PITCH + 64 * lane;
            float v[64];
#pragma unroll
            for (int i = 0; i < 64; ++i) v[i] = in[i * 8];
            float run = 0.f;
#pragma unroll
            for (int i = 0; i < 64; ++i) { run += v[i]; v[i] = run; }
            float inc = run;
#pragma unroll
            for (int ofs = 1; ofs < 64; ofs <<= 1) { const float t = __shfl_up(inc, ofs); if (lane >= ofs) inc += t; }
            const float carry = inc - run;
#pragma unroll
            for (int i = 0; i < 16; ++i) { f32x4 q4 = {v[4 * i] + carry, v[4 * i + 1] + carry, v[4 * i + 2] + carry, v[4 * i + 3] + carry}; *((f32x4*)o + i) = q4; }
            const float last = __shfl(inc, 63);
            if (lane == 0) { float r2 = last; float* on = Fs + (size_t)sidx * FS_PITCH + PAST;
                for (int i = 0; i < 16; ++i) { r2 += LFn[sidx * 16 + i]; on[i] = r2; }
                for (int i = 16; i < 64; ++i) on[i] = r2; }
            __syncthreads();
        }
    }
#pragma nounroll
    for (int rep = 0; rep < REP_P1; ++rep) {
        if (rep) xcd_barrier(bar);
        pg8::Gemm g{XN, WIN, DM, DM / 64}; pg8::StaticOrder S; S.init(MTOT, NG, G, bx, 1);
        pg8::EpiInProj E{QA, KA, VA, SZA, QB, KB, VB, SZB, SMA, SMB, out, (unsigned*)(ctl + CW_KNORM)};
        pg8::gemm_phase<pg8::EpiInProj, pg8::StaticOrder>(lds, g, S, E);
    }
    xcd_barrier(bar);

#pragma nounroll
    for (int rep = 0; rep < REP_P2; ++rep) {
        if (rep) xcd_barrier(bar);
        att::Ctx X; X.lds = lds; X.QA = QA; X.KA = KA; X.VA = VA; X.QB = QB; X.KB = KB; X.VB = VB; X.SZA = SZA; X.SZB = SZB; X.G = XN;
        X.Fp = Fp; X.Fs = Fs; X.rel = rel; X.cak = cak; X.cav = cav; X.cbk = cbk; X.cbv = cbv; X.knorm = (const unsigned*)(ctl + CW_KNORM);
        constexpr int NU = 64 + 1024 + 1024 + 64;
        gu32* qctr = ctl + CW_QUEUE + rep * 64;
        volatile LAS unsigned* qw = (volatile LAS unsigned*)(lds + MISC_OFF) + 16;
        if (threadIdx.x == 0) qw[0] = __hip_atomic_fetch_add(qctr, 1u, RLX_AGENT);
        __syncthreads();
        for (;;) {
            const int u = (int)__builtin_amdgcn_readfirstlane(qw[0]);
            if (u >= NU) break;
            unsigned nxt = 0u;
            if (threadIdx.x == 0) nxt = __hip_atomic_fetch_add(qctr, 1u, RLX_AGENT);

            if (u < 64) { for (int r2 = 0; r2 < REP_S; ++r2) att::sample_unit<0>(X, u >> 3, u & 7); }
            else if (u < 64 + 2048) { const int kind = (u - 64) >> 10, idx = (u - 64) & 1023;
                const int hh = ((idx & 7) + (idx >> 8)) & 7, bb = (idx >> 3) & 1, qb = 63 - (idx >> 4);
                if (kind == 0) { for (int r2 = 0; r2 < REP_FP; ++r2) att::prompt_unit<0, 8>(X, bb, hh, qb); } else { for (int r2 = 0; r2 < REP_BP; ++r2) att::prompt_unit<1, 8>(X, bb, hh, qb); } }
            else { const int i2 = u - 64 - 2048; for (int r2 = 0; r2 < REP_S; ++r2) att::sample_unit<1>(X, i2 >> 3, i2 & 7); }
            if (threadIdx.x == 0) qw[0] = nxt;
            __syncthreads();
        }
    }
    xcd_barrier(bar);

#pragma nounroll
    for (int rep = 0; rep < REP_P3A; ++rep) {
        if (rep) xcd_barrier(bar);
        pg8::Gemm g{XN, WBR, DM, 8}; pg8::StaticOrder S; S.init(MTOT, DM, G, bx, 2);
        pg8::EpiMerge E{SMA, SMB, MG};
        pg8::gemm_phase<pg8::EpiMerge, pg8::StaticOrder>(lds, g, S, E);
    }
    xcd_barrier(bar);
#pragma nounroll
    for (int rep = 0; rep < REP_P3B; ++rep) {
        if (rep) xcd_barrier(bar);
        pg8::Gemm g{MG, WOUT, DM, DM / 64}; pg8::StaticOrder S; S.init(MTOT, DM, G, bx, 1);
        pg8::EpiF32 E{OUTF, DM};
        pg8::gemm_phase<pg8::EpiF32, pg8::StaticOrder>(lds, g, S, E);
    }
    xcd_barrier(bar);
#pragma nounroll
    for (int rep = 0; rep < REP_P4; ++rep) {
        const int tid = fresh_tid(), lane = tid & 63; const int wave = __builtin_amdgcn_readfirstlane(tid >> 6); const int gw = vcu * 8 + wave;
        f32x4 gv[4];
#pragma unroll
        for (int j = 0; j < 4; ++j) gv[j] = *((const f32x4*)g_post + lane + 64 * j);
        for (int m = gw; m < MP + MS; m += NGW) {
            const float* xrow = (m < MP) ? x_p + (size_t)m * DM : x_s + (size_t)(m - MP) * DM;
            float* yrow = (m < MP) ? out + O_YP + (size_t)m * DM : out + O_YS + (size_t)(m - MP) * DM;
            const float* orow = OUTF + (size_t)m * DM;
            f32x4 v[4], xv[4]; float ss = 0.f;
#pragma unroll
            for (int j = 0; j < 4; ++j) { v[j] = *((const f32x4*)orow + lane + 64 * j); xv[j] = *((const f32x4*)xrow + lane + 64 * j);
                ss += (v[j][0] * v[j][0] + v[j][1] * v[j][1]) + (v[j][2] * v[j][2] + v[j][3] * v[j][3]); }
            ss = wave_sum(ss);
            const float rs = 1.0f / sqrtf(ss * (1.0f / DM) + EPS);
#pragma unroll
            for (int j = 0; j < 4; ++j) *((f32x4*)yrow + lane + 64 * j) = xv[j] + v[j] * rs * gv[j];
        }
    }
}

extern "C" void kernel_launch(void* const* d_in, const int* in_sizes, int n_in, void* d_out, int out_size, void* d_ws, size_t ws_size, hipStream_t stream) {
    static int grid = 0;
    if (grid == 0) {
        if (n_in != 15 || in_sizes[0] != MP * DM || (size_t)out_size != O_END || ws_size < WS_END) {
            fprintf(stderr, "kernel_launch: unexpected shapes: n_in %d in0 %d out %d ws %zu (need %zu)\n", n_in, n_in > 0 ? in_sizes[0] : -1, out_size, ws_size, (size_t)WS_END); grid = -1; return; }
        int dev = 0, cus = 0, per_cu = 0;
        if (hipGetDevice(&dev) != hipSuccess || hipDeviceGetAttribute(&cus, hipDeviceAttributeMultiprocessorCount, dev) != hipSuccess) { fprintf(stderr, "kernel_launch: device query failed\n"); grid = -1; return; }
        if (hipFuncSetAttribute((const void*)fwd_kernel, hipFuncAttributeMaxDynamicSharedMemorySize, LDS_BYTES) != hipSuccess) { fprintf(stderr, "kernel_launch: hipFuncSetAttribute failed\n"); grid = -1; return; }
        if (hipOccupancyMaxActiveBlocksPerMultiprocessor(&per_cu, (const void*)fwd_kernel, 512, LDS_BYTES) != hipSuccess || per_cu < 1) {
            fprintf(stderr, "kernel_launch: occupancy query reports %d blocks per CU\n", per_cu); (void)hipGetLastError(); grid = -1; return; }
        grid = cus;
    }
    if (grid < 0) return;
    if (hipMemsetAsync((char*)d_ws + WS_CTL, 0, CTL_ZERO_BYTES, stream) != hipSuccess) { fprintf(stderr, "kernel_launch: memset failed\n"); return; }
    Args a{};
    for (int i = 0; i < 15; ++i) a.in[i] = (const float*)d_in[i];
    a.out = (float*)d_out; a.ws = (unsigned char*)d_ws;
    hipLaunchKernelGGL(fwd_kernel, dim3(grid), dim3(512), LDS_BYTES, stream, a);
    const hipError_t le = hipPeekAtLastError();
    if (le != hipSuccess) fprintf(stderr, "kernel_launch: launch failed: %s\n", hipGetErrorName(le));
}
```

```cpp
#include <hip/hip_runtime.h>
#include <hip/hip_bf16.h>
#include <cstdio>
#include <cstdint>

constexpr int DM = 1024, NB = 2, SEQ = 16384, DECB = 8, DECS = 16, PAST = 4096, AKEEP = 512;
constexpr int NH = 8, HD = 64, WA = 512;
constexpr int NIN = 6152;
constexpr int NG = 6144;
constexpr int MP = NB * SEQ;
constexpr int MS = DECB * DECS;
constexpr int MTOT = MP + 256;
constexpr int NREL = 192;
constexpr float EPS = 1e-6f;
constexpr float L2E = 1.4426950408889634f;
constexpr float C2 = 0.125f * L2E;
constexpr int FS_PITCH = 4160;

constexpr size_t O_YP = 0, O_YS = 33554432, O_AKP = 33685504, O_AVP = 34209792, O_BKP = 34734080, O_BVP = 51511296, O_BLP = 68288512,
                 O_AKS = 68550656, O_AVS = 70647808, O_BKS = 72744960, O_BVS = 72810496, O_BLS = 72876032, O_END = 72877056;

constexpr size_t MiB = 1u << 20;
constexpr size_t WS_CTL = 0, CTL_ZERO_BYTES = 1 * MiB;
constexpr size_t WS_FP = 1 * MiB;
constexpr size_t WS_LFP = 2 * MiB;
constexpr size_t WS_FS = 3 * MiB;
constexpr size_t WS_LFN = 5 * MiB;
constexpr size_t WS_WIN = 6 * MiB;
constexpr size_t WS_WBR = 18 * MiB;
constexpr size_t WS_WOUT = 20 * MiB;
constexpr size_t WS_XN = 24 * MiB;
constexpr size_t ACT_BYTES = (size_t)MTOT * 512 * 2;
constexpr size_t WS_QA = 89 * MiB, WS_KA = 122 * MiB, WS_VA = 155 * MiB, WS_QB = 188 * MiB, WS_KB = 221 * MiB, WS_VB = 254 * MiB;
constexpr size_t WS_MG = 89 * MiB;
constexpr size_t WS_OUTF = 155 * MiB;
constexpr size_t WS_SZA = 287 * MiB, WS_SZB = 320 * MiB;
constexpr size_t WS_SMA = 353 * MiB, WS_SMB = 418 * MiB;
constexpr size_t WS_END = 483 * MiB;
static_assert(ACT_BYTES <= 33 * MiB && WS_XN + 2 * ACT_BYTES <= WS_QA && WS_OUTF + (size_t)MTOT * 1024 * 4 <= WS_SZA && WS_MG + 2 * ACT_BYTES <= WS_OUTF, "ws map");

constexpr int CW_KNORM = 64;
constexpr int CW_QUEUE = 1024;
constexpr int CW_BAR = 4096;

constexpr int RING_BYTES = 131072;
constexpr int LDSCTL_OFF = RING_BYTES, MISC_OFF = LDSCTL_OFF + 320;
constexpr int TB_OFF = LDSCTL_OFF + 1024;
constexpr int WSF_OFF = LDSCTL_OFF + 2048;
constexpr int QMX_OFF = LDSCTL_OFF + 4096;
constexpr int LDS_BYTES = 147456;

#define GAS __attribute__((address_space(1)))
#define LAS __attribute__((address_space(3)))
typedef unsigned short bf16;
typedef unsigned v4u __attribute__((ext_vector_type(4)));
typedef unsigned v2u __attribute__((ext_vector_type(2)));
typedef float f32x4 __attribute__((ext_vector_type(4)));
typedef float f32x2 __attribute__((ext_vector_type(2)));
typedef float f32x16 __attribute__((ext_vector_type(16)));
typedef short bf16x8 __attribute__((ext_vector_type(8)));
typedef short s16x4 __attribute__((ext_vector_type(4)));
typedef short v4i16_t __attribute__((ext_vector_type(4)));
typedef __bf16 bf16x2_t __attribute__((ext_vector_type(2)));
typedef GAS unsigned gu32;
#define RLX_AGENT __ATOMIC_RELAXED, __HIP_MEMORY_SCOPE_AGENT

__device__ __forceinline__ unsigned cvtpk(float lo, float hi) { f32x2 v = {lo, hi}; bf16x2_t b = __builtin_convertvector(v, bf16x2_t); return __builtin_bit_cast(unsigned, b); }
__device__ __forceinline__ int fresh_tid() { int t = threadIdx.x; asm volatile("" : "+v"(t)); return t; }
__device__ __forceinline__ float bflo(unsigned u) { return __uint_as_float(u << 16); }
__device__ __forceinline__ float bfhi(unsigned u) { return __uint_as_float(u & 0xffff0000u); }
__device__ __forceinline__ float fexp2(float x) { return __builtin_amdgcn_exp2f(x); }
__device__ __forceinline__ float sigmoidf_(float v) { return __builtin_amdgcn_rcpf(1.0f + fexp2(-v * L2E)); }

namespace pg8 {
#define PG8_LAS __attribute__((address_space(3)))
typedef unsigned short bf16_t;
typedef unsigned u32x4 __attribute__((ext_vector_type(4)));
constexpr int BM = 256, BK = 64, HALF = 128, HTB = HALF * BK * 2, STAGE_BYTES = 8 * HTB, NXCD = 8, WGM = 8;

__host__ __device__ __forceinline__ int lds_byte(int r, int c) { const int st = (r >> 4) * 2 + (c >> 5), rr = r & 15, cc = c & 31, ob = rr * 64 + cc * 2; return st * 1024 + (ob ^ (((ob >> 9) & 1) << 5)); }
__host__ __device__ __forceinline__ void stage_rc(int b, int& R, int& C) { const int st = b / 1024, sb = b % 1024, swz = sb ^ (((sb >> 9) & 1) << 5); R = (st >> 1) * 16 + swz / 64; C = (st & 1) * 32 + (swz % 64) / 2; }
__host__ __device__ __forceinline__ int perm32(int rho) { const int n = rho >> 4, i = rho & 15; return 8 * (i >> 2) + 4 * n + (i & 3); }

struct Unit { int pm, pn, kh; };
struct Gemm { const bf16_t* A; const bf16_t* Bt; int ldk; int nt; };

struct StaticOrder {
    int nM, nN, nwg, G, c, nkh;
    __device__ void init(int M, int N, int G_, int c_, int nkh_) { nM = M / BM; nN = N / BM; nwg = nM * nN; G = G_; c = c_; nkh = nkh_; }
    __device__ bool next(int i, Unit& u) const {
        const int ti = i / nkh; u.kh = i - ti * nkh;
        const long L = (long)ti * G + c; if (L >= nwg) return false;
        int wgid = (int)L; { const int q = nwg / NXCD, r = nwg % NXCD, xcd = wgid % NXCD, off = wgid / NXCD; wgid = (xcd < r ? xcd * (q + 1) : r * (q + 1) + (xcd - r) * q) + off; }
        const int nig = WGM * nN, gid = wgid / nig, fm = gid * WGM, gsz = (nM - fm) < WGM ? (nM - fm) : WGM;
        u.pm = fm + ((wgid % nig) % gsz); u.pn = (wgid % nig) / gsz; return true;
    }
};


struct EpiInProj {
    static constexpr bool PERM = true;
    bf16_t *QA, *KA, *VA, *SZA, *QB, *KB, *VB, *SZB, *SMA, *SMB;
    float* out;
    unsigned* knorm;
    __device__ __forceinline__ bool keep(const Unit&) const { return false; }
    __device__ __forceinline__ void operator()(f32x4 (&acc)[2][2][4][2], const Unit& u, int wr, int wc, int fr, int fq) const {
        const int pn = u.pn, pm = u.pm;
        bf16_t* dst; int ldd, dcol, actk; float* f32p = nullptr; int fmode = 0, nvalid = 256; bool dnorm = false; int noff = 0;
        const bool sample = (pm == 128);
        if (pn < 16) {
            const int seg = pn >> 1; dcol = (pn & 1) * 256; ldd = 512;
            if (seg == 0) { dst = QA; actk = 1; }
            else if (seg == 1) { dst = KA; actk = 0; }
            else if (seg == 2) { dst = VA; actk = 0; }
            else if (seg == 3) { dst = SZA; actk = 2; }
            else if (seg == 4) { dst = QB; actk = 1; }
            else if (seg == 5) { dst = KB; actk = 0; }
            else if (seg == 6) { dst = VB; actk = 0; }
            else { dst = SZB; actk = 2; }
            if (seg == 1 || seg == 2) {
                if (!sample) { const int bt = pm & 63; if (bt >= 62) { f32p = out + (seg == 1 ? O_AKP : O_AVP) + ((size_t)((pm >> 6) * 512 + (bt - 62) * 256)) * 512 + dcol; fmode = 1; } }
                else { f32p = out + (seg == 1 ? O_AKS : O_AVS) + dcol; fmode = 2; nvalid = 128; }
            } else if (seg == 4) { if (!sample) { dnorm = true; noff = 32; }
            } else if (seg == 5 || seg == 6) {
                if (!sample) { f32p = out + (seg == 5 ? O_BKP : O_BVP) + (size_t)pm * 256 * 512 + dcol; fmode = 1; dnorm = (seg == 5); }
                else { f32p = out + (seg == 5 ? O_BKS : O_BVS) + dcol; fmode = 1; nvalid = 128; }
            }
        } else { ldd = 1024; actk = 3; if (pn < 20) { dst = SMA; dcol = (pn - 16) * 256; } else { dst = SMB; dcol = (pn - 20) * 256; } }
        const int rl0 = wr * 64 + fr, cl = wc * 32 + 8 * fq;
        if (dnorm) {
#pragma unroll
            for (int bj = 0; bj < 2; ++bj) { float mx = 0.f;
#pragma unroll
                for (int ai = 0; ai < 2; ++ai)
#pragma unroll
                    for (int m = 0; m < 4; ++m) { const f32x4 a = acc[ai][bj][m][0], b = acc[ai][bj][m][1];
                        float s = (a[0] * a[0] + a[1] * a[1]) + (a[2] * a[2] + a[3] * a[3]) + (b[0] * b[0] + b[1] * b[1]) + (b[2] * b[2] + b[3] * b[3]);
                        s += __shfl_xor(s, 16); s += __shfl_xor(s, 32); mx = fmaxf(mx, s); }
                mx = fmaxf(mx, __shfl_xor(mx, 1)); mx = fmaxf(mx, __shfl_xor(mx, 2)); mx = fmaxf(mx, __shfl_xor(mx, 4)); mx = fmaxf(mx, __shfl_xor(mx, 8));
                if (fr == 0 && fq == 0) { const int head = (pn & 1) * 4 + bj * 2 + (wc >> 1);
                    __hip_atomic_fetch_max(knorm + noff + (((pm >> 6) * 8 + head) * 2 + (wc & 1)), __float_as_uint(mx), __ATOMIC_RELAXED, __HIP_MEMORY_SCOPE_AGENT); }
            }
        }
#pragma unroll
        for (int ai = 0; ai < 2; ++ai)
#pragma unroll
            for (int m = 0; m < 4; ++m) { const int rl = rl0 + ai * HALF + m * 16; const size_t grow = (size_t)pm * BM + rl;
#pragma unroll
                for (int bj = 0; bj < 2; ++bj) { f32x4 v0 = acc[ai][bj][m][0], v1 = acc[ai][bj][m][1];
                    if (f32p != nullptr && rl < nvalid) { const size_t ro = (fmode == 1) ? (size_t)rl * 512 : ((size_t)((rl >> 4) * 512 + 496 + (rl & 15))) * 512;
                        *(f32x4*)(f32p + ro + cl + bj * HALF) = v0; *(f32x4*)(f32p + ro + cl + bj * HALF + 4) = v1; }
                    if (actk == 1) { v0 = v0 * C2; v1 = v1 * C2; }
                    else if (actk == 2) {
#pragma unroll
                        for (int e = 0; e < 4; ++e) { v0[e] = v0[e] * sigmoidf_(v0[e]); v1[e] = v1[e] * sigmoidf_(v1[e]); } }
                    else if (actk == 3) {
#pragma unroll
                        for (int e = 0; e < 4; ++e) { v0[e] = sigmoidf_(v0[e]); v1[e] = sigmoidf_(v1[e]); } }
                    u32x4 w; w.x = cvtpk(v0[0], v0[1]); w.y = cvtpk(v0[2], v0[3]); w.z = cvtpk(v1[0], v1[1]); w.w = cvtpk(v1[2], v1[3]);
                    *(u32x4*)(dst + grow * ldd + dcol + cl + bj * HALF) = w; } }
    }
};
struct EpiMerge {
    static constexpr bool PERM = true;
    const bf16_t *SMA, *SMB; bf16_t* MG;
    __device__ __forceinline__ bool keep(const Unit& u) const { return u.kh == 0; }
    __device__ __forceinline__ void operator()(f32x4 (&acc)[2][2][4][2], const Unit& u, int wr, int wc, int fr, int fq) const {
        const int rl0 = wr * 64 + fr, cl = wc * 32 + 8 * fq;
        const size_t off0 = ((size_t)u.pm * BM + rl0) * 1024 + u.pn * BM + cl;
#pragma unroll
        for (int ai = 0; ai < 2; ++ai) {
            u32x4 sb[4][2], sa[4][2];
#pragma unroll
            for (int m = 0; m < 4; ++m)
#pragma unroll
                for (int bj = 0; bj < 2; ++bj) { const size_t off = off0 + (size_t)(ai * HALF + m * 16) * 1024 + bj * HALF;
                    sb[m][bj] = *(const u32x4*)(SMB + off); if (u.kh == 0) sa[m][bj] = *(const u32x4*)(SMA + off); }
#pragma unroll
            for (int m = 0; m < 4; ++m)
#pragma unroll
                for (int bj = 0; bj < 2; ++bj) { const size_t off = off0 + (size_t)(ai * HALF + m * 16) * 1024 + bj * HALF;
                    const u32x4 b4 = sb[m][bj];
                    float g[8] = {bflo(b4.x), bfhi(b4.x), bflo(b4.y), bfhi(b4.y), bflo(b4.z), bfhi(b4.z), bflo(b4.w), bfhi(b4.w)};
                    if (u.kh == 0) { const u32x4 a4 = sa[m][bj];
                        const float a[8] = {bflo(a4.x), bfhi(a4.x), bflo(a4.y), bfhi(a4.y), bflo(a4.z), bfhi(a4.z), bflo(a4.w), bfhi(a4.w)};
#pragma unroll
                        for (int e = 0; e < 8; ++e) g[e] = a[e] * __builtin_amdgcn_rcpf(g[e]);
#pragma unroll
                        for (int e = 0; e < 4; ++e) { acc[ai][bj][m][0][e] *= g[e]; acc[ai][bj][m][1][e] *= g[4 + e]; }
                    } else { f32x4 v0 = acc[ai][bj][m][0], v1 = acc[ai][bj][m][1];
#pragma unroll
                        for (int e = 0; e < 4; ++e) { v0[e] *= g[e]; v1[e] *= g[4 + e]; }
                        u32x4 w; w.x = cvtpk(v0[0], v0[1]); w.y = cvtpk(v0[2], v0[3]); w.z = cvtpk(v1[0], v1[1]); w.w = cvtpk(v1[2], v1[3]);
                        *(u32x4*)(MG + off) = w; } }
        }
    }
};
struct EpiF32 {
    static constexpr bool PERM = false;
    float* C; int ldc;
    __device__ __forceinline__ bool keep(const Unit&) const { return false; }
    __device__ __forceinline__ void operator()(f32x4 (&acc)[2][2][4][2], const Unit& u, int wr, int wc, int fr, int fq) const {
        const int row0 = u.pm * BM + wr * 64 + fr, col0 = u.pn * BM + wc * 32 + 4 * fq;
#pragma unroll
        for (int ai = 0; ai < 2; ++ai)
#pragma unroll
            for (int m = 0; m < 4; ++m) { float* rowp = C + (size_t)(row0 + ai * HALF + m * 16) * ldc + col0;
#pragma unroll
                for (int bj = 0; bj < 2; ++bj)
#pragma unroll
                    for (int n = 0; n < 2; ++n) *(f32x4*)(rowp + bj * HALF + n * 16) = acc[ai][bj][m][n]; }
    }
};

template <class Epi, class Sched>
__device__ __forceinline__ void gemm_phase(PG8_LAS unsigned char* lds, const Gemm g, const Sched& S, const Epi& E) {
    const int tid = fresh_tid(), wid = __builtin_amdgcn_readfirstlane(tid >> 6), lane = tid & 63, wr = wid >> 2, wc = wid & 3, fr = lane & 15, fq = lane >> 4;
    const int K = g.ldk, nt = g.nt;
    unsigned voffA[2], voffB[2];
#pragma unroll
    for (int i = 0; i < 2; ++i) { int R, C; stage_rc(tid * 16 + i * 8192, R, C); const int Rb = Epi::PERM ? ((R & ~31) + perm32(R & 31)) : R;
        voffA[i] = (unsigned)(R * K + C) * 2u; voffB[i] = (unsigned)(Rb * K + C) * 2u; }
    const size_t kstep = (size_t)(BK * 2);
    const size_t hstep = (size_t)HALF * K * 2;
    const size_t tstep = 2 * hstep;
    const size_t khb = (size_t)nt * BK * 2;
    const unsigned ldsw = (unsigned)wid * 1024u;
    const int aoff = lds_byte(wr * 64 + fr, fq * 8), boff = lds_byte(wc * 32 + fr, fq * 8);
#define PG8_SA(b, h) (((b) * 2 + (h)) * HTB)
#define PG8_SB(b, h) ((4 + (b) * 2 + (h)) * HTB)
#define PG8_STAGE(bufoff, gbase, voff) do { _Pragma("unroll") for (int _i = 0; _i < 2; ++_i) \
        __builtin_amdgcn_global_load_lds((const unsigned*)((const char*)(gbase) + (voff)[_i]), (PG8_LAS unsigned*)(lds + (bufoff) + ldsw + _i * 8192), 16, 0, 0); } while (0)
#define PG8_LDA(dst, b, h) do { _Pragma("unroll") for (int m = 0; m < 4; ++m) _Pragma("unroll") for (int k = 0; k < 2; ++k) dst[m][k] = *(const PG8_LAS bf16x8*)(lds + PG8_SA(b, h) + aoff + m * 2048 + k * 1024); } while (0)
#define PG8_LDB(dst, b, h) do { _Pragma("unroll") for (int n = 0; n < 2; ++n) _Pragma("unroll") for (int k = 0; k < 2; ++k) dst[n][k] = *(const PG8_LAS bf16x8*)(lds + PG8_SB(b, h) + boff + n * 2048 + k * 1024); } while (0)
#define PG8_MMA(ai, bj, At, Bt) do { __builtin_amdgcn_s_setprio(1); _Pragma("unroll") for (int m = 0; m < 4; ++m) _Pragma("unroll") for (int n = 0; n < 2; ++n) _Pragma("unroll") for (int k = 0; k < 2; ++k) \
        acc[ai][bj][m][n] = __builtin_amdgcn_mfma_f32_16x16x32_bf16(Bt[n][k], At[m][k], acc[ai][bj][m][n], 0, 0, 0); __builtin_amdgcn_s_setprio(0); } while (0)
#define PG8_WAIT_V(n) asm volatile("s_waitcnt vmcnt(" #n ")" ::: "memory")
#define PG8_WAIT_L(n) asm volatile("s_waitcnt lgkmcnt(" #n ")" ::: "memory")
#define PG8_BAR __builtin_amdgcn_s_barrier()
#define PG8_SCHED __builtin_amdgcn_sched_barrier(0)
    Unit cur, nxt; int ui = 0;
    if (!S.next(0, cur)) return;
    f32x4 acc[2][2][4][2];
#pragma unroll
    for (int a = 0; a < 2; ++a)
#pragma unroll
        for (int b = 0; b < 2; ++b)
#pragma unroll
            for (int m = 0; m < 4; ++m)
#pragma unroll
                for (int n = 0; n < 2; ++n) acc[a][b][m][n] = (f32x4){0.f, 0.f, 0.f, 0.f};
    bf16x8 At[4][2], B0[2][2], B1[2][2];
    const char* cA = (const char*)g.A + (size_t)cur.pm * tstep + (size_t)cur.kh * khb; const char* cB = (const char*)g.Bt + (size_t)cur.pn * tstep + (size_t)cur.kh * khb;
    PG8_STAGE(PG8_SB(0, 0), cB, voffB); PG8_STAGE(PG8_SB(0, 1), cB + hstep, voffB); PG8_STAGE(PG8_SA(0, 0), cA, voffA); PG8_STAGE(PG8_SA(0, 1), cA + hstep, voffA);
    if (wr == 1) PG8_BAR;
    PG8_WAIT_V(2); PG8_BAR;
    PG8_STAGE(PG8_SB(1, 0), cB + kstep, voffB); PG8_STAGE(PG8_SA(1, 0), cA + kstep, voffA); PG8_STAGE(PG8_SB(1, 1), cB + hstep + kstep, voffB);
    PG8_WAIT_V(6); PG8_BAR;
    for (;;) {
        const bool has_next = S.next(ui + 1, nxt);
        const char* nA = has_next ? (const char*)g.A + (size_t)nxt.pm * tstep + (size_t)nxt.kh * khb : cA; const char* nB = has_next ? (const char*)g.Bt + (size_t)nxt.pn * tstep + (size_t)nxt.kh * khb : cB;
        for (int t = 0; t < nt; t += 2) {
            const bool last = (t == nt - 2);
            const char* a1 = cA + (size_t)(t + 1) * kstep;
            const char* a2 = last ? nA : cA + (size_t)(t + 2) * kstep; const char* b2 = last ? nB : cB + (size_t)(t + 2) * kstep;
            const char* a3 = a2 + kstep; const char* b3 = b2 + kstep;
            PG8_LDB(B0, 0, 0); PG8_LDB(B1, 0, 1); PG8_SCHED; PG8_LDA(At, 0, 0); PG8_STAGE(PG8_SA(1, 1), a1 + hstep, voffA);
            PG8_WAIT_V(8); PG8_WAIT_L(0); PG8_BAR; PG8_MMA(0, 0, At, B0); PG8_MMA(0, 1, At, B1); PG8_BAR; PG8_SCHED;
            PG8_LDA(At, 0, 1); PG8_STAGE(PG8_SB(0, 0), b2, voffB); PG8_STAGE(PG8_SB(0, 1), b2 + hstep, voffB); PG8_STAGE(PG8_SA(0, 0), a2, voffA);
            PG8_WAIT_V(8); PG8_WAIT_L(0); PG8_BAR; PG8_MMA(1, 0, At, B0); PG8_MMA(1, 1, At, B1); PG8_BAR; PG8_SCHED;
            PG8_LDB(B0, 1, 0); PG8_LDB(B1, 1, 1); PG8_SCHED; PG8_LDA(At, 1, 0); PG8_STAGE(PG8_SA(0, 1), a2 + hstep, voffA);
            PG8_WAIT_V(8); PG8_WAIT_L(0); PG8_BAR; PG8_MMA(0, 0, At, B0); PG8_MMA(0, 1, At, B1); PG8_BAR; PG8_SCHED;
            PG8_LDA(At, 1, 1); PG8_STAGE(PG8_SB(1, 0), b3, voffB); PG8_STAGE(PG8_SB(1, 1), b3 + hstep, voffB); PG8_STAGE(PG8_SA(1, 0), a3, voffA);
            PG8_WAIT_V(8); PG8_WAIT_L(0); PG8_BAR; PG8_MMA(1, 0, At, B0); PG8_MMA(1, 1, At, B1); PG8_BAR; PG8_SCHED;
        }
        if (wr == 0) PG8_BAR;
        E(acc, cur, wr, wc, fr, fq);
        if (!has_next) break;
        if (!E.keep(cur)) {
#pragma unroll
            for (int a = 0; a < 2; ++a)
#pragma unroll
                for (int b = 0; b < 2; ++b)
#pragma unroll
                    for (int m = 0; m < 4; ++m)
#pragma unroll
                        for (int n = 0; n < 2; ++n) acc[a][b][m][n] = (f32x4){0.f, 0.f, 0.f, 0.f};
        }
        cur = nxt; cA = nA; cB = nB; ++ui;
        if (wr == 1) PG8_BAR;
    }
    PG8_WAIT_V(0);
    PG8_BAR;
#undef PG8_SA
#undef PG8_SB
#undef PG8_STAGE
#undef PG8_LDA
#undef PG8_LDB
#undef PG8_MMA
#undef PG8_WAIT_V
#undef PG8_WAIT_L
#undef PG8_BAR
#undef PG8_SCHED
}
}

#define XB_TMO      128
#define XB_XCNT(j)  (256  + 64 * (j))
#define XB_XSUB(j)  (1280 + 64 * (j))
#define XB_XGEN(j)  (2304 + 64 * (j))
#define XB_TOP      3328
#define XB_TOPGEN   3392
#define XCD_BAR_WORDS 3456
#define XB_SPIN_CAP (1u << 18)
__device__ __forceinline__ unsigned xb_ld(unsigned* p)              { return __hip_atomic_load(p, __ATOMIC_RELAXED, __HIP_MEMORY_SCOPE_AGENT); }
__device__ __forceinline__ unsigned xb_add(unsigned* p, unsigned v) { return __hip_atomic_fetch_add(p, v, __ATOMIC_RELAXED, __HIP_MEMORY_SCOPE_AGENT); }
__device__ __forceinline__ unsigned xb_xcc_id() { return (unsigned)__builtin_amdgcn_s_getreg((3 << 11) | 20) & 0xFu; }
#define XB_SPIN(cond, bar) do { unsigned _sp = 0; while (cond) { __builtin_amdgcn_s_sleep(1); \
    if ((++_sp & 255u) == 0u) { if (xb_ld(&(bar)[XB_TMO])) break; if (_sp > XB_SPIN_CAP) { atomicAdd(&(bar)[XB_TMO], 1u); break; } } } } while (0)
struct XcdBarrier { unsigned* bar; unsigned x; volatile LAS unsigned* st; };
__device__ __forceinline__ XcdBarrier xcd_barrier_post(unsigned* bar, volatile LAS unsigned* st) {
    XcdBarrier b; b.bar = bar; b.x = xb_xcc_id(); b.st = st;
    if (threadIdx.x == 0) (void)xb_add(&bar[XB_XCNT(b.x)], 1u);
    return b;
}
__device__ __forceinline__ void xcd_barrier_complete(unsigned* bar, unsigned x, unsigned& nloc, unsigned& nx) {
    const unsigned G = gridDim.x * gridDim.y * gridDim.z;
    unsigned sum, cnt, mine, sp = 0u;
    for (;;) {
        sum = 0u; cnt = 0u; mine = 0u;
#pragma unroll
        for (unsigned j = 0; j < 16; ++j) { const unsigned c = xb_ld(&bar[XB_XCNT(j)]); sum += c; cnt += (c > 0u) ? 1u : 0u; mine = (j == x) ? c : mine; }
        if (sum == G) break;
        __builtin_amdgcn_s_sleep(1);
        if ((++sp & 255u) == 0u) { if (xb_ld(&bar[XB_TMO])) break; if (sp > XB_SPIN_CAP) { atomicAdd(&bar[XB_TMO], 1u); break; } }
    }
    nloc = mine > 0u ? mine : 1u; nx = cnt > 0u ? cnt : 1u;
}
__device__ __forceinline__ void xcd_barrier(const XcdBarrier& b) {
    asm volatile("s_waitcnt vmcnt(0)" ::: "memory");
    __syncthreads();
    if (threadIdx.x == 0) {
        unsigned* bar = b.bar;
        __builtin_amdgcn_s_waitcnt(0);
        unsigned nloc = b.st[0], nx = b.st[1];
        if (nloc == 0u) { xcd_barrier_complete(bar, b.x, nloc, nx); b.st[0] = nloc; b.st[1] = nx; }
        const unsigned old = xb_add(&bar[XB_XSUB(b.x)], 1u);
        const unsigned gen = old / nloc;
        if (old + 1u == (gen + 1u) * nloc) {
            __builtin_amdgcn_fence(__ATOMIC_RELEASE, "agent");
            asm volatile("s_waitcnt vmcnt(0)" ::: "memory");
            const unsigned og = xb_add(&bar[XB_TOP], 1u);
            const unsigned tg = og / nx;
            if (og + 1u == (tg + 1u) * nx) xb_add(&bar[XB_TOPGEN], 1u);
            else XB_SPIN(xb_ld(&bar[XB_TOPGEN]) == tg, bar);
            __builtin_amdgcn_fence(__ATOMIC_ACQUIRE, "agent");
            xb_add(&bar[XB_XGEN(b.x)], 1u);
            asm volatile("s_waitcnt vmcnt(0)" ::: "memory");
        } else {
            XB_SPIN(xb_ld(&bar[XB_XGEN(b.x)]) == gen, bar);
            __builtin_amdgcn_fence(__ATOMIC_ACQUIRE, "agent");
            asm volatile("s_waitcnt vmcnt(0)" ::: "memory");
        }
    }
    __syncthreads();
}

struct Args { const float* in[15]; float* out; unsigned char* ws; };

__device__ __forceinline__ float wave_sum(float v) {
#pragma unroll
    for (int o = 1; o < 64; o <<= 1) v += __shfl_xor(v, o);
    return v;
}
__device__ __forceinline__ float wave_max(float v) {
#pragma unroll
    for (int o = 1; o < 64; o <<= 1) v = fmaxf(v, __shfl_xor(v, o));
    return v;
}

__device__ __forceinline__ void p0_transpose_item(const float* W, int ldw, int csrc, bf16* WT, int ldt, int kdst, int nrow0, LAS float* scr, int k0, int lane) {
#pragma unroll 8
    for (int i = 0; i < 32; ++i) { const int kk = 2 * i + (lane >> 5); scr[kk * 33 + (lane & 31)] = W[(size_t)(k0 + kk) * ldw + csrc + (lane & 31)]; }
    asm volatile("s_waitcnt lgkmcnt(0)" ::: "memory");
    const int c = lane & 7;
#pragma unroll
    for (int j = 0; j < 4; ++j) { const int n = (lane >> 3) + 8 * j; const LAS float* s = scr + (8 * c) * 33 + n;
        v4u o; o.x = cvtpk(s[0 * 33], s[1 * 33]); o.y = cvtpk(s[2 * 33], s[3 * 33]); o.z = cvtpk(s[4 * 33], s[5 * 33]); o.w = cvtpk(s[6 * 33], s[7 * 33]);
        *(GAS v4u*)(WT + (size_t)(nrow0 + n) * ldt + kdst + k0 + 8 * c) = o; }
    asm volatile("s_waitcnt lgkmcnt(0)" ::: "memory");
}

namespace att {
typedef LAS const unsigned char* ldsc;
__device__ __forceinline__ int crow(int r, int hi) { return (r & 3) + 8 * (r >> 2) + 4 * hi; }
#define MFMA32(a, b, c) __builtin_amdgcn_mfma_f32_32x32x16_bf16(a, b, c, 0, 0, 0)
__device__ __forceinline__ s16x4 vtr(ldsc p) { return __builtin_bit_cast(s16x4, __builtin_amdgcn_ds_read_tr16_b64_v4i16((LAS v4i16_t*)p)); }

__device__ __forceinline__ void qkt(f32x16& p0, f32x16& p1, ldsc Kslot, const bf16x8* qr, const f32x16& c0, const f32x16& c1, int r32, int hi) {
    ldsc kb = Kslot + hi * 1024 + r32 * 16;
#pragma unroll
    for (int d0 = 0; d0 < 4; ++d0) {
        const bf16x8 b0 = *(LAS const bf16x8*)(kb + d0 * 2048);
        const bf16x8 b1 = *(LAS const bf16x8*)(kb + d0 * 2048 + 512);
        if (d0 == 0) { p0 = MFMA32(b0, qr[0], c0); p1 = MFMA32(b1, qr[0], c1); }
        else { p0 = MFMA32(b0, qr[d0], p0); p1 = MFMA32(b1, qr[d0], p1); } }
}
__device__ __forceinline__ float rowmax(const f32x16& p0, const f32x16& p1) {
    float a = fmaxf(p0[0], p1[0]);
#pragma unroll
    for (int r = 1; r < 16; ++r) a = fmaxf(a, fmaxf(p0[r], p1[r]));
    auto rr = __builtin_amdgcn_permlane32_swap(__float_as_uint(a), __float_as_uint(a), false, false);
    return fmaxf(__uint_as_float(rr[0]), __uint_as_float(rr[1]));
}
__device__ __forceinline__ float halfsum(float a) {
    auto rr = __builtin_amdgcn_permlane32_swap(__float_as_uint(a), __float_as_uint(a), false, false);
    return __uint_as_float(rr[0]) + __uint_as_float(rr[1]);
}
__device__ __forceinline__ void softmax_pv(f32x16& p0, f32x16& p1, f32x16 (&o)[2], float& m_run, float& l_run, LAS float* wsf, ldsc Vslot, int lane, int r32, int hi) {
    const float rm = rowmax(p0, p1);
    const float mn = fmaxf(m_run, rm); const float alpha = fexp2(m_run - mn); m_run = mn;
    float s = 0.f;
#pragma unroll
    for (int r = 0; r < 16; ++r) { p0[r] = fexp2(p0[r] - mn); p1[r] = fexp2(p1[r] - mn); s += p0[r] + p1[r]; }
    l_run = l_run * alpha + s;
    if (hi == 0) wsf[r32] = alpha;
#pragma unroll
    for (int g = 0; g < 4; ++g) { const f32x4 a4 = *(LAS const f32x4*)(wsf + 8 * g + 4 * hi);
#pragma unroll
        for (int j = 0; j < 4; ++j) { o[0][4 * g + j] *= a4[j]; o[1][4 * g + j] *= a4[j]; } }
    bf16x8 pa[4];
    { v4u w;
      w.x = cvtpk(p0[0], p0[1]); w.y = cvtpk(p0[2], p0[3]); w.z = cvtpk(p0[4], p0[5]); w.w = cvtpk(p0[6], p0[7]); pa[0] = __builtin_bit_cast(bf16x8, w);
      w.x = cvtpk(p0[8], p0[9]); w.y = cvtpk(p0[10], p0[11]); w.z = cvtpk(p0[12], p0[13]); w.w = cvtpk(p0[14], p0[15]); pa[1] = __builtin_bit_cast(bf16x8, w);
      w.x = cvtpk(p1[0], p1[1]); w.y = cvtpk(p1[2], p1[3]); w.z = cvtpk(p1[4], p1[5]); w.w = cvtpk(p1[6], p1[7]); pa[2] = __builtin_bit_cast(bf16x8, w);
      w.x = cvtpk(p1[8], p1[9]); w.y = cvtpk(p1[10], p1[11]); w.z = cvtpk(p1[12], p1[13]); w.w = cvtpk(p1[14], p1[15]); pa[3] = __builtin_bit_cast(bf16x8, w); }
    ldsc vp = Vslot + ((lane >> 4) & 1) * 32 + (lane & 3) * 8 + (4 * hi + ((lane & 15) >> 2)) * 64;
#pragma unroll
    for (int d0 = 0; d0 < 2; ++d0)
#pragma unroll
        for (int ks = 0; ks < 4; ++ks) { const s16x4 lo = vtr(vp + d0 * 4096 + ks * 1024), hh = vtr(vp + d0 * 4096 + ks * 1024 + 512);
            const bf16x8 vb = (bf16x8){lo[0], lo[1], lo[2], lo[3], hh[0], hh[1], hh[2], hh[3]};
            o[d0] = MFMA32(pa[ks], vb, o[d0]); }
}
__device__ __forceinline__ v4u mul8(v4u a, v4u z) {
    v4u r; r.x = cvtpk(bflo(a.x) * bflo(z.x), bfhi(a.x) * bfhi(z.x)); r.y = cvtpk(bflo(a.y) * bflo(z.y), bfhi(a.y) * bfhi(z.y));
    r.z = cvtpk(bflo(a.z) * bflo(z.z), bfhi(a.z) * bfhi(z.z)); r.w = cvtpk(bflo(a.w) * bflo(z.w), bfhi(a.w) * bfhi(z.w)); return r;
}

struct Ctx {
    LAS unsigned char* lds;
    const bf16 *QA, *KA, *VA, *QB, *KB, *VB, *SZA, *SZB; bf16* G;
    const float *Fp, *Fs, *rel; const float *cak, *cav, *cbk, *cbv;
    const unsigned* knorm;
};

constexpr int PL_K = 0, PL_V = 24576, PL_F = 49152, PL_BT = 51200, PL_OST = 77824, SLOTB = 8192;
__device__ __forceinline__ void glds16(const void* gsrc, unsigned lds_dst) { unsigned keep;
    asm volatile("s_mov_b32 %0, m0\n\ts_mov_b32 m0, %2\n\ts_nop 0\n\tglobal_load_lds_dwordx4 %1, off\n\ts_mov_b32 m0, %0" : "=&s"(keep) : "v"(gsrc), "s"(lds_dst) : "memory"); }
__device__ __forceinline__ void glds4(const void* gsrc, unsigned lds_dst) { unsigned keep;
    asm volatile("s_mov_b32 %0, m0\n\ts_mov_b32 m0, %2\n\ts_nop 0\n\tglobal_load_lds_dword %1, off\n\ts_mov_b32 m0, %0" : "=&s"(keep) : "v"(gsrc), "s"(lds_dst) : "memory"); }
typedef LAS const char* lds_cptr;
__device__ __forceinline__ void kload8(bf16x8* kf, lds_cptr kp) {
    kf[0] = *(LAS const bf16x8*)(kp);        kf[1] = *(LAS const bf16x8*)(kp + 512);
    kf[2] = *(LAS const bf16x8*)(kp + 2048); kf[3] = *(LAS const bf16x8*)(kp + 2560);
    kf[4] = *(LAS const bf16x8*)(kp + 4096); kf[5] = *(LAS const bf16x8*)(kp + 4608);
    kf[6] = *(LAS const bf16x8*)(kp + 6144); kf[7] = *(LAS const bf16x8*)(kp + 6656);
}
__device__ __forceinline__ void kload2(bf16x8* kf, lds_cptr kp, int j) { kf[2 * j] = *(LAS const bf16x8*)(kp + j * 2048); kf[2 * j + 1] = *(LAS const bf16x8*)(kp + j * 2048 + 512); }
__device__ __forceinline__ s16x4 vtr2(lds_cptr p) { return __builtin_bit_cast(s16x4, __builtin_amdgcn_ds_read_tr16_b64_v4i16((LAS v4i16_t*)p)); }
#define SBAR() __builtin_amdgcn_sched_barrier(0)
#define PIN(x) asm volatile("" : "+v"(x))
#define WAITB(N) asm volatile("s_waitcnt vmcnt(" #N ") lgkmcnt(0)\n\ts_barrier" ::: "memory")

template <int KIND, int THRL>
__device__ __forceinline__ void prompt_unit(const Ctx& X, int b, int h, int qb) {
    const int tid = fresh_tid(), lane = tid & 63, r32 = lane & 31, hi = lane >> 5; const int wid = __builtin_amdgcn_readfirstlane(tid >> 6);
    LAS unsigned char* lds = X.lds;
    const bf16* Q = KIND ? X.QA : X.QB; const bf16* Kt = KIND ? X.KA : X.KB; const bf16* Vt = KIND ? X.VA : X.VB; const bf16* SZ = KIND ? X.SZA : X.SZB;
    const size_t rowbase = (size_t)b * SEQ; const int q0 = qb * 256;
    const bf16* Qw = Q + (rowbase + q0 + wid * 32) * 512 + h * 64;
    const unsigned lds0 = (unsigned)(uintptr_t)lds;
    LAS float* wsf = (LAS float*)(lds + WSF_OFF) + wid * 64;
    const float* Fbh = X.Fp + (size_t)(b * 8 + h) * SEQ;
    int j_lo; const int j_hi = 4 * qb + 3; float Fq0L = 0.f;
    if (KIND == 0) {
        const float kn = __uint_as_float(__hip_atomic_load(X.knorm + ((b * 8 + h) * 2), RLX_AGENT)) + __uint_as_float(__hip_atomic_load(X.knorm + ((b * 8 + h) * 2) + 1, RLX_AGENT));
        const float qn = __uint_as_float(__hip_atomic_load(X.knorm + 32 + ((b * 8 + h) * 2), RLX_AGENT)) + __uint_as_float(__hip_atomic_load(X.knorm + 32 + ((b * 8 + h) * 2) + 1, RLX_AGENT));
        const float thr = 2.0f * C2 * sqrtf(qn * kn) * 1.02f + 40.0f;
        const float Fq0 = Fbh[q0]; Fq0L = Fq0 * L2E;
        int cnt = 0, base = 4 * qb - 1;
        for (;;) {
            const int jb = base - lane; bool ok = false;
            if (jb >= 0) ok = (Fq0 - Fbh[64 * jb + 63]) * L2E >= -thr;
            const unsigned long long mk = __ballot(ok);
            const int c = (mk == ~0ull) ? 64 : __builtin_ctzll(~mk);
            cnt += c; if (c < 64) break; base -= 64; if (base < 0) break;
        }
        j_lo = 4 * qb - cnt; if (j_lo < 0) j_lo = 0;
        if (((j_hi - j_lo + 1) & 1) && j_lo > 0) --j_lo;
        j_lo = __builtin_amdgcn_readfirstlane(j_lo);
    } else {
        j_lo = 4 * qb - 8; if (j_lo < 0) j_lo = 0;
    }
    const int n = j_hi - j_lo + 1;
    int ta, tb;
    if (KIND == 0) { ta = 0; tb = n - 4 + (wid >> 1); }
    else { const int cw = 4 * qb + (wid >> 1); ta = cw - 8; if (ta < 0) ta = 0; ta -= j_lo; tb = cw - j_lo; }
    const bf16* Kh = Kt + (rowbase + (size_t)j_lo * 64) * 512 + h * 64; const bf16* Vh = Vt + (rowbase + (size_t)j_lo * 64) * 512 + h * 64;
    const float* Fj = Fbh + 64 * j_lo;
    const bf16* ksrc = Kh + (size_t)lane * 512 + wid * 8;
    const bf16* vsrc = Vh + (size_t)(16 * (wid & 3) + (lane >> 2)) * 512 + (wid >> 2) * 32 + (lane & 3) * 8;
    const unsigned kdst = lds0 + PL_K + wid * 1024, vdst = lds0 + PL_V + wid * 1024, fdst = lds0 + PL_F;
#define DMA_K(t, slot) glds16(ksrc + (size_t)(t) * 64 * 512, (unsigned)__builtin_amdgcn_readfirstlane(kdst + (slot)))
#define DMA_V(t, slot) glds16(vsrc + (size_t)(t) * 64 * 512, (unsigned)__builtin_amdgcn_readfirstlane(vdst + (slot)))
#define DMA_F(t) do { if (KIND == 0) glds4(Fj + 64 * (t) + lane, (unsigned)__builtin_amdgcn_readfirstlane(fdst + ((t) & 3) * 256)); } while (0)
    const lds_cptr shm3 = (lds_cptr)lds; const lds_cptr kp0 = shm3 + PL_K + hi * 1024 + r32 * 16;
    const lds_cptr vp0 = shm3 + PL_V + ((lane >> 4) & 1) * 32 + (lane & 3) * 8 + (4 * hi + ((lane & 15) >> 2)) * 64;
    LAS const float* BT = (LAS const float*)(lds + PL_BT);
    float c191 = 0.f;
    if (KIND == 1) {
        const float* relh = X.rel + h * NREL;
#pragma unroll
        for (int k = 0; k < 12; ++k) { const int e = tid + 512 * k, di = e >> 10, ln = (e >> 4) & 63, r = e & 15;
            int idx = (32 * di - 32) + (ln & 31) - crow(r, ln >> 5) + 63; idx = min(max(idx, 0), NREL - 1);
            ((LAS float*)(lds + PL_BT))[e] = relh[idx] * L2E; }
        c191 = relh[NREL - 1] * L2E;
    }
    DMA_K(0, 0); DMA_F(0); DMA_V(0, 0); DMA_K(1, SLOTB); DMA_F(1);
    bf16x8 qr[4];
#pragma unroll
    for (int d0 = 0; d0 < 4; ++d0) qr[d0] = *(const bf16x8*)(Qw + (size_t)r32 * 512 + d0 * 16 + hi * 8);
    DMA_K(2, 2 * SLOTB); DMA_F(2);
    float mhat = 0.f, l_reg = 0.f; f32x16 o[2]; o[0] = f32x16{}; o[1] = f32x16{};
    const int qrel = wid * 32 + r32;
    bool resc = false;
    f32x16 pA0, pA1, pB0, pB1; bf16x8 kf[8];
    s16x4 vlo[8], vhi[8]; v4u pw0, pw1, pw2, pw3;
    int sl_prev = 0, sl_cur = 0, sl_next = SLOTB;
#define ROT() do { sl_prev = sl_cur; sl_cur = sl_next; sl_next = (sl_next == 2 * SLOTB) ? 0 : sl_next + SLOTB; } while (0)
#define CINIT(C0, C1, t) do { \
        if (KIND == 0) { LAS const float* fb_ = (LAS const float*)(lds + PL_F + ((t) & 3) * 256); const float base_ = Fq0L - mhat; \
            _Pragma("unroll") for (int g_ = 0; g_ < 4; ++g_) { const f32x4 f0_ = *(LAS const f32x4*)(fb_ + 8 * g_ + 4 * hi), f1_ = *(LAS const f32x4*)(fb_ + 32 + 8 * g_ + 4 * hi); \
                _Pragma("unroll") for (int e_ = 0; e_ < 4; ++e_) { C0[4 * g_ + e_] = __builtin_fmaf(f0_[e_], -L2E, base_); C1[4 * g_ + e_] = __builtin_fmaf(f1_[e_], -L2E, base_); } } \
        } else { const int dl0_ = 32 * (wid & 1) + 64 * (tb - (t)); \
            if (dl0_ >= 160) { const float cc_ = c191 - mhat; _Pragma("unroll") for (int r_ = 0; r_ < 16; ++r_) C0[r_] = cc_; } \
            else { LAS const float* bp_ = BT + (((dl0_ + 32) >> 5) * 64 + lane) * 16; \
                _Pragma("unroll") for (int g_ = 0; g_ < 4; ++g_) { const f32x4 f0_ = *(LAS const f32x4*)(bp_ + 4 * g_); _Pragma("unroll") for (int e_ = 0; e_ < 4; ++e_) C0[4 * g_ + e_] = f0_[e_] - mhat; } } \
            if (dl0_ - 32 >= 160) { const float cc_ = c191 - mhat; _Pragma("unroll") for (int r_ = 0; r_ < 16; ++r_) C1[r_] = cc_; } \
            else { LAS const float* bp_ = BT + (((dl0_) >> 5) * 64 + lane) * 16; \
                _Pragma("unroll") for (int g_ = 0; g_ < 4; ++g_) { const f32x4 f1_ = *(LAS const f32x4*)(bp_ + 4 * g_); _Pragma("unroll") for (int e_ = 0; e_ < 4; ++e_) C1[4 * g_ + e_] = f1_[e_] - mhat; } } \
        } } while (0)
#define CMASK(P0, P1, t) do { if (KIND == 0) { const int jb_ = (t) - (n - 4); if (jb_ >= 0) { const int kb_ = 64 * jb_ + 4 * hi; \
        _Pragma("unroll") for (int r_ = 0; r_ < 16; ++r_) { const int kv_ = kb_ + (r_ & 3) + 8 * (r_ >> 2); if (kv_ > qrel) P0[r_] = -INFINITY; if (kv_ + 32 > qrel) P1[r_] = -INFINITY; } } } } while (0)
#define MX3(a, b, c) __builtin_fmaxf(__builtin_fmaxf((a), (b)), (c))
#define ROWMAX(C0, C1, rm) do { float a_ = MX3(C0[0], C0[1], C1[0]), b_ = MX3(C0[2], C0[3], C1[1]); a_ = MX3(a_, C1[2], C1[3]); \
        _Pragma("unroll") for (int r_ = 4; r_ < 16; r_ += 4) { a_ = MX3(a_, C0[r_], C0[r_ + 1]); b_ = MX3(b_, C0[r_ + 2], C0[r_ + 3]); a_ = MX3(a_, C1[r_], C1[r_ + 1]); b_ = MX3(b_, C1[r_ + 2], C1[r_ + 3]); } \
        rm = __builtin_fmaxf(a_, b_); { auto rr_ = __builtin_amdgcn_permlane32_swap(__float_as_uint(rm), __float_as_uint(rm), false, false); rm = __builtin_fmaxf(__uint_as_float(rr_[0]), __uint_as_float(rr_[1])); } } while (0)
#define FIRST(C0, C1, t) do { CINIT(C0, C1, t); \
        C0 = MFMA32(kf[0], qr[0], C0); C1 = MFMA32(kf[1], qr[0], C1); C0 = MFMA32(kf[2], qr[1], C0); C1 = MFMA32(kf[3], qr[1], C1); \
        C0 = MFMA32(kf[4], qr[2], C0); C1 = MFMA32(kf[5], qr[2], C1); C0 = MFMA32(kf[6], qr[3], C0); C1 = MFMA32(kf[7], qr[3], C1); \
        CMASK(C0, C1, t); float rm_; ROWMAX(C0, C1, rm_); mhat += rm_; \
        _Pragma("unroll") for (int r_ = 0; r_ < 16; ++r_) { C0[r_] = fexp2(C0[r_] - rm_); C1[r_] = fexp2(C1[r_] - rm_); } } while (0)
#define PKW(P, B) cvtpk(P[B], P[B + 1])
#define PAF(k) __builtin_bit_cast(bf16x8, pw##k)
#define VFR(i) (bf16x8){vlo[i][0], vlo[i][1], vlo[i][2], vlo[i][3], vhi[i][0], vhi[i][1], vhi[i][2], vhi[i][3]}
#define GAPA(MF, A0, A1, A2, A3, W0, W1, PW) do { MF; sacc += A0; sacc += A1; sacc += A2; sacc += A3; PIN(sacc); W0; W1; PIN(PW); SBAR(); } while (0)
#define GAPB(MF, Xv, B) do { MF; Xv[B] = fexp2(Xv[B]); Xv[B + 1] = fexp2(Xv[B + 1]); Xv[B + 2] = fexp2(Xv[B + 2]); Xv[B + 3] = fexp2(Xv[B + 3]); PIN(Xv); SBAR(); } while (0)
#define VRD(i) do { vlo[i] = vtr2(vp_ + (((i) >> 2) * 4096 + ((i) & 3) * 1024)); vhi[i] = vtr2(vp_ + (((i) >> 2) * 4096 + ((i) & 3) * 1024 + 512)); } while (0)
#define KRD(G, j) do { if (G) { kload2(kf, kp0 + sl_next, j); SBAR(); } } while (0)
#define DMA_SLOT(t) do { if ((t) + 3 < n) { DMA_K((t) + 3, sl_cur); DMA_F((t) + 3); } if ((t) + 1 < n) { DMA_V((t) + 1, sl_next); } } while (0)
#define STEP(C0, C1, P0, P1, t, GL) do { CINIT(C0, C1, t); SBAR(); \
        const lds_cptr vp_ = vp0 + sl_prev; \
        VRD(0); SBAR(); float sacc = (P0[0] + P0[1]); \
        GAPA(C0 = MFMA32(kf[0], qr[0], C0), P0[2], P0[3], P0[4], P0[5],     pw0[0] = PKW(P0, 0), pw0[1] = PKW(P0, 2), pw0); \
        VRD(4); SBAR(); GAPA(C1 = MFMA32(kf[1], qr[0], C1), P0[6], P0[7], P0[8], P0[9],     pw0[2] = PKW(P0, 4), pw0[3] = PKW(P0, 6), pw0); \
        VRD(1); SBAR(); GAPA(C0 = MFMA32(kf[2], qr[1], C0), P0[10], P0[11], P0[12], P0[13], pw1[0] = PKW(P0, 8), pw1[1] = PKW(P0, 10), pw1); \
        VRD(5); SBAR(); GAPA(C1 = MFMA32(kf[3], qr[1], C1), P0[14], P0[15], P1[0], P1[1],   pw1[2] = PKW(P0, 12), pw1[3] = PKW(P0, 14), pw1); \
        VRD(2); SBAR(); GAPA(C0 = MFMA32(kf[4], qr[2], C0), P1[2], P1[3], P1[4], P1[5],     pw2[0] = PKW(P1, 0), pw2[1] = PKW(P1, 2), pw2); \
        VRD(6); SBAR(); GAPA(C1 = MFMA32(kf[5], qr[2], C1), P1[6], P1[7], P1[8], P1[9],     pw2[2] = PKW(P1, 4), pw2[3] = PKW(P1, 6), pw2); \
        VRD(3); SBAR(); GAPA(C0 = MFMA32(kf[6], qr[3], C0), P1[10], P1[11], P1[12], P1[13], pw3[0] = PKW(P1, 8), pw3[1] = PKW(P1, 10), pw3); \
        VRD(7); SBAR(); GAPA(C1 = MFMA32(kf[7], qr[3], C1), P1[14], P1[15], 0.f, 0.f,       pw3[2] = PKW(P1, 12), pw3[3] = PKW(P1, 14), pw3); \
        l_reg += sacc; \
        DMA_SLOT(t); \
        CMASK(C0, C1, t); \
        { float rm; ROWMAX(C0, C1, rm); resc = false; \
          if (__builtin_expect(__any(rm > (float)THRL), 0)) { const float dl = __builtin_fmaxf(rm, 0.f); mhat += dl; \
            _Pragma("unroll") for (int r_ = 0; r_ < 16; ++r_) { C0[r_] -= dl; C1[r_] -= dl; } \
            const float f = fexp2(-dl); l_reg *= f; if (hi == 0) wsf[r32] = f; resc = true; } } \
        SBAR(); \
        GAPB(o[0] = MFMA32(PAF(0), VFR(0), o[0]), C0, 0); \
        GAPB(o[1] = MFMA32(PAF(0), VFR(4), o[1]), C0, 4); \
        KRD(GL, 0); GAPB(o[0] = MFMA32(PAF(1), VFR(1), o[0]), C0, 8); \
        KRD(GL, 1); GAPB(o[1] = MFMA32(PAF(1), VFR(5), o[1]), C0, 12); \
        KRD(GL, 2); GAPB(o[0] = MFMA32(PAF(2), VFR(2), o[0]), C1, 0); \
        KRD(GL, 3); GAPB(o[1] = MFMA32(PAF(2), VFR(6), o[1]), C1, 4); \
        GAPB(o[0] = MFMA32(PAF(3), VFR(3), o[0]), C1, 8); \
        GAPB(o[1] = MFMA32(PAF(3), VFR(7), o[1]), C1, 12); \
    } while (0)
#define DRAIN(P0, P1) do { float sacc = P0[0] + P0[1]; _Pragma("unroll") for (int r_ = 2; r_ < 16; ++r_) sacc += P0[r_]; _Pragma("unroll") for (int r_ = 0; r_ < 16; ++r_) sacc += P1[r_]; l_reg += sacc; \
        pw0 = (v4u){PKW(P0, 0), PKW(P0, 2), PKW(P0, 4), PKW(P0, 6)}; pw1 = (v4u){PKW(P0, 8), PKW(P0, 10), PKW(P0, 12), PKW(P0, 14)}; \
        pw2 = (v4u){PKW(P1, 0), PKW(P1, 2), PKW(P1, 4), PKW(P1, 6)}; pw3 = (v4u){PKW(P1, 8), PKW(P1, 10), PKW(P1, 12), PKW(P1, 14)}; \
        const lds_cptr vp_ = vp0 + sl_prev; \
        _Pragma("unroll") for (int i_ = 0; i_ < 8; ++i_) { vlo[i_] = vtr2(vp_ + ((i_ >> 2) * 4096 + (i_ & 3) * 1024)); vhi[i_] = vtr2(vp_ + ((i_ >> 2) * 4096 + (i_ & 3) * 1024 + 512)); } \
        o[0] = MFMA32(PAF(0), VFR(0), o[0]); o[1] = MFMA32(PAF(0), VFR(4), o[1]); o[0] = MFMA32(PAF(1), VFR(1), o[0]); o[1] = MFMA32(PAF(1), VFR(5), o[1]); \
        o[0] = MFMA32(PAF(2), VFR(2), o[0]); o[1] = MFMA32(PAF(2), VFR(6), o[1]); o[0] = MFMA32(PAF(3), VFR(3), o[0]); o[1] = MFMA32(PAF(3), VFR(7), o[1]); } while (0)
#define RESC() do { if (resc) { _Pragma("unroll") for (int g_ = 0; g_ < 4; ++g_) { const f32x4 a4_ = *(LAS const f32x4*)(wsf + 8 * g_ + 4 * hi); \
        _Pragma("unroll") for (int e_ = 0; e_ < 4; ++e_) { o[0][4 * g_ + e_] *= a4_[e_]; o[1][4 * g_ + e_] *= a4_[e_]; } } resc = false; } } while (0)
#define CLOSE(t) do { if ((t) + 3 < n) { if (KIND == 0) WAITB(3); else WAITB(2); } else if ((t) + 1 < n) { WAITB(1); } else { WAITB(0); } } while (0)
#define IDLE(t) do { DMA_SLOT(t); if ((t) + 1 >= ta && (t) + 1 <= tb) kload8(kf, kp0 + sl_next); CLOSE(t); ROT(); } while (0)

    if (KIND == 0) WAITB(4); else WAITB(2);
    if (ta == 0) { kload8(kf, kp0); FIRST(pA0, pA1, 0); }
    WAITB(0);
    DMA_K(3, 0); DMA_F(3); DMA_V(1, SLOTB);
    ROT();
    if (1 >= ta && 1 <= tb) kload8(kf, kp0 + sl_cur);
    if (KIND == 0) WAITB(3); else WAITB(2);
    int t = 1;
    if (ta > 0) {
        for (; t < ta; ++t) IDLE(t);
        DMA_SLOT(t); FIRST(pA0, pA1, t); if (t + 1 <= tb) kload8(kf, kp0 + sl_next); CLOSE(t); ROT(); ++t;
    }
    for (; t + 1 <= tb; t += 2) {
        STEP(pB0, pB1, pA0, pA1, t, true); CLOSE(t); RESC(); ROT();
        const bool gl2 = (t + 2 <= tb);
        STEP(pA0, pA1, pB0, pB1, t + 1, gl2); CLOSE(t + 1); RESC(); ROT();
    }
    if (t <= tb) { STEP(pB0, pB1, pA0, pA1, t, false); CLOSE(t); RESC(); ROT(); ++t;
        DMA_SLOT(t); DRAIN(pB0, pB1); CLOSE(t); ROT(); ++t; }
    else { DMA_SLOT(t); DRAIN(pA0, pA1); CLOSE(t); ROT(); ++t; }
    for (; t <= n; ++t) IDLE(t);
    { const float lt = halfsum(l_reg);
      if (hi == 0) wsf[32 + r32] = lt;
      float rli[16];
#pragma unroll
      for (int g = 0; g < 4; ++g) { const f32x4 a4 = *(LAS const f32x4*)(wsf + 32 + 8 * g + 4 * hi);
#pragma unroll
          for (int e = 0; e < 4; ++e) rli[4 * g + e] = __builtin_amdgcn_rcpf(a4[e]); }
      LAS bf16* stg = (LAS bf16*)(lds + PL_OST + wid * 4096);
#pragma unroll
      for (int r = 0; r < 16; ++r) { const int orow = crow(r, hi);
#pragma unroll
          for (int d0 = 0; d0 < 2; ++d0) stg[orow * 64 + d0 * 32 + r32] = (bf16)(cvtpk(o[d0][r] * rli[r], 0.f) & 0xffffu); }
      const size_t grow0 = rowbase + q0 + wid * 32;
#pragma unroll
      for (int i = 0; i < 4; ++i) { const int row = i * 8 + (lane >> 3), ch = lane & 7;
          const v4u v = *(LAS const v4u*)(stg + row * 64 + ch * 8);
          const v4u z = *(const v4u*)(SZ + (grow0 + row) * 512 + h * 64 + ch * 8);
          *(v4u*)(X.G + (grow0 + row) * 1024 + (KIND ? 0 : 512) + h * 64 + ch * 8) = mul8(v, z); } }
    asm volatile("s_waitcnt vmcnt(0) lgkmcnt(0)\n\ts_barrier" ::: "memory");
#undef DMA_K
#undef DMA_V
#undef DMA_F
#undef ROT
#undef CINIT
#undef CMASK
#undef MX3
#undef ROWMAX
#undef FIRST
#undef PKW
#undef PAF
#undef VFR
#undef GAPA
#undef GAPB
#undef VRD
#undef KRD
#undef DMA_SLOT
#undef STEP
#undef DRAIN
#undef RESC
#undef CLOSE
#undef IDLE
}

template <int KIND>
__device__ __forceinline__ void sample_unit(const Ctx& X, int bs, int h) {
    const int tid = fresh_tid(), lane = tid & 63, r32 = lane & 31, hi = lane >> 5; const int wid = __builtin_amdgcn_readfirstlane(tid >> 6);
    LAS unsigned char* lds = X.lds;
    const int ncache = KIND ? AKEEP : PAST, nct = ncache / 64, ntile = nct + 1;
    const float* Kc = (KIND ? X.cak : X.cbk) + ((size_t)bs * ncache * 8 + h) * 64;
    const float* Vc = (KIND ? X.cav : X.cbv) + ((size_t)bs * ncache * 8 + h) * 64;
    const bf16* Q = KIND ? X.QA : X.QB; const bf16* Kn = KIND ? X.KA : X.KB; const bf16* Vn = KIND ? X.VA : X.VB; const bf16* SZ = KIND ? X.SZA : X.SZB;
    const size_t nrow0 = (size_t)MP + 16 * bs;
    LAS float* wsf = (LAS float*)(lds + WSF_OFF) + wid * 64;
    LAS float* tb = (LAS float*)(lds + TB_OFF);
    if (KIND == 1) { if (tid < NREL) tb[tid] = X.rel[h * NREL + tid] * L2E; }
    __syncthreads();
    bf16x8 qr[4];
#pragma unroll
    for (int d0 = 0; d0 < 4; ++d0) qr[d0] = *(const bf16x8*)(Q + (nrow0 + (r32 & 15)) * 512 + h * 64 + d0 * 16 + hi * 8);
    const float* Fsr = X.Fs + (size_t)(bs * 8 + h) * FS_PITCH;
    const float Fref = (KIND == 0) ? Fsr[PAST - 1] : 0.f;
    LAS unsigned char* kslot = lds + wid * 16384; LAS unsigned char* vslot = kslot + 8192;
    float m_run = -1e30f, l_run = 0.f; f32x16 o[2]; o[0] = f32x16{}; o[1] = f32x16{};
    const int tq = r32 & 15;
    for (int t = wid; t < ntile; t += 8) {
        if (t < nct) {
            const float* kr = Kc + (size_t)(t * 64 + (lane >> 4)) * 512 + (lane & 15) * 4; const float* vr = Vc + (size_t)(t * 64 + (lane >> 4)) * 512 + (lane & 15) * 4;
            f32x4 kq[16], vq[16];
#pragma unroll
            for (int i = 0; i < 16; ++i) kq[i] = *(const f32x4*)(kr + (size_t)i * 4 * 512);
#pragma unroll
            for (int i = 0; i < 16; ++i) vq[i] = *(const f32x4*)(vr + (size_t)i * 4 * 512);
            LAS unsigned char* kw = kslot + ((lane & 15) >> 1) * 1024 + (lane >> 4) * 16 + (lane & 1) * 8;
            LAS unsigned char* vw = vslot + ((lane & 15) >> 3) * 4096 + (lane >> 4) * 64 + (lane & 7) * 8;
#pragma unroll
            for (int i = 0; i < 16; ++i) { v2u w; w.x = cvtpk(kq[i][0], kq[i][1]); w.y = cvtpk(kq[i][2], kq[i][3]); *(LAS v2u*)(kw + i * 64) = w; }
#pragma unroll
            for (int i = 0; i < 16; ++i) { v2u w; w.x = cvtpk(vq[i][0], vq[i][1]); w.y = cvtpk(vq[i][2], vq[i][3]); *(LAS v2u*)(vw + i * 256) = w; }
        } else {
#pragma unroll
            for (int c = 0; c < 8; ++c) { v4u wk = (v4u){0u, 0u, 0u, 0u}, wv = wk;
                if (lane < 16) { wk = *(const v4u*)(Kn + (nrow0 + lane) * 512 + h * 64 + c * 8); wv = *(const v4u*)(Vn + (nrow0 + lane) * 512 + h * 64 + c * 8); }
                *(LAS v4u*)(kslot + c * 1024 + lane * 16) = wk;
                *(LAS v4u*)(vslot + (c >> 2) * 4096 + lane * 64 + (c & 3) * 16) = wv; }
        }
        f32x16 c0, c1, p0, p1;
        if (KIND == 0) {
            const float* fb = Fsr + t * 64;
#pragma unroll
            for (int g = 0; g < 4; ++g) { const f32x4 f0 = *(const f32x4*)(fb + 8 * g + 4 * hi), f1 = *(const f32x4*)(fb + 32 + 8 * g + 4 * hi);
#pragma unroll
                for (int e = 0; e < 4; ++e) { c0[4 * g + e] = (Fref - f0[e]) * L2E; c1[4 * g + e] = (Fref - f1[e]) * L2E; } }
        } else { c0 = f32x16{}; c1 = f32x16{}; }
        qkt(p0, p1, (ldsc)kslot, qr, c0, c1, r32, hi);
        if (KIND == 1) {
            const int dist0 = ncache + tq - (64 * t + 4 * hi) + 63;
#pragma unroll
            for (int r = 0; r < 16; ++r) { const int i0 = dist0 - ((r & 3) + 8 * (r >> 2));
                const int a0 = min(max(i0, 0), NREL - 1), a1 = min(max(i0 - 32, 0), NREL - 1);
                p0[r] += tb[a0]; p1[r] += tb[a1]; }
        }
        if (t == nct) {
#pragma unroll
            for (int r = 0; r < 16; ++r) { const int kv = 4 * hi + (r & 3) + 8 * (r >> 2);
                const bool ok = (kv < 16) && (KIND == 1 || kv <= tq);
                if (!ok) p0[r] = -1e30f; p1[r] = -1e30f; }
        }
        softmax_pv(p0, p1, o, m_run, l_run, wsf, (ldsc)vslot, lane, r32, hi);
    }
    const float lt = halfsum(l_run);
    __syncthreads();
    LAS float* OP = (LAS float*)lds;
    LAS float* ML = (LAS float*)(lds + 32768);
    if (lane < 16) { ML[(wid * 16 + lane) * 2] = m_run; ML[(wid * 16 + lane) * 2 + 1] = lt; }
#pragma unroll
    for (int r = 0; r < 8; ++r) { const int q = crow(r, hi);
#pragma unroll
        for (int d0 = 0; d0 < 2; ++d0) OP[(wid * 16 + q) * 64 + d0 * 32 + r32] = o[d0][r]; }
    __syncthreads();
    { const int q = tid >> 5, d = (tid & 31) * 2;
      float M = -1e30f;
#pragma unroll
      for (int w = 0; w < 8; ++w) M = fmaxf(M, ML[(w * 16 + q) * 2]);
      float L = 0.f, a0 = 0.f, a1 = 0.f;
#pragma unroll
      for (int w = 0; w < 8; ++w) { const float f = fexp2(ML[(w * 16 + q) * 2] - M); L += ML[(w * 16 + q) * 2 + 1] * f;
          const f32x2 ov = *(LAS const f32x2*)(OP + (w * 16 + q) * 64 + d); a0 += ov[0] * f; a1 += ov[1] * f; }
      const float rl = 1.0f / L;
      const unsigned z = *(const unsigned*)(SZ + (nrow0 + q) * 512 + h * 64 + d);
      *(unsigned*)(X.G + (nrow0 + q) * 1024 + (KIND ? 0 : 512) + h * 64 + d) = cvtpk(a0 * rl * bflo(z), a1 * rl * bfhi(z)); }
    __syncthreads();
}
}


__device__ __forceinline__ f32x16 mini_tile(const bf16* Xrow0, const bf16* Wrow0, int k0, int ksteps, f32x16 acc, int r32, int hi) {
    const bf16* ap = Wrow0 + (size_t)r32 * DM + k0 + hi * 8;
    const bf16* bp = Xrow0 + (size_t)r32 * DM + k0 + hi * 8;
#pragma unroll 8
    for (int s = 0; s < ksteps; ++s) { const bf16x8 a = *(const bf16x8*)(ap + 16 * s); const bf16x8 b = *(const bf16x8*)(bp + 16 * s);
        acc = __builtin_amdgcn_mfma_f32_32x32x16_bf16(a, b, acc, 0, 0, 0); }
    return acc;
}
struct SampleInProj { bf16 *QA, *KA, *VA, *SZA, *QB, *KB, *VB, *SZB, *SMA, *SMB; float* out; };
__device__ __forceinline__ void sample_inproj_store(const SampleInProj& E, const f32x16& acc, int m0, int n0, int r32, int hi) {
    const int pn = n0 >> 8; bf16* dst; int ldd, cbase, actk; float* f32p = nullptr; int fmode = 0;
    if (pn < 16) { const int seg = pn >> 1; ldd = 512; cbase = seg * 512;
        if (seg == 0) { dst = E.QA; actk = 1; } else if (seg == 1) { dst = E.KA; actk = 0; } else if (seg == 2) { dst = E.VA; actk = 0; } else if (seg == 3) { dst = E.SZA; actk = 2; }
        else if (seg == 4) { dst = E.QB; actk = 1; } else if (seg == 5) { dst = E.KB; actk = 0; } else if (seg == 6) { dst = E.VB; actk = 0; } else { dst = E.SZB; actk = 2; }
        if (seg == 1 || seg == 2) { f32p = E.out + (seg == 1 ? O_AKS : O_AVS); fmode = 2; }
        else if (seg == 5 || seg == 6) { f32p = E.out + (seg == 5 ? O_BKS : O_BVS); fmode = 1; }
    } else { ldd = 1024; actk = 3; if (pn < 20) { dst = E.SMA; cbase = 4096; } else { dst = E.SMB; cbase = 5120; } }
    const int rl = m0 + r32; const size_t grow = (size_t)MP + rl;
    const size_t ro = (fmode == 1) ? (size_t)rl * 512 : ((size_t)((rl >> 4) * 512 + 496 + (rl & 15))) * 512;
#pragma unroll
    for (int g = 0; g < 4; ++g) { const int col = n0 + 8 * g + 4 * hi - cbase;
        f32x4 v = {acc[4 * g], acc[4 * g + 1], acc[4 * g + 2], acc[4 * g + 3]};
        if (f32p != nullptr) *(f32x4*)(f32p + ro + col) = v;
        if (actk == 1) v = v * C2;
        else if (actk == 2) {
#pragma unroll
            for (int e = 0; e < 4; ++e) v[e] = v[e] * sigmoidf_(v[e]); }
        else if (actk == 3) {
#pragma unroll
            for (int e = 0; e < 4; ++e) v[e] = sigmoidf_(v[e]); }
        v2u w; w.x = cvtpk(v[0], v[1]); w.y = cvtpk(v[2], v[3]);
        *(v2u*)(dst + grow * ldd + col) = w; }
}

#ifndef REP_FP
#define REP_FP 1
#endif
#ifndef REP_BP
#define REP_BP 1
#endif
#ifndef REP_S
#define REP_S 1
#endif
#ifndef REP_P0
#define REP_P0 1
#endif
#ifndef REP_P1
#define REP_P1 1
#endif
#ifndef REP_P2
#define REP_P2 1
#endif
#ifndef REP_P3A
#define REP_P3A 1
#endif
#ifndef REP_P3B
#define REP_P3B 1
#endif
#ifndef REP_P4
#define REP_P4 1
#endif
__global__ void __launch_bounds__(512, 2) fwd_kernel(Args args) {
    extern __shared__ __attribute__((aligned(16))) unsigned char lds_raw[];
    LAS unsigned char* lds = (LAS unsigned char*)lds_raw;
    const int G = gridDim.x; const int bx = blockIdx.x; const int vcu = (G % 8 == 0) ? (bx % 8) * (G / 8) + bx / 8 : bx;
    unsigned char* ws = args.ws; float* out = args.out;
    gu32* ctl = (gu32*)(ws + WS_CTL);
    const float* x_p = args.in[0]; const float* x_s = args.in[1];
    const float *cak = args.in[2], *cav = args.in[3], *cbk = args.in[4], *cbv = args.in[5], *cbl = args.in[6];
    const float *g_pre = args.in[7], *w_in = args.in[8], *b_f = args.in[9], *rel = args.in[10], *w_bra = args.in[11], *w_brb = args.in[12], *w_out = args.in[13], *g_post = args.in[14];
    float* Fp = (float*)(ws + WS_FP); float* LFp = (float*)(ws + WS_LFP); float* Fs = (float*)(ws + WS_FS); float* LFn = (float*)(ws + WS_LFN);
    bf16* WIN = (bf16*)(ws + WS_WIN); bf16* WBR = (bf16*)(ws + WS_WBR); bf16* WOUT = (bf16*)(ws + WS_WOUT);
    bf16* XN = (bf16*)(ws + WS_XN);
    bf16 *QA = (bf16*)(ws + WS_QA), *KA = (bf16*)(ws + WS_KA), *VA = (bf16*)(ws + WS_VA), *QB = (bf16*)(ws + WS_QB), *KB = (bf16*)(ws + WS_KB), *VB = (bf16*)(ws + WS_VB);
    bf16 *SZA = (bf16*)(ws + WS_SZA), *SZB = (bf16*)(ws + WS_SZB), *SMA = (bf16*)(ws + WS_SMA), *SMB = (bf16*)(ws + WS_SMB);
    bf16* MG = (bf16*)(ws + WS_MG); float* OUTF = (float*)(ws + WS_OUTF);

    for (int u = threadIdx.x; u < (LDS_BYTES - LDSCTL_OFF) / 4; u += 512) ((LAS unsigned*)(lds + LDSCTL_OFF))[u] = 0u;
    __syncthreads();
    volatile LAS unsigned* MISC = (volatile LAS unsigned*)(lds + MISC_OFF);
    XcdBarrier bar = xcd_barrier_post((unsigned*)(ctl + CW_BAR), MISC + 8);
    const int NGW = G * 8;

#pragma nounroll
    for (int rep = 0; rep < REP_P0; ++rep) {
        const int tid = fresh_tid(), lane = tid & 63; const int wave = __builtin_amdgcn_readfirstlane(tid >> 6); const int gw = vcu * 8 + wave;
        LAS float* wfT = (LAS float*)(lds + 73728);
        for (int k = tid; k < DM; k += 512) { const f32x4 a = *(const f32x4*)(w_in + (size_t)k * NIN + 4096), b = *(const f32x4*)(w_in + (size_t)k * NIN + 4100);
            wfT[0 * DM + k] = a[0]; wfT[1 * DM + k] = a[1]; wfT[2 * DM + k] = a[2]; wfT[3 * DM + k] = a[3];
            wfT[4 * DM + k] = b[0]; wfT[5 * DM + k] = b[1]; wfT[6 * DM + k] = b[2]; wfT[7 * DM + k] = b[3]; }
        __syncthreads();
        LAS float* scr = (LAS float*)(lds + wave * 8704);
        constexpr int I_IN = 16 * 192, I_BR = 8 * 32, I_OUT = 16 * 32, NITEMS = I_IN + 2 * I_BR + I_OUT;
        for (int it = gw; it < NITEMS; it += NGW) {
            int r = it;
            if (r < I_IN) { const int kb = r / 192, nb = r % 192, n0 = 32 * nb; p0_transpose_item(w_in, NIN, n0 + (n0 >= 4096 ? 8 : 0), WIN, DM, 0, n0, scr, 64 * kb, lane); continue; } r -= I_IN;
            if (r < I_BR) { const int kb = r / 32, nb = r % 32; p0_transpose_item(w_bra, DM, 32 * nb, WBR, DM, 0, 32 * nb, scr, 64 * kb, lane); continue; } r -= I_BR;
            if (r < I_BR) { const int kb = r / 32, nb = r % 32; p0_transpose_item(w_brb, DM, 32 * nb, WBR, DM, 512, 32 * nb, scr, 64 * kb, lane); continue; } r -= I_BR;
            { const int kb = r / 32, nb = r % 32; p0_transpose_item(w_out, DM, 32 * nb, WOUT, DM, 0, 32 * nb, scr, 64 * kb, lane); }
        }
        f32x4 gv[4];
#pragma unroll
        for (int j = 0; j < 4; ++j) gv[j] = *((const f32x4*)g_pre + lane + 64 * j);
        for (int m = gw; m < MTOT; m += NGW) {
            GAS unsigned long long* o8 = (GAS unsigned long long*)(XN + (size_t)m * DM) + lane;
            if (m >= MP + MS) {
#pragma unroll
                for (int j = 0; j < 4; ++j) o8[64 * j] = 0ull;
                continue; }
            const float* xrow = (m < MP) ? x_p + (size_t)m * DM : x_s + (size_t)(m - MP) * DM;
            f32x4 v[4]; float ss = 0.f;
#pragma unroll
            for (int j = 0; j < 4; ++j) { v[j] = *((const f32x4*)xrow + lane + 64 * j); ss += (v[j][0] * v[j][0] + v[j][1] * v[j][1]) + (v[j][2] * v[j][2] + v[j][3] * v[j][3]); }
            float dt[8];
#pragma unroll
            for (int hh = 0; hh < 8; ++hh) dt[hh] = 0.f;
#pragma unroll
            for (int j = 0; j < 4; ++j) { v[j] = v[j] * gv[j];
#pragma unroll
                for (int hh = 0; hh < 8; ++hh) { const f32x4 w = *(LAS const f32x4*)(wfT + hh * DM + 256 * j + 4 * lane);
                    dt[hh] += (v[j][0] * w[0] + v[j][1] * w[1]) + (v[j][2] * w[2] + v[j][3] * w[3]); } }
            ss = wave_sum(ss);
            const float rs = 1.0f / sqrtf(ss * (1.0f / DM) + EPS);
            {
                const bool u5 = (lane & 32) != 0, u4 = (lane & 16) != 0, u3 = (lane & 8) != 0;
#pragma unroll
                for (int i = 0; i < 4; ++i) { const float snd = u5 ? dt[i] : dt[i + 4], kp = u5 ? dt[i + 4] : dt[i]; dt[i] = kp + __shfl_xor(snd, 32); }
#pragma unroll
                for (int i = 0; i < 2; ++i) { const float snd = u4 ? dt[i] : dt[i + 2], kp = u4 ? dt[i + 2] : dt[i]; dt[i] = kp + __shfl_xor(snd, 16); }
                { const float snd = u3 ? dt[0] : dt[1], kp = u3 ? dt[1] : dt[0]; dt[0] = kp + __shfl_xor(snd, 8); }
                dt[0] += __shfl_xor(dt[0], 1); dt[0] += __shfl_xor(dt[0], 2); dt[0] += __shfl_xor(dt[0], 4);
            }
            if ((lane & 7) == 0) {
                const int hh = lane >> 3;
                const float val = dt[0] * rs + b_f[hh];
                const float lf = (val >= 0.f) ? -log1pf(expf(-val)) : (val - log1pf(expf(val)));
                if (m < MP) { out[O_BLP + (size_t)m * 8 + hh] = lf; LFp[(size_t)((m >> 14) * 8 + hh) * SEQ + (m & (SEQ - 1))] = lf; }
                else { const int ms = m - MP; out[O_BLS + (size_t)ms * 8 + hh] = lf; LFn[((ms >> 4) * 8 + hh) * 16 + (ms & 15)] = lf; }
            }
#pragma unroll
            for (int j = 0; j < 4; ++j) o8[64 * j] = (unsigned long long)cvtpk(v[j][0] * rs, v[j][1] * rs) | ((unsigned long long)cvtpk(v[j][2] * rs, v[j][3] * rs) << 32);
        }
        { const int gt = vcu * 512 + tid, NT = G * 512; constexpr int PER = 496 * 128;
          for (int i = gt; i < 2 * 8 * PER; i += NT) { const int ten = i / (8 * PER), r = i - ten * 8 * PER, bb = r / PER, off = r - bb * PER;
              const f32x4* src = (const f32x4*)(ten ? cav : cak) + (size_t)bb * 65536 + 2048 + off;
              f32x4* dst = (f32x4*)(out + (ten ? O_AVS : O_AKS)) + (size_t)bb * 65536 + off; *dst = *src; } }
    }
    xcd_barrier(bar);

    if (vcu < 24) {
        const int tid = fresh_tid(), lane = tid & 63; const int wave = __builtin_amdgcn_readfirstlane(tid >> 6);
        LAS float* wtot = (LAS float*)(lds + QMX_OFF);
        if (vcu < 16) {
            const float* in = LFp + (size_t)vcu * SEQ + wave * 2048 + lane * 32; float* o = Fp + (size_t)vcu * SEQ + wave * 2048 + lane * 32;
            f32x4 v[8];
#pragma unroll
            for (int i = 0; i < 8; ++i) v[i] = *((const f32x4*)in + i);
            float run = 0.f;
#pragma unroll
            for (int i = 0; i < 8; ++i) { v[i][0] += run; v[i][1] += v[i][0]; v[i][2] += v[i][1]; v[i][3] += v[i][2]; run = v[i][3]; }
            float inc = run;
#pragma unroll
            for (int ofs = 1; ofs < 64; ofs <<= 1) { const float t = __shfl_up(inc, ofs); if (lane >= ofs) inc += t; }
            if (lane == 63) wtot[wave] = inc;
            __syncthreads();
            float carry = inc - run;
#pragma unroll
            for (int w = 0; w < 8; ++w) if (w < wave) carry += wtot[w];
#pragma unroll
            for (int i = 0; i < 8; ++i) { v[i] = v[i] + carry; *((f32x4*)o + i) = v[i]; }
        } else {
            const int sidx = (vcu - 16) * 8 + wave, bs = vcu - 16, hh = wave;
            const float* in = cbl + ((size_t)bs * PAST + 64 * lane) * 8 + hh; float* o = Fs + (size_t)sidx * FS_PITCH + 64 * lane;
            float v[64];
#pragma unroll
            for (int i = 0; i < 64; ++i) v[i] = in[i * 8];
            float run = 0.f;
#pragma unroll
            for (int i = 0; i < 64; ++i) { run += v[i]; v[i] = run; }
            float inc = run;
#pragma unroll
            for (int ofs = 1; ofs < 64; ofs <<= 1) { const float t = __shfl_up(inc, ofs); if (lane >= ofs) inc += t; }
            const float carry = inc - run;
#pragma unroll
            for (int i = 0; i < 16; ++i) { f32x4 q4 = {v[4 * i] + carry, v[4 * i + 1] + carry, v[4 * i + 2] + carry, v[4 * i + 3] + carry}; *((f32x4*)o + i) = q4; }
            const float last = __shfl(inc, 63);
            if (lane == 0) { float r2 = last; float* on = Fs + (size_t)sidx * FS_PITCH + PAST;
                for (int i = 0; i < 16; ++i) { r2 += LFn[sidx * 16 + i]; on[i] = r2; }
                for (int i = 16; i < 64; ++i) on[i] = r2; }
            __syncthreads();
        }
    }
#pragma nounroll
    for (int rep = 0; rep < REP_P1; ++rep) {
        if (rep) xcd_barrier(bar);
        {
            const int tid = fresh_tid(), lane = tid & 63; const int wave = __builtin_amdgcn_readfirstlane(tid >> 6);
            if (rep == 0 && wave < 3) { const int task = vcu * 3 + wave;
                if (task < 768) { const int mb = task & 3, nb = task >> 2;
                    f32x16 acc = f32x16{}; acc = mini_tile(XN + (size_t)(MP + 32 * mb) * DM, WIN + (size_t)(32 * nb) * DM, 0, 64, acc, lane & 31, lane >> 5);
                    SampleInProj SE{QA, KA, VA, SZA, QB, KB, VB, SZB, SMA, SMB, out};
                    sample_inproj_store(SE, acc, 32 * mb, 32 * nb, lane & 31, lane >> 5); } }
        }
        pg8::Gemm g{XN, WIN, DM, DM / 64}; pg8::StaticOrder S; S.init(MP, NG, G, bx, 1);
        pg8::EpiInProj E{QA, KA, VA, SZA, QB, KB, VB, SZB, SMA, SMB, out, (unsigned*)(ctl + CW_KNORM)};
        pg8::gemm_phase<pg8::EpiInProj, pg8::StaticOrder>(lds, g, S, E);
    }
    xcd_barrier(bar);

#pragma nounroll
    for (int rep = 0; rep < REP_P2; ++rep) {
        if (rep) xcd_barrier(bar);
        att::Ctx X; X.lds = lds; X.QA = QA; X.KA = KA; X.VA = VA; X.QB = QB; X.KB = KB; X.VB = VB; X.SZA = SZA; X.SZB = SZB; X.G = XN;
        X.Fp = Fp; X.Fs = Fs; X.rel = rel; X.cak = cak; X.cav = cav; X.cbk = cbk; X.cbv = cbv; X.knorm = (const unsigned*)(ctl + CW_KNORM);
        constexpr int NU = 64 + 1024 + 1024 + 64;
        gu32* qctr = ctl + CW_QUEUE + rep * 64;
        volatile LAS unsigned* qw = (volatile LAS unsigned*)(lds + MISC_OFF) + 16;
        if (threadIdx.x == 0) qw[0] = __hip_atomic_fetch_add(qctr, 1u, RLX_AGENT);
        __syncthreads();
        for (;;) {
            const int u = (int)__builtin_amdgcn_readfirstlane(qw[0]);
            if (u >= NU) break;
            unsigned nxt = 0u;
            if (threadIdx.x == 0) nxt = __hip_atomic_fetch_add(qctr, 1u, RLX_AGENT);

            if (u < 64) { for (int r2 = 0; r2 < REP_S; ++r2) att::sample_unit<0>(X, u >> 3, u & 7); }
            else if (u < 64 + 2048) { const int kind = (u - 64) >> 10, idx = (u - 64) & 1023;
                const int hh = ((idx & 7) + (idx >> 8)) & 7, bb = (idx >> 3) & 1, qb = 63 - (idx >> 4);
                if (kind == 0) { for (int r2 = 0; r2 < REP_FP; ++r2) att::prompt_unit<0, 8>(X, bb, hh, qb); } else { for (int r2 = 0; r2 < REP_BP; ++r2) att::prompt_unit<1, 8>(X, bb, hh, qb); } }
            else { const int i2 = u - 64 - 2048; for (int r2 = 0; r2 < REP_S; ++r2) att::sample_unit<1>(X, i2 >> 3, i2 & 7); }
            if (threadIdx.x == 0) qw[0] = nxt;
            __syncthreads();
        }
    }
    xcd_barrier(bar);

#pragma nounroll
    for (int rep = 0; rep < REP_P3A; ++rep) {
        if (rep) xcd_barrier(bar);
        if (rep == 0 && vcu < 16) {
            const int tid = fresh_tid(), lane = tid & 63, r32 = lane & 31, hi = lane >> 5; const int wave = __builtin_amdgcn_readfirstlane(tid >> 6);
            const int task = vcu * 8 + wave, mb = task & 3, nb = task >> 2;
            f32x16 a1 = f32x16{}, a2 = f32x16{};
            a1 = mini_tile(XN + (size_t)(MP + 32 * mb) * DM, WBR + (size_t)(32 * nb) * DM, 0, 32, a1, r32, hi);
            a2 = mini_tile(XN + (size_t)(MP + 32 * mb) * DM, WBR + (size_t)(32 * nb) * DM, 512, 32, a2, r32, hi);
            const size_t grow = (size_t)MP + 32 * mb + r32;
#pragma unroll
            for (int g4 = 0; g4 < 4; ++g4) { const int col = 32 * nb + 8 * g4 + 4 * hi;
                const v2u sa = *(const v2u*)(SMA + grow * 1024 + col), sb = *(const v2u*)(SMB + grow * 1024 + col);
                v2u w; w.x = cvtpk(bflo(sa.x) * a1[4 * g4] + bflo(sb.x) * a2[4 * g4], bfhi(sa.x) * a1[4 * g4 + 1] + bfhi(sb.x) * a2[4 * g4 + 1]);
                w.y = cvtpk(bflo(sa.y) * a1[4 * g4 + 2] + bflo(sb.y) * a2[4 * g4 + 2], bfhi(sa.y) * a1[4 * g4 + 3] + bfhi(sb.y) * a2[4 * g4 + 3]);
                *(v2u*)(MG + grow * 1024 + col) = w; }
        }
        pg8::Gemm g{XN, WBR, DM, 8}; pg8::StaticOrder S; S.init(MP, DM, G, bx, 2);
        pg8::EpiMerge E{SMA, SMB, MG};
        pg8::gemm_phase<pg8::EpiMerge, pg8::StaticOrder>(lds, g, S, E);
    }
    xcd_barrier(bar);
#pragma nounroll
    for (int rep = 0; rep < REP_P3B; ++rep) {
        if (rep) xcd_barrier(bar);
        if (rep == 0 && vcu < 16) {
            const int tid = fresh_tid(), lane = tid & 63, r32 = lane & 31, hi = lane >> 5; const int wave = __builtin_amdgcn_readfirstlane(tid >> 6);
            const int task = vcu * 8 + wave, mb = task & 3, nb = task >> 2;
            f32x16 a1 = f32x16{};
            a1 = mini_tile(MG + (size_t)(MP + 32 * mb) * DM, WOUT + (size_t)(32 * nb) * DM, 0, 64, a1, r32, hi);
            const size_t grow = (size_t)MP + 32 * mb + r32;
#pragma unroll
            for (int g4 = 0; g4 < 4; ++g4) { const f32x4 v = {a1[4 * g4], a1[4 * g4 + 1], a1[4 * g4 + 2], a1[4 * g4 + 3]}; *(f32x4*)(OUTF + grow * 1024 + 32 * nb + 8 * g4 + 4 * hi) = v; }
        }
        pg8::Gemm g{MG, WOUT, DM, DM / 64}; pg8::StaticOrder S; S.init(MP, DM, G, bx, 1);
        pg8::EpiF32 E{OUTF, DM};
        pg8::gemm_phase<pg8::EpiF32, pg8::StaticOrder>(lds, g, S, E);
    }
    xcd_barrier(bar);
#pragma nounroll
    for (int rep = 0; rep < REP_P4; ++rep) {
        const int tid = fresh_tid(), lane = tid & 63; const int wave = __builtin_amdgcn_readfirstlane(tid >> 6); const int gw = vcu * 8 + wave;
        f32x4 gv[4];
#pragma unroll
        for (int j = 0; j < 4; ++j) gv[j] = *((const f32x4*)g_post + lane + 64 * j);
        for (int m = gw; m < MP + MS; m += NGW) {
            const float* xrow = (m < MP) ? x_p + (size_t)m * DM : x_s + (size_t)(m - MP) * DM;
            float* yrow = (m < MP) ? out + O_YP + (size_t)m * DM : out + O_YS + (size_t)(m - MP) * DM;
            const float* orow = OUTF + (size_t)m * DM;
            f32x4 v[4], xv[4]; float ss = 0.f;
#pragma unroll
            for (int j = 0; j < 4; ++j) { v[j] = *((const f32x4*)orow + lane + 64 * j); xv[j] = *((const f32x4*)xrow + lane + 64 * j);
                ss += (v[j][0] * v[j][0] + v[j][1] * v[j][1]) + (v[j][2] * v[j][2] + v[j][3] * v[j][3]); }
            ss = wave_sum(ss);
            const float rs = 1.0f / sqrtf(ss * (1.0f / DM) + EPS);
#pragma unroll
            for (int j = 0; j < 4; ++j) *((f32x4*)yrow + lane + 64 * j) = xv[j] + v[j] * rs * gv[j];
        }
    }
}

extern "C" void kernel_launch(void* const* d_in, const int* in_sizes, int n_in, void* d_out, int out_size, void* d_ws, size_t ws_size, hipStream_t stream) {
    static int grid = 0;
    if (grid == 0) {
        if (n_in != 15 || in_sizes[0] != MP * DM || (size_t)out_size != O_END || ws_size < WS_END) {
            fprintf(stderr, "kernel_launch: unexpected shapes: n_in %d in0 %d out %d ws %zu (need %zu)\n", n_in, n_in > 0 ? in_sizes[0] : -1, out_size, ws_size, (size_t)WS_END); grid = -1; return; }
        int dev = 0, cus = 0, per_cu = 0;
        if (hipGetDevice(&dev) != hipSuccess || hipDeviceGetAttribute(&cus, hipDeviceAttributeMultiprocessorCount, dev) != hipSuccess) { fprintf(stderr, "kernel_launch: device query failed\n"); grid = -1; return; }
        if (hipFuncSetAttribute((const void*)fwd_kernel, hipFuncAttributeMaxDynamicSharedMemorySize, LDS_BYTES) != hipSuccess) { fprintf(stderr, "kernel_launch: hipFuncSetAttribute failed\n"); grid = -1; return; }
        if (hipOccupancyMaxActiveBlocksPerMultiprocessor(&per_cu, (const void*)fwd_kernel, 512, LDS_BYTES) != hipSuccess || per_cu < 1) {
            fprintf(stderr, "kernel_launch: occupancy query reports %d blocks per CU\n", per_cu); (void)hipGetLastError(); grid = -1; return; }
        grid = cus;
    }
    if (grid < 0) return;
    if (hipMemsetAsync((char*)d_ws + WS_CTL, 0, CTL_ZERO_BYTES, stream) != hipSuccess) { fprintf(stderr, "kernel_launch: memset failed\n"); return; }
    Args a{};
    for (int i = 0; i < 15; ++i) a.in[i] = (const float*)d_in[i];
    a.out = (float*)d_out; a.ws = (unsigned char*)d_ws;
    hipLaunchKernelGGL(fwd_kernel, dim3(grid), dim3(512), LDS_BYTES, stream, a);
    const hipError_t le = hipPeekAtLastError();
    if (le != hipSuccess) fprintf(stderr, "kernel_launch: launch failed: %s\n", hipGetErrorName(le));
}
```

```cpp
#include <hip/hip_runtime.h>
#include <hip/hip_bf16.h>
#include <cstdio>
#include <cstdint>

constexpr int DM = 1024, NB = 2, SEQ = 16384, DECB = 8, DECS = 16, PAST = 4096, AKEEP = 512;
constexpr int NH = 8, HD = 64, WA = 512;
constexpr int NIN = 6152;
constexpr int NG = 6144;
constexpr int MP = NB * SEQ;
constexpr int MS = DECB * DECS;
constexpr int MTOT = MP + 256;
constexpr int NREL = 192;
constexpr float EPS = 1e-6f;
constexpr float L2E = 1.4426950408889634f;
constexpr float C2 = 0.125f * L2E;
constexpr int FS_PITCH = 4160;

constexpr size_t O_YP = 0, O_YS = 33554432, O_AKP = 33685504, O_AVP = 34209792, O_BKP = 34734080, O_BVP = 51511296, O_BLP = 68288512,
                 O_AKS = 68550656, O_AVS = 70647808, O_BKS = 72744960, O_BVS = 72810496, O_BLS = 72876032, O_END = 72877056;

constexpr size_t MiB = 1u << 20;
constexpr size_t WS_CTL = 0, CTL_ZERO_BYTES = 1 * MiB;
constexpr size_t WS_FP = 1 * MiB;
constexpr size_t WS_LFP = 2 * MiB;
constexpr size_t WS_FS = 3 * MiB;
constexpr size_t WS_LFN = 5 * MiB;
constexpr size_t WS_WIN = 6 * MiB;
constexpr size_t WS_WBR = 18 * MiB;
constexpr size_t WS_WOUT = 20 * MiB;
constexpr size_t WS_XN = 24 * MiB;
constexpr size_t ACT_BYTES = (size_t)MTOT * 512 * 2;
constexpr size_t WS_QA = 89 * MiB, WS_KA = 122 * MiB, WS_VA = 155 * MiB, WS_QB = 188 * MiB, WS_KB = 221 * MiB, WS_VB = 254 * MiB;
constexpr size_t WS_MG = 89 * MiB;
constexpr size_t WS_OUTF = 155 * MiB;
constexpr size_t WS_SZA = 287 * MiB, WS_SZB = 320 * MiB;
constexpr size_t WS_SMA = 353 * MiB, WS_SMB = 418 * MiB;
constexpr size_t WS_END = 483 * MiB;
static_assert(ACT_BYTES <= 33 * MiB && WS_XN + 2 * ACT_BYTES <= WS_QA && WS_OUTF + (size_t)MTOT * 1024 * 4 <= WS_SZA && WS_MG + 2 * ACT_BYTES <= WS_OUTF, "ws map");

constexpr int CW_KNORM = 64;
constexpr int CW_QUEUE = 1024;
constexpr int CW_BAR = 4096;

constexpr int RING_BYTES = 131072;
constexpr int LDSCTL_OFF = RING_BYTES, MISC_OFF = LDSCTL_OFF + 320;
constexpr int TB_OFF = LDSCTL_OFF + 1024;
constexpr int WSF_OFF = LDSCTL_OFF + 2048;
constexpr int QMX_OFF = LDSCTL_OFF + 4096;
constexpr int LDS_BYTES = 147456;

#define GAS __attribute__((address_space(1)))
#define LAS __attribute__((address_space(3)))
typedef unsigned short bf16;
typedef unsigned v4u __attribute__((ext_vector_type(4)));
typedef unsigned v2u __attribute__((ext_vector_type(2)));
typedef float f32x4 __attribute__((ext_vector_type(4)));
typedef float f32x2 __attribute__((ext_vector_type(2)));
typedef float f32x16 __attribute__((ext_vector_type(16)));
typedef short bf16x8 __attribute__((ext_vector_type(8)));
typedef short s16x4 __attribute__((ext_vector_type(4)));
typedef short v4i16_t __attribute__((ext_vector_type(4)));
typedef __bf16 bf16x2_t __attribute__((ext_vector_type(2)));
typedef GAS unsigned gu32;
#define RLX_AGENT __ATOMIC_RELAXED, __HIP_MEMORY_SCOPE_AGENT

__device__ __forceinline__ unsigned cvtpk(float lo, float hi) { f32x2 v = {lo, hi}; bf16x2_t b = __builtin_convertvector(v, bf16x2_t); return __builtin_bit_cast(unsigned, b); }
__device__ __forceinline__ int fresh_tid() { int t = threadIdx.x; asm volatile("" : "+v"(t)); return t; }
__device__ __forceinline__ float bflo(unsigned u) { return __uint_as_float(u << 16); }
__device__ __forceinline__ float bfhi(unsigned u) { return __uint_as_float(u & 0xffff0000u); }
__device__ __forceinline__ float fexp2(float x) { return __builtin_amdgcn_exp2f(x); }
__device__ __forceinline__ float sigmoidf_(float v) { return __builtin_amdgcn_rcpf(1.0f + fexp2(-v * L2E)); }

namespace pg8 {
#define PG8_LAS __attribute__((address_space(3)))
typedef unsigned short bf16_t;
typedef unsigned u32x4 __attribute__((ext_vector_type(4)));
constexpr int BM = 256, BK = 64, HALF = 128, HTB = HALF * BK * 2, STAGE_BYTES = 8 * HTB, NXCD = 8, WGM = 8;

__host__ __device__ __forceinline__ int lds_byte(int r, int c) { const int st = (r >> 4) * 2 + (c >> 5), rr = r & 15, cc = c & 31, ob = rr * 64 + cc * 2; return st * 1024 + (ob ^ (((ob >> 9) & 1) << 5)); }
__host__ __device__ __forceinline__ void stage_rc(int b, int& R, int& C) { const int st = b / 1024, sb = b % 1024, swz = sb ^ (((sb >> 9) & 1) << 5); R = (st >> 1) * 16 + swz / 64; C = (st & 1) * 32 + (swz % 64) / 2; }
__host__ __device__ __forceinline__ int perm32(int rho) { const int n = rho >> 4, i = rho & 15; return 8 * (i >> 2) + 4 * n + (i & 3); }

struct Unit { int pm, pn, kh; };
struct Gemm { const bf16_t* A; const bf16_t* Bt; int ldk; int nt; };

struct StaticOrder {
    int nM, nN, nwg, G, c, nkh;
    __device__ void init(int M, int N, int G_, int c_, int nkh_) { nM = M / BM; nN = N / BM; nwg = nM * nN; G = G_; c = c_; nkh = nkh_; }
    __device__ bool next(int i, Unit& u) const {
        const int ti = i / nkh; u.kh = i - ti * nkh;
        const long L = (long)ti * G + c; if (L >= nwg) return false;
        int wgid = (int)L; { const int q = nwg / NXCD, r = nwg % NXCD, xcd = wgid % NXCD, off = wgid / NXCD; wgid = (xcd < r ? xcd * (q + 1) : r * (q + 1) + (xcd - r) * q) + off; }
        const int nig = WGM * nN, gid = wgid / nig, fm = gid * WGM, gsz = (nM - fm) < WGM ? (nM - fm) : WGM;
        u.pm = fm + ((wgid % nig) % gsz); u.pn = (wgid % nig) / gsz; return true;
    }
};


struct EpiInProj {
    static constexpr bool PERM = true;
    bf16_t *QA, *KA, *VA, *SZA, *QB, *KB, *VB, *SZB, *SMA, *SMB;
    float* out;
    unsigned* knorm;
    __device__ __forceinline__ bool keep(const Unit&) const { return false; }
    __device__ __forceinline__ void operator()(f32x4 (&acc)[2][2][4][2], const Unit& u, int wr, int wc, int fr, int fq) const {
        const int pn = u.pn, pm = u.pm;
        bf16_t* dst; int ldd, dcol, actk; float* f32p = nullptr; int fmode = 0, nvalid = 256; bool dnorm = false; int noff = 0;
        const bool sample = (pm == 128);
        if (pn < 16) {
            const int seg = pn >> 1; dcol = (pn & 1) * 256; ldd = 512;
            if (seg == 0) { dst = QA; actk = 1; }
            else if (seg == 1) { dst = KA; actk = 0; }
            else if (seg == 2) { dst = VA; actk = 0; }
            else if (seg == 3) { dst = SZA; actk = 2; }
            else if (seg == 4) { dst = QB; actk = 1; }
            else if (seg == 5) { dst = KB; actk = 0; }
            else if (seg == 6) { dst = VB; actk = 0; }
            else { dst = SZB; actk = 2; }
            if (seg == 1 || seg == 2) {
                if (!sample) { const int bt = pm & 63; if (bt >= 62) { f32p = out + (seg == 1 ? O_AKP : O_AVP) + ((size_t)((pm >> 6) * 512 + (bt - 62) * 256)) * 512 + dcol; fmode = 1; } }
                else { f32p = out + (seg == 1 ? O_AKS : O_AVS) + dcol; fmode = 2; nvalid = 128; }
            } else if (seg == 4) { if (!sample) { dnorm = true; noff = 32; }
            } else if (seg == 5 || seg == 6) {
                if (!sample) { f32p = out + (seg == 5 ? O_BKP : O_BVP) + (size_t)pm * 256 * 512 + dcol; fmode = 1; dnorm = (seg == 5); }
                else { f32p = out + (seg == 5 ? O_BKS : O_BVS) + dcol; fmode = 1; nvalid = 128; }
            }
        } else { ldd = 1024; actk = 3; if (pn < 20) { dst = SMA; dcol = (pn - 16) * 256; } else { dst = SMB; dcol = (pn - 20) * 256; } }
        const int rl0 = wr * 64 + fr, cl = wc * 32 + 8 * fq;
        if (dnorm) {
#pragma unroll
            for (int bj = 0; bj < 2; ++bj) { float mx = 0.f;
#pragma unroll
                for (int ai = 0; ai < 2; ++ai)
#pragma unroll
                    for (int m = 0; m < 4; ++m) { const f32x4 a = acc[ai][bj][m][0], b = acc[ai][bj][m][1];
                        float s = (a[0] * a[0] + a[1] * a[1]) + (a[2] * a[2] + a[3] * a[3]) + (b[0] * b[0] + b[1] * b[1]) + (b[2] * b[2] + b[3] * b[3]);
                        s += __shfl_xor(s, 16); s += __shfl_xor(s, 32); mx = fmaxf(mx, s); }
                mx = fmaxf(mx, __shfl_xor(mx, 1)); mx = fmaxf(mx, __shfl_xor(mx, 2)); mx = fmaxf(mx, __shfl_xor(mx, 4)); mx = fmaxf(mx, __shfl_xor(mx, 8));
                if (fr == 0 && fq == 0) { const int head = (pn & 1) * 4 + bj * 2 + (wc >> 1);
                    __hip_atomic_fetch_max(knorm + noff + (((pm >> 6) * 8 + head) * 2 + (wc & 1)), __float_as_uint(mx), __ATOMIC_RELAXED, __HIP_MEMORY_SCOPE_AGENT); }
            }
        }
#pragma unroll
        for (int ai = 0; ai < 2; ++ai)
#pragma unroll
            for (int m = 0; m < 4; ++m) { const int rl = rl0 + ai * HALF + m * 16; const size_t grow = (size_t)pm * BM + rl;
#pragma unroll
                for (int bj = 0; bj < 2; ++bj) { f32x4 v0 = acc[ai][bj][m][0], v1 = acc[ai][bj][m][1];
                    if (f32p != nullptr && rl < nvalid) { const size_t ro = (fmode == 1) ? (size_t)rl * 512 : ((size_t)((rl >> 4) * 512 + 496 + (rl & 15))) * 512;
                        *(f32x4*)(f32p + ro + cl + bj * HALF) = v0; *(f32x4*)(f32p + ro + cl + bj * HALF + 4) = v1; }
                    if (actk == 1) { v0 = v0 * C2; v1 = v1 * C2; }
                    else if (actk == 2) {
#pragma unroll
                        for (int e = 0; e < 4; ++e) { v0[e] = v0[e] * sigmoidf_(v0[e]); v1[e] = v1[e] * sigmoidf_(v1[e]); } }
                    else if (actk == 3) {
#pragma unroll
                        for (int e = 0; e < 4; ++e) { v0[e] = sigmoidf_(v0[e]); v1[e] = sigmoidf_(v1[e]); } }
                    u32x4 w; w.x = cvtpk(v0[0], v0[1]); w.y = cvtpk(v0[2], v0[3]); w.z = cvtpk(v1[0], v1[1]); w.w = cvtpk(v1[2], v1[3]);
                    *(u32x4*)(dst + grow * ldd + dcol + cl + bj * HALF) = w; } }
    }
};
struct EpiMerge {
    static constexpr bool PERM = true;
    const bf16_t *SMA, *SMB; bf16_t* MG;
    __device__ __forceinline__ bool keep(const Unit& u) const { return u.kh == 0; }
    __device__ __forceinline__ void operator()(f32x4 (&acc)[2][2][4][2], const Unit& u, int wr, int wc, int fr, int fq) const {
        const int rl0 = wr * 64 + fr, cl = wc * 32 + 8 * fq;
        const size_t off0 = ((size_t)u.pm * BM + rl0) * 1024 + u.pn * BM + cl;
#pragma unroll
        for (int ai = 0; ai < 2; ++ai) {
            u32x4 sb[4][2], sa[4][2];
#pragma unroll
            for (int m = 0; m < 4; ++m)
#pragma unroll
                for (int bj = 0; bj < 2; ++bj) { const size_t off = off0 + (size_t)(ai * HALF + m * 16) * 1024 + bj * HALF;
                    sb[m][bj] = *(const u32x4*)(SMB + off); if (u.kh == 0) sa[m][bj] = *(const u32x4*)(SMA + off); }
#pragma unroll
            for (int m = 0; m < 4; ++m)
#pragma unroll
                for (int bj = 0; bj < 2; ++bj) { const size_t off = off0 + (size_t)(ai * HALF + m * 16) * 1024 + bj * HALF;
                    const u32x4 b4 = sb[m][bj];
                    float g[8] = {bflo(b4.x), bfhi(b4.x), bflo(b4.y), bfhi(b4.y), bflo(b4.z), bfhi(b4.z), bflo(b4.w), bfhi(b4.w)};
                    if (u.kh == 0) { const u32x4 a4 = sa[m][bj];
                        const float a[8] = {bflo(a4.x), bfhi(a4.x), bflo(a4.y), bfhi(a4.y), bflo(a4.z), bfhi(a4.z), bflo(a4.w), bfhi(a4.w)};
#pragma unroll
                        for (int e = 0; e < 8; ++e) g[e] = a[e] * __builtin_amdgcn_rcpf(g[e]);
#pragma unroll
                        for (int e = 0; e < 4; ++e) { acc[ai][bj][m][0][e] *= g[e]; acc[ai][bj][m][1][e] *= g[4 + e]; }
                    } else { f32x4 v0 = acc[ai][bj][m][0], v1 = acc[ai][bj][m][1];
#pragma unroll
                        for (int e = 0; e < 4; ++e) { v0[e] *= g[e]; v1[e] *= g[4 + e]; }
                        u32x4 w; w.x = cvtpk(v0[0], v0[1]); w.y = cvtpk(v0[2], v0[3]); w.z = cvtpk(v1[0], v1[1]); w.w = cvtpk(v1[2], v1[3]);
                        *(u32x4*)(MG + off) = w; } }
        }
    }
};
struct EpiF32 {
    static constexpr bool PERM = false;
    float* C; int ldc;
    __device__ __forceinline__ bool keep(const Unit&) const { return false; }
    __device__ __forceinline__ void operator()(f32x4 (&acc)[2][2][4][2], const Unit& u, int wr, int wc, int fr, int fq) const {
        const int row0 = u.pm * BM + wr * 64 + fr, col0 = u.pn * BM + wc * 32 + 4 * fq;
#pragma unroll
        for (int ai = 0; ai < 2; ++ai)
#pragma unroll
            for (int m = 0; m < 4; ++m) { float* rowp = C + (size_t)(row0 + ai * HALF + m * 16) * ldc + col0;
#pragma unroll
                for (int bj = 0; bj < 2; ++bj)
#pragma unroll
                    for (int n = 0; n < 2; ++n) *(f32x4*)(rowp + bj * HALF + n * 16) = acc[ai][bj][m][n]; }
    }
};

template <class Epi, class Sched>
__device__ __forceinline__ void gemm_phase(PG8_LAS unsigned char* lds, const Gemm g, const Sched& S, const Epi& E) {
    const int tid = fresh_tid(), wid = __builtin_amdgcn_readfirstlane(tid >> 6), lane = tid & 63, wr = wid >> 2, wc = wid & 3, fr = lane & 15, fq = lane >> 4;
    const int K = g.ldk, nt = g.nt;
    unsigned voffA[2], voffB[2];
#pragma unroll
    for (int i = 0; i < 2; ++i) { int R, C; stage_rc(tid * 16 + i * 8192, R, C); const int Rb = Epi::PERM ? ((R & ~31) + perm32(R & 31)) : R;
        voffA[i] = (unsigned)(R * K + C) * 2u; voffB[i] = (unsigned)(Rb * K + C) * 2u; }
    const size_t kstep = (size_t)(BK * 2);
    const size_t hstep = (size_t)HALF * K * 2;
    const size_t tstep = 2 * hstep;
    const size_t khb = (size_t)nt * BK * 2;
    const unsigned ldsw = (unsigned)wid * 1024u;
    const int aoff = lds_byte(wr * 64 + fr, fq * 8), boff = lds_byte(wc * 32 + fr, fq * 8);
#define PG8_SA(b, h) (((b) * 2 + (h)) * HTB)
#define PG8_SB(b, h) ((4 + (b) * 2 + (h)) * HTB)
#define PG8_STAGE(bufoff, gbase, voff) do { _Pragma("unroll") for (int _i = 0; _i < 2; ++_i) \
        __builtin_amdgcn_global_load_lds((const unsigned*)((const char*)(gbase) + (voff)[_i]), (PG8_LAS unsigned*)(lds + (bufoff) + ldsw + _i * 8192), 16, 0, 0); } while (0)
#define PG8_LDA(dst, b, h) do { _Pragma("unroll") for (int m = 0; m < 4; ++m) _Pragma("unroll") for (int k = 0; k < 2; ++k) dst[m][k] = *(const PG8_LAS bf16x8*)(lds + PG8_SA(b, h) + aoff + m * 2048 + k * 1024); } while (0)
#define PG8_LDB(dst, b, h) do { _Pragma("unroll") for (int n = 0; n < 2; ++n) _Pragma("unroll") for (int k = 0; k < 2; ++k) dst[n][k] = *(const PG8_LAS bf16x8*)(lds + PG8_SB(b, h) + boff + n * 2048 + k * 1024); } while (0)
#define PG8_MMA(ai, bj, At, Bt) do { __builtin_amdgcn_s_setprio(1); _Pragma("unroll") for (int m = 0; m < 4; ++m) _Pragma("unroll") for (int n = 0; n < 2; ++n) _Pragma("unroll") for (int k = 0; k < 2; ++k) \
        acc[ai][bj][m][n] = __builtin_amdgcn_mfma_f32_16x16x32_bf16(Bt[n][k], At[m][k], acc[ai][bj][m][n], 0, 0, 0); __builtin_amdgcn_s_setprio(0); } while (0)
#define PG8_WAIT_V(n) asm volatile("s_waitcnt vmcnt(" #n ")" ::: "memory")
#define PG8_WAIT_L(n) asm volatile("s_waitcnt lgkmcnt(" #n ")" ::: "memory")
#define PG8_BAR __builtin_amdgcn_s_barrier()
#define PG8_SCHED __builtin_amdgcn_sched_barrier(0)
    Unit cur, nxt; int ui = 0;
    if (!S.next(0, cur)) return;
    f32x4 acc[2][2][4][2];
#pragma unroll
    for (int a = 0; a < 2; ++a)
#pragma unroll
        for (int b = 0; b < 2; ++b)
#pragma unroll
            for (int m = 0; m < 4; ++m)
#pragma unroll
                for (int n = 0; n < 2; ++n) acc[a][b][m][n] = (f32x4){0.f, 0.f, 0.f, 0.f};
    bf16x8 At[4][2], B0[2][2], B1[2][2];
    const char* cA = (const char*)g.A + (size_t)cur.pm * tstep + (size_t)cur.kh * khb; const char* cB = (const char*)g.Bt + (size_t)cur.pn * tstep + (size_t)cur.kh * khb;
    PG8_STAGE(PG8_SB(0, 0), cB, voffB); PG8_STAGE(PG8_SB(0, 1), cB + hstep, voffB); PG8_STAGE(PG8_SA(0, 0), cA, voffA); PG8_STAGE(PG8_SA(0, 1), cA + hstep, voffA);
    if (wr == 1) PG8_BAR;
    PG8_WAIT_V(2); PG8_BAR;
    PG8_STAGE(PG8_SB(1, 0), cB + kstep, voffB); PG8_STAGE(PG8_SA(1, 0), cA + kstep, voffA); PG8_STAGE(PG8_SB(1, 1), cB + hstep + kstep, voffB);
    PG8_WAIT_V(6); PG8_BAR;
    for (;;) {
        const bool has_next = S.next(ui + 1, nxt);
        const char* nA = has_next ? (const char*)g.A + (size_t)nxt.pm * tstep + (size_t)nxt.kh * khb : cA; const char* nB = has_next ? (const char*)g.Bt + (size_t)nxt.pn * tstep + (size_t)nxt.kh * khb : cB;
        for (int t = 0; t < nt; t += 2) {
            const bool last = (t == nt - 2);
            const char* a1 = cA + (size_t)(t + 1) * kstep;
            const char* a2 = last ? nA : cA + (size_t)(t + 2) * kstep; const char* b2 = last ? nB : cB + (size_t)(t + 2) * kstep;
            const char* a3 = a2 + kstep; const char* b3 = b2 + kstep;
            PG8_LDB(B0, 0, 0); PG8_LDB(B1, 0, 1); PG8_SCHED; PG8_LDA(At, 0, 0); PG8_STAGE(PG8_SA(1, 1), a1 + hstep, voffA);
            PG8_WAIT_V(8); PG8_WAIT_L(0); PG8_BAR; PG8_MMA(0, 0, At, B0); PG8_MMA(0, 1, At, B1); PG8_BAR; PG8_SCHED;
            PG8_LDA(At, 0, 1); PG8_STAGE(PG8_SB(0, 0), b2, voffB); PG8_STAGE(PG8_SB(0, 1), b2 + hstep, voffB); PG8_STAGE(PG8_SA(0, 0), a2, voffA);
            PG8_WAIT_V(8); PG8_WAIT_L(0); PG8_BAR; PG8_MMA(1, 0, At, B0); PG8_MMA(1, 1, At, B1); PG8_BAR; PG8_SCHED;
            PG8_LDB(B0, 1, 0); PG8_LDB(B1, 1, 1); PG8_SCHED; PG8_LDA(At, 1, 0); PG8_STAGE(PG8_SA(0, 1), a2 + hstep, voffA);
            PG8_WAIT_V(8); PG8_WAIT_L(0); PG8_BAR; PG8_MMA(0, 0, At, B0); PG8_MMA(0, 1, At, B1); PG8_BAR; PG8_SCHED;
            PG8_LDA(At, 1, 1); PG8_STAGE(PG8_SB(1, 0), b3, voffB); PG8_STAGE(PG8_SB(1, 1), b3 + hstep, voffB); PG8_STAGE(PG8_SA(1, 0), a3, voffA);
            PG8_WAIT_V(8); PG8_WAIT_L(0); PG8_BAR; PG8_MMA(1, 0, At, B0); PG8_MMA(1, 1, At, B1); PG8_BAR; PG8_SCHED;
        }
        if (wr == 0) PG8_BAR;
        E(acc, cur, wr, wc, fr, fq);
        if (!has_next) break;
        if (!E.keep(cur)) {
#pragma unroll
            for (int a = 0; a < 2; ++a)
#pragma unroll
                for (int b = 0; b < 2; ++b)
#pragma unroll
                    for (int m = 0; m < 4; ++m)
#pragma unroll
                        for (int n = 0; n < 2; ++n) acc[a][b][m][n] = (f32x4){0.f, 0.f, 0.f, 0.f};
        }
        cur = nxt; cA = nA; cB = nB; ++ui;
        if (wr == 1) PG8_BAR;
    }
    PG8_WAIT_V(0);
    PG8_BAR;
#undef PG8_SA
#undef PG8_SB
#undef PG8_STAGE
#undef PG8_LDA
#undef PG8_LDB
#undef PG8_MMA
#undef PG8_WAIT_V
#undef PG8_WAIT_L
#undef PG8_BAR
#undef PG8_SCHED
}
}

#define XB_TMO      128
#define XB_XCNT(j)  (256  + 64 * (j))
#define XB_XSUB(j)  (1280 + 64 * (j))
#define XB_XGEN(j)  (2304 + 64 * (j))
#define XB_TOP      3328
#define XB_TOPGEN   3392
#define XCD_BAR_WORDS 3456
#define XB_SPIN_CAP (1u << 18)
__device__ __forceinline__ unsigned xb_ld(unsigned* p)              { return __hip_atomic_load(p, __ATOMIC_RELAXED, __HIP_MEMORY_SCOPE_AGENT); }
__device__ __forceinline__ unsigned xb_add(unsigned* p, unsigned v) { return __hip_atomic_fetch_add(p, v, __ATOMIC_RELAXED, __HIP_MEMORY_SCOPE_AGENT); }
__device__ __forceinline__ unsigned xb_xcc_id() { return (unsigned)__builtin_amdgcn_s_getreg((3 << 11) | 20) & 0xFu; }
#define XB_SPIN(cond, bar) do { unsigned _sp = 0; while (cond) { __builtin_amdgcn_s_sleep(1); \
    if ((++_sp & 255u) == 0u) { if (xb_ld(&(bar)[XB_TMO])) break; if (_sp > XB_SPIN_CAP) { atomicAdd(&(bar)[XB_TMO], 1u); break; } } } } while (0)
struct XcdBarrier { unsigned* bar; unsigned x; volatile LAS unsigned* st; };
__device__ __forceinline__ XcdBarrier xcd_barrier_post(unsigned* bar, volatile LAS unsigned* st) {
    XcdBarrier b; b.bar = bar; b.x = xb_xcc_id(); b.st = st;
    if (threadIdx.x == 0) (void)xb_add(&bar[XB_XCNT(b.x)], 1u);
    return b;
}
__device__ __forceinline__ void xcd_barrier_complete(unsigned* bar, unsigned x, unsigned& nloc, unsigned& nx) {
    const unsigned G = gridDim.x * gridDim.y * gridDim.z;
    unsigned sum, cnt, mine, sp = 0u;
    for (;;) {
        sum = 0u; cnt = 0u; mine = 0u;
#pragma unroll
        for (unsigned j = 0; j < 16; ++j) { const unsigned c = xb_ld(&bar[XB_XCNT(j)]); sum += c; cnt += (c > 0u) ? 1u : 0u; mine = (j == x) ? c : mine; }
        if (sum == G) break;
        __builtin_amdgcn_s_sleep(1);
        if ((++sp & 255u) == 0u) { if (xb_ld(&bar[XB_TMO])) break; if (sp > XB_SPIN_CAP) { atomicAdd(&bar[XB_TMO], 1u); break; } }
    }
    nloc = mine > 0u ? mine : 1u; nx = cnt > 0u ? cnt : 1u;
}
__device__ __forceinline__ void xcd_barrier(const XcdBarrier& b) {
    asm volatile("s_waitcnt vmcnt(0)" ::: "memory");
    __syncthreads();
    if (threadIdx.x == 0) {
        unsigned* bar = b.bar;
        __builtin_amdgcn_s_waitcnt(0);
        unsigned nloc = b.st[0], nx = b.st[1];
        if (nloc == 0u) { xcd_barrier_complete(bar, b.x, nloc, nx); b.st[0] = nloc; b.st[1] = nx; }
        const unsigned old = xb_add(&bar[XB_XSUB(b.x)], 1u);
        const unsigned gen = old / nloc;
        if (old + 1u == (gen + 1u) * nloc) {
            __builtin_amdgcn_fence(__ATOMIC_RELEASE, "agent");
            asm volatile("s_waitcnt vmcnt(0)" ::: "memory");
            const unsigned og = xb_add(&bar[XB_TOP], 1u);
            const unsigned tg = og / nx;
            if (og + 1u == (tg + 1u) * nx) xb_add(&bar[XB_TOPGEN], 1u);
            else XB_SPIN(xb_ld(&bar[XB_TOPGEN]) == tg, bar);
            __builtin_amdgcn_fence(__ATOMIC_ACQUIRE, "agent");
            xb_add(&bar[XB_XGEN(b.x)], 1u);
            asm volatile("s_waitcnt vmcnt(0)" ::: "memory");
        } else {
            XB_SPIN(xb_ld(&bar[XB_XGEN(b.x)]) == gen, bar);
            __builtin_amdgcn_fence(__ATOMIC_ACQUIRE, "agent");
            asm volatile("s_waitcnt vmcnt(0)" ::: "memory");
        }
    }
    __syncthreads();
}

struct Args { const float* in[15]; float* out; unsigned char* ws; };

__device__ __forceinline__ float wave_sum(float v) {
#pragma unroll
    for (int o = 1; o < 64; o <<= 1) v += __shfl_xor(v, o);
    return v;
}
__device__ __forceinline__ float wave_max(float v) {
#pragma unroll
    for (int o = 1; o < 64; o <<= 1) v = fmaxf(v, __shfl_xor(v, o));
    return v;
}

__device__ __forceinline__ void p0_transpose_item(const float* W, int ldw, int csrc, bf16* WT, int ldt, int kdst, int nrow0, LAS float* scr, int k0, int lane) {
#pragma unroll 8
    for (int i = 0; i < 32; ++i) { const int kk = 2 * i + (lane >> 5); scr[kk * 33 + (lane & 31)] = W[(size_t)(k0 + kk) * ldw + csrc + (lane & 31)]; }
    asm volatile("s_waitcnt lgkmcnt(0)" ::: "memory");
    const int c = lane & 7;
#pragma unroll
    for (int j = 0; j < 4; ++j) { const int n = (lane >> 3) + 8 * j; const LAS float* s = scr + (8 * c) * 33 + n;
        v4u o; o.x = cvtpk(s[0 * 33], s[1 * 33]); o.y = cvtpk(s[2 * 33], s[3 * 33]); o.z = cvtpk(s[4 * 33], s[5 * 33]); o.w = cvtpk(s[6 * 33], s[7 * 33]);
        *(GAS v4u*)(WT + (size_t)(nrow0 + n) * ldt + kdst + k0 + 8 * c) = o; }
    asm volatile("s_waitcnt lgkmcnt(0)" ::: "memory");
}

namespace att {
typedef LAS const unsigned char* ldsc;
__device__ __forceinline__ int crow(int r, int hi) { return (r & 3) + 8 * (r >> 2) + 4 * hi; }
#define MFMA32(a, b, c) __builtin_amdgcn_mfma_f32_32x32x16_bf16(a, b, c, 0, 0, 0)
__device__ __forceinline__ s16x4 vtr(ldsc p) { return __builtin_bit_cast(s16x4, __builtin_amdgcn_ds_read_tr16_b64_v4i16((LAS v4i16_t*)p)); }

__device__ __forceinline__ void qkt(f32x16& p0, f32x16& p1, ldsc Kslot, const bf16x8* qr, const f32x16& c0, const f32x16& c1, int r32, int hi) {
    ldsc kb = Kslot + hi * 1024 + r32 * 16;
#pragma unroll
    for (int d0 = 0; d0 < 4; ++d0) {
        const bf16x8 b0 = *(LAS const bf16x8*)(kb + d0 * 2048);
        const bf16x8 b1 = *(LAS const bf16x8*)(kb + d0 * 2048 + 512);
        if (d0 == 0) { p0 = MFMA32(b0, qr[0], c0); p1 = MFMA32(b1, qr[0], c1); }
        else { p0 = MFMA32(b0, qr[d0], p0); p1 = MFMA32(b1, qr[d0], p1); } }
}
__device__ __forceinline__ float rowmax(const f32x16& p0, const f32x16& p1) {
    float a = fmaxf(p0[0], p1[0]);
#pragma unroll
    for (int r = 1; r < 16; ++r) a = fmaxf(a, fmaxf(p0[r], p1[r]));
    auto rr = __builtin_amdgcn_permlane32_swap(__float_as_uint(a), __float_as_uint(a), false, false);
    return fmaxf(__uint_as_float(rr[0]), __uint_as_float(rr[1]));
}
__device__ __forceinline__ float halfsum(float a) {
    auto rr = __builtin_amdgcn_permlane32_swap(__float_as_uint(a), __float_as_uint(a), false, false);
    return __uint_as_float(rr[0]) + __uint_as_float(rr[1]);
}
__device__ __forceinline__ void softmax_pv(f32x16& p0, f32x16& p1, f32x16 (&o)[2], float& m_run, float& l_run, LAS float* wsf, ldsc Vslot, int lane, int r32, int hi) {
    const float rm = rowmax(p0, p1);
    const float mn = fmaxf(m_run, rm); const float alpha = fexp2(m_run - mn); m_run = mn;
    float s = 0.f;
#pragma unroll
    for (int r = 0; r < 16; ++r) { p0[r] = fexp2(p0[r] - mn); p1[r] = fexp2(p1[r] - mn); s += p0[r] + p1[r]; }
    l_run = l_run * alpha + s;
    if (hi == 0) wsf[r32] = alpha;
#pragma unroll
    for (int g = 0; g < 4; ++g) { const f32x4 a4 = *(LAS const f32x4*)(wsf + 8 * g + 4 * hi);
#pragma unroll
        for (int j = 0; j < 4; ++j) { o[0][4 * g + j] *= a4[j]; o[1][4 * g + j] *= a4[j]; } }
    bf16x8 pa[4];
    { v4u w;
      w.x = cvtpk(p0[0], p0[1]); w.y = cvtpk(p0[2], p0[3]); w.z = cvtpk(p0[4], p0[5]); w.w = cvtpk(p0[6], p0[7]); pa[0] = __builtin_bit_cast(bf16x8, w);
      w.x = cvtpk(p0[8], p0[9]); w.y = cvtpk(p0[10], p0[11]); w.z = cvtpk(p0[12], p0[13]); w.w = cvtpk(p0[14], p0[15]); pa[1] = __builtin_bit_cast(bf16x8, w);
      w.x = cvtpk(p1[0], p1[1]); w.y = cvtpk(p1[2], p1[3]); w.z = cvtpk(p1[4], p1[5]); w.w = cvtpk(p1[6], p1[7]); pa[2] = __builtin_bit_cast(bf16x8, w);
      w.x = cvtpk(p1[8], p1[9]); w.y = cvtpk(p1[10], p1[11]); w.z = cvtpk(p1[12], p1[13]); w.w = cvtpk(p1[14], p1[15]); pa[3] = __builtin_bit_cast(bf16x8, w); }
    ldsc vp = Vslot + ((lane >> 4) & 1) * 32 + (lane & 3) * 8 + (4 * hi + ((lane & 15) >> 2)) * 64;
#pragma unroll
    for (int d0 = 0; d0 < 2; ++d0)
#pragma unroll
        for (int ks = 0; ks < 4; ++ks) { const s16x4 lo = vtr(vp + d0 * 4096 + ks * 1024), hh = vtr(vp + d0 * 4096 + ks * 1024 + 512);
            const bf16x8 vb = (bf16x8){lo[0], lo[1], lo[2], lo[3], hh[0], hh[1], hh[2], hh[3]};
            o[d0] = MFMA32(pa[ks], vb, o[d0]); }
}
__device__ __forceinline__ v4u mul8(v4u a, v4u z) {
    v4u r; r.x = cvtpk(bflo(a.x) * bflo(z.x), bfhi(a.x) * bfhi(z.x)); r.y = cvtpk(bflo(a.y) * bflo(z.y), bfhi(a.y) * bfhi(z.y));
    r.z = cvtpk(bflo(a.z) * bflo(z.z), bfhi(a.z) * bfhi(z.z)); r.w = cvtpk(bflo(a.w) * bflo(z.w), bfhi(a.w) * bfhi(z.w)); return r;
}

struct Ctx {
    LAS unsigned char* lds;
    const bf16 *QA, *KA, *VA, *QB, *KB, *VB, *SZA, *SZB; bf16* G;
    const float *Fp, *Fs, *rel; const float *cak, *cav, *cbk, *cbv;
    const unsigned* knorm;
};

constexpr int PL_K = 0, PL_V = 24576, PL_F = 49152, PL_BT = 51200, PL_OST = 77824, SLOTB = 8192;
__device__ __forceinline__ void glds16(const void* gsrc, unsigned lds_dst) { unsigned keep;
    asm volatile("s_mov_b32 %0, m0\n\ts_mov_b32 m0, %2\n\ts_nop 0\n\tglobal_load_lds_dwordx4 %1, off\n\ts_mov_b32 m0, %0" : "=&s"(keep) : "v"(gsrc), "s"(lds_dst) : "memory"); }
__device__ __forceinline__ void glds4(const void* gsrc, unsigned lds_dst) { unsigned keep;
    asm volatile("s_mov_b32 %0, m0\n\ts_mov_b32 m0, %2\n\ts_nop 0\n\tglobal_load_lds_dword %1, off\n\ts_mov_b32 m0, %0" : "=&s"(keep) : "v"(gsrc), "s"(lds_dst) : "memory"); }
typedef LAS const char* lds_cptr;
__device__ __forceinline__ void kload8(bf16x8* kf, lds_cptr kp) {
    kf[0] = *(LAS const bf16x8*)(kp);        kf[1] = *(LAS const bf16x8*)(kp + 512);
    kf[2] = *(LAS const bf16x8*)(kp + 2048); kf[3] = *(LAS const bf16x8*)(kp + 2560);
    kf[4] = *(LAS const bf16x8*)(kp + 4096); kf[5] = *(LAS const bf16x8*)(kp + 4608);
    kf[6] = *(LAS const bf16x8*)(kp + 6144); kf[7] = *(LAS const bf16x8*)(kp + 6656);
}
__device__ __forceinline__ void kload2(bf16x8* kf, lds_cptr kp, int j) { kf[2 * j] = *(LAS const bf16x8*)(kp + j * 2048); kf[2 * j + 1] = *(LAS const bf16x8*)(kp + j * 2048 + 512); }
__device__ __forceinline__ s16x4 vtr2(lds_cptr p) { return __builtin_bit_cast(s16x4, __builtin_amdgcn_ds_read_tr16_b64_v4i16((LAS v4i16_t*)p)); }
#define SBAR() __builtin_amdgcn_sched_barrier(0)
#define PIN(x) asm volatile("" : "+v"(x))
#define WAITB(N) asm volatile("s_waitcnt vmcnt(" #N ") lgkmcnt(0)\n\ts_barrier" ::: "memory")

template <int KIND, int THRL>
__device__ __forceinline__ void prompt_unit(const Ctx& X, int b, int h, int qb) {
    const int tid = fresh_tid(), lane = tid & 63, r32 = lane & 31, hi = lane >> 5; const int wid = __builtin_amdgcn_readfirstlane(tid >> 6);
    LAS unsigned char* lds = X.lds;
    const bf16* Q = KIND ? X.QA : X.QB; const bf16* Kt = KIND ? X.KA : X.KB; const bf16* Vt = KIND ? X.VA : X.VB; const bf16* SZ = KIND ? X.SZA : X.SZB;
    const size_t rowbase = (size_t)b * SEQ; const int q0 = qb * 256;
    const bf16* Qw = Q + (rowbase + q0 + wid * 32) * 512 + h * 64;
    const unsigned lds0 = (unsigned)(uintptr_t)lds;
    LAS float* wsf = (LAS float*)(lds + WSF_OFF) + wid * 64;
    const float* Fbh = X.Fp + (size_t)(b * 8 + h) * SEQ;
    int j_lo; const int j_hi = 4 * qb + 3; float Fq0L = 0.f;
    if (KIND == 0) {
        const float kn = __uint_as_float(__hip_atomic_load(X.knorm + ((b * 8 + h) * 2), RLX_AGENT)) + __uint_as_float(__hip_atomic_load(X.knorm + ((b * 8 + h) * 2) + 1, RLX_AGENT));
        const float qn = __uint_as_float(__hip_atomic_load(X.knorm + 32 + ((b * 8 + h) * 2), RLX_AGENT)) + __uint_as_float(__hip_atomic_load(X.knorm + 32 + ((b * 8 + h) * 2) + 1, RLX_AGENT));
        const float thr = 2.0f * C2 * sqrtf(qn * kn) * 1.02f + 40.0f;
        const float Fq0 = Fbh[q0]; Fq0L = Fq0 * L2E;
        int cnt = 0, base = 4 * qb - 1;
        for (;;) {
            const int jb = base - lane; bool ok = false;
            if (jb >= 0) ok = (Fq0 - Fbh[64 * jb + 63]) * L2E >= -thr;
            const unsigned long long mk = __ballot(ok);
            const int c = (mk == ~0ull) ? 64 : __builtin_ctzll(~mk);
            cnt += c; if (c < 64) break; base -= 64; if (base < 0) break;
        }
        j_lo = 4 * qb - cnt; if (j_lo < 0) j_lo = 0;
        if (((j_hi - j_lo + 1) & 1) && j_lo > 0) --j_lo;
        j_lo = __builtin_amdgcn_readfirstlane(j_lo);
    } else {
        j_lo = 4 * qb - 8; if (j_lo < 0) j_lo = 0;
    }
    const int n = j_hi - j_lo + 1;
    int ta, tb;
    if (KIND == 0) { ta = 0; tb = n - 4 + (wid >> 1); }
    else { const int cw = 4 * qb + (wid >> 1); ta = cw - 8; if (ta < 0) ta = 0; ta -= j_lo; tb = cw - j_lo; }
    const bf16* Kh = Kt + (rowbase + (size_t)j_lo * 64) * 512 + h * 64; const bf16* Vh = Vt + (rowbase + (size_t)j_lo * 64) * 512 + h * 64;
    const float* Fj = Fbh + 64 * j_lo;
    const bf16* ksrc = Kh + (size_t)lane * 512 + wid * 8;
    const bf16* vsrc = Vh + (size_t)(16 * (wid & 3) + (lane >> 2)) * 512 + (wid >> 2) * 32 + (lane & 3) * 8;
    const unsigned kdst = lds0 + PL_K + wid * 1024, vdst = lds0 + PL_V + wid * 1024, fdst = lds0 + PL_F;
#define DMA_K(t, slot) glds16(ksrc + (size_t)(t) * 64 * 512, (unsigned)__builtin_amdgcn_readfirstlane(kdst + (slot)))
#define DMA_V(t, slot) glds16(vsrc + (size_t)(t) * 64 * 512, (unsigned)__builtin_amdgcn_readfirstlane(vdst + (slot)))
#define DMA_F(t) do { if (KIND == 0) glds4(Fj + 64 * (t) + lane, (unsigned)__builtin_amdgcn_readfirstlane(fdst + ((t) & 3) * 256)); } while (0)
    const lds_cptr shm3 = (lds_cptr)lds; const lds_cptr kp0 = shm3 + PL_K + hi * 1024 + r32 * 16;
    const lds_cptr vp0 = shm3 + PL_V + ((lane >> 4) & 1) * 32 + (lane & 3) * 8 + (4 * hi + ((lane & 15) >> 2)) * 64;
    LAS const float* BT = (LAS const float*)(lds + PL_BT);
    float c191 = 0.f;
    if (KIND == 1) {
        const float* relh = X.rel + h * NREL;
#pragma unroll
        for (int k = 0; k < 12; ++k) { const int e = tid + 512 * k, di = e >> 10, ln = (e >> 4) & 63, r = e & 15;
            int idx = (32 * di - 32) + (ln & 31) - crow(r, ln >> 5) + 63; idx = min(max(idx, 0), NREL - 1);
            ((LAS float*)(lds + PL_BT))[e] = relh[idx] * L2E; }
        c191 = relh[NREL - 1] * L2E;
    }
    DMA_K(0, 0); DMA_F(0); DMA_V(0, 0); DMA_K(1, SLOTB); DMA_F(1);
    bf16x8 qr[4];
#pragma unroll
    for (int d0 = 0; d0 < 4; ++d0) qr[d0] = *(const bf16x8*)(Qw + (size_t)r32 * 512 + d0 * 16 + hi * 8);
    DMA_K(2, 2 * SLOTB); DMA_F(2);
    float mhat = 0.f, l_reg = 0.f; f32x16 o[2]; o[0] = f32x16{}; o[1] = f32x16{};
    const int qrel = wid * 32 + r32;
    bool resc = false;
    f32x16 pA0, pA1, pB0, pB1; bf16x8 kf[8];
    s16x4 vlo[8], vhi[8]; v4u pw0, pw1, pw2, pw3;
    int sl_prev = 0, sl_cur = 0, sl_next = SLOTB;
#define ROT() do { sl_prev = sl_cur; sl_cur = sl_next; sl_next = (sl_next == 2 * SLOTB) ? 0 : sl_next + SLOTB; } while (0)
#define CINIT(C0, C1, t) do { \
        if (KIND == 0) { LAS const float* fb_ = (LAS const float*)(lds + PL_F + ((t) & 3) * 256); const float base_ = Fq0L - mhat; \
            _Pragma("unroll") for (int g_ = 0; g_ < 4; ++g_) { const f32x4 f0_ = *(LAS const f32x4*)(fb_ + 8 * g_ + 4 * hi), f1_ = *(LAS const f32x4*)(fb_ + 32 + 8 * g_ + 4 * hi); \
                _Pragma("unroll") for (int e_ = 0; e_ < 4; ++e_) { C0[4 * g_ + e_] = __builtin_fmaf(f0_[e_], -L2E, base_); C1[4 * g_ + e_] = __builtin_fmaf(f1_[e_], -L2E, base_); } } \
        } else { const int dl0_ = 32 * (wid & 1) + 64 * (tb - (t)); \
            if (dl0_ >= 160) { const float cc_ = c191 - mhat; _Pragma("unroll") for (int r_ = 0; r_ < 16; ++r_) C0[r_] = cc_; } \
            else { LAS const float* bp_ = BT + (((dl0_ + 32) >> 5) * 64 + lane) * 16; \
                _Pragma("unroll") for (int g_ = 0; g_ < 4; ++g_) { const f32x4 f0_ = *(LAS const f32x4*)(bp_ + 4 * g_); _Pragma("unroll") for (int e_ = 0; e_ < 4; ++e_) C0[4 * g_ + e_] = f0_[e_] - mhat; } } \
            if (dl0_ - 32 >= 160) { const float cc_ = c191 - mhat; _Pragma("unroll") for (int r_ = 0; r_ < 16; ++r_) C1[r_] = cc_; } \
            else { LAS const float* bp_ = BT + (((dl0_) >> 5) * 64 + lane) * 16; \
                _Pragma("unroll") for (int g_ = 0; g_ < 4; ++g_) { const f32x4 f1_ = *(LAS const f32x4*)(bp_ + 4 * g_); _Pragma("unroll") for (int e_ = 0; e_ < 4; ++e_) C1[4 * g_ + e_] = f1_[e_] - mhat; } } \
        } } while (0)
#define CMASK(P0, P1, t) do { if (KIND == 0) { const int jb_ = (t) - (n - 4); if (jb_ >= 0) { const int kb_ = 64 * jb_ + 4 * hi; \
        _Pragma("unroll") for (int r_ = 0; r_ < 16; ++r_) { const int kv_ = kb_ + (r_ & 3) + 8 * (r_ >> 2); if (kv_ > qrel) P0[r_] = -INFINITY; if (kv_ + 32 > qrel) P1[r_] = -INFINITY; } } } } while (0)
#define MX3(a, b, c) __builtin_fmaxf(__builtin_fmaxf((a), (b)), (c))
#define ROWMAX(C0, C1, rm) do { float a_ = MX3(C0[0], C0[1], C1[0]), b_ = MX3(C0[2], C0[3], C1[1]); a_ = MX3(a_, C1[2], C1[3]); \
        _Pragma("unroll") for (int r_ = 4; r_ < 16; r_ += 4) { a_ = MX3(a_, C0[r_], C0[r_ + 1]); b_ = MX3(b_, C0[r_ + 2], C0[r_ + 3]); a_ = MX3(a_, C1[r_], C1[r_ + 1]); b_ = MX3(b_, C1[r_ + 2], C1[r_ + 3]); } \
        rm = __builtin_fmaxf(a_, b_); { auto rr_ = __builtin_amdgcn_permlane32_swap(__float_as_uint(rm), __float_as_uint(rm), false, false); rm = __builtin_fmaxf(__uint_as_float(rr_[0]), __uint_as_float(rr_[1])); } } while (0)
#define FIRST(C0, C1, t) do { CINIT(C0, C1, t); \
        C0 = MFMA32(kf[0], qr[0], C0); C1 = MFMA32(kf[1], qr[0], C1); C0 = MFMA32(kf[2], qr[1], C0); C1 = MFMA32(kf[3], qr[1], C1); \
        C0 = MFMA32(kf[4], qr[2], C0); C1 = MFMA32(kf[5], qr[2], C1); C0 = MFMA32(kf[6], qr[3], C0); C1 = MFMA32(kf[7], qr[3], C1); \
        CMASK(C0, C1, t); float rm_; ROWMAX(C0, C1, rm_); mhat += rm_; \
        _Pragma("unroll") for (int r_ = 0; r_ < 16; ++r_) { C0[r_] = fexp2(C0[r_] - rm_); C1[r_] = fexp2(C1[r_] - rm_); } } while (0)
#define PKW(P, B) cvtpk(P[B], P[B + 1])
#define PAF(k) __builtin_bit_cast(bf16x8, pw##k)
#define VFR(i) (bf16x8){vlo[i][0], vlo[i][1], vlo[i][2], vlo[i][3], vhi[i][0], vhi[i][1], vhi[i][2], vhi[i][3]}
#define GAPA(MF, A0, A1, A2, A3, W0, W1, PW) do { MF; sacc += A0; sacc += A1; sacc += A2; sacc += A3; PIN(sacc); W0; W1; PIN(PW); SBAR(); } while (0)
#define GAPB(MF, Xv, B) do { MF; Xv[B] = fexp2(Xv[B]); Xv[B + 1] = fexp2(Xv[B + 1]); Xv[B + 2] = fexp2(Xv[B + 2]); Xv[B + 3] = fexp2(Xv[B + 3]); PIN(Xv); SBAR(); } while (0)
#define VRD(i) do { vlo[i] = vtr2(vp_ + (((i) >> 2) * 4096 + ((i) & 3) * 1024)); vhi[i] = vtr2(vp_ + (((i) >> 2) * 4096 + ((i) & 3) * 1024 + 512)); } while (0)
#define KRD(G, j) do { if (G) { kload2(kf, kp0 + sl_next, j); SBAR(); } } while (0)
#define DMA_SLOT(t) do { if ((t) + 3 < n) { DMA_K((t) + 3, sl_cur); DMA_F((t) + 3); } if ((t) + 1 < n) { DMA_V((t) + 1, sl_next); } } while (0)
#define STEP(C0, C1, P0, P1, t, GL) do { CINIT(C0, C1, t); SBAR(); \
        const lds_cptr vp_ = vp0 + sl_prev; \
        VRD(0); SBAR(); float sacc = (P0[0] + P0[1]); \
        GAPA(C0 = MFMA32(kf[0], qr[0], C0), P0[2], P0[3], P0[4], P0[5],     pw0[0] = PKW(P0, 0), pw0[1] = PKW(P0, 2), pw0); \
        VRD(4); SBAR(); GAPA(C1 = MFMA32(kf[1], qr[0], C1), P0[6], P0[7], P0[8], P0[9],     pw0[2] = PKW(P0, 4), pw0[3] = PKW(P0, 6), pw0); \
        VRD(1); SBAR(); GAPA(C0 = MFMA32(kf[2], qr[1], C0), P0[10], P0[11], P0[12], P0[13], pw1[0] = PKW(P0, 8), pw1[1] = PKW(P0, 10), pw1); \
        VRD(5); SBAR(); GAPA(C1 = MFMA32(kf[3], qr[1], C1), P0[14], P0[15], P1[0], P1[1],   pw1[2] = PKW(P0, 12), pw1[3] = PKW(P0, 14), pw1); \
        VRD(2); SBAR(); GAPA(C0 = MFMA32(kf[4], qr[2], C0), P1[2], P1[3], P1[4], P1[5],     pw2[0] = PKW(P1, 0), pw2[1] = PKW(P1, 2), pw2); \
        VRD(6); SBAR(); GAPA(C1 = MFMA32(kf[5], qr[2], C1), P1[6], P1[7], P1[8], P1[9],     pw2[2] = PKW(P1, 4), pw2[3] = PKW(P1, 6), pw2); \
        VRD(3); SBAR(); GAPA(C0 = MFMA32(kf[6], qr[3], C0), P1[10], P1[11], P1[12], P1[13], pw3[0] = PKW(P1, 8), pw3[1] = PKW(P1, 10), pw3); \
        VRD(7); SBAR(); GAPA(C1 = MFMA32(kf[7], qr[3], C1), P1[14], P1[15], 0.f, 0.f,       pw3[2] = PKW(P1, 12), pw3[3] = PKW(P1, 14), pw3); \
        l_reg += sacc; \
        DMA_SLOT(t); \
        CMASK(C0, C1, t); \
        { float rm; ROWMAX(C0, C1, rm); resc = false; \
          if (__builtin_expect(__any(rm > (float)THRL), 0)) { const float dl = __builtin_fmaxf(rm, 0.f); mhat += dl; \
            _Pragma("unroll") for (int r_ = 0; r_ < 16; ++r_) { C0[r_] -= dl; C1[r_] -= dl; } \
            const float f = fexp2(-dl); l_reg *= f; if (hi == 0) wsf[r32] = f; resc = true; } } \
        SBAR(); \
        GAPB(o[0] = MFMA32(PAF(0), VFR(0), o[0]), C0, 0); \
        GAPB(o[1] = MFMA32(PAF(0), VFR(4), o[1]), C0, 4); \
        KRD(GL, 0); GAPB(o[0] = MFMA32(PAF(1), VFR(1), o[0]), C0, 8); \
        KRD(GL, 1); GAPB(o[1] = MFMA32(PAF(1), VFR(5), o[1]), C0, 12); \
        KRD(GL, 2); GAPB(o[0] = MFMA32(PAF(2), VFR(2), o[0]), C1, 0); \
        KRD(GL, 3); GAPB(o[1] = MFMA32(PAF(2), VFR(6), o[1]), C1, 4); \
        GAPB(o[0] = MFMA32(PAF(3), VFR(3), o[0]), C1, 8); \
        GAPB(o[1] = MFMA32(PAF(3), VFR(7), o[1]), C1, 12); \
    } while (0)
#define DRAIN(P0, P1) do { float sacc = P0[0] + P0[1]; _Pragma("unroll") for (int r_ = 2; r_ < 16; ++r_) sacc += P0[r_]; _Pragma("unroll") for (int r_ = 0; r_ < 16; ++r_) sacc += P1[r_]; l_reg += sacc; \
        pw0 = (v4u){PKW(P0, 0), PKW(P0, 2), PKW(P0, 4), PKW(P0, 6)}; pw1 = (v4u){PKW(P0, 8), PKW(P0, 10), PKW(P0, 12), PKW(P0, 14)}; \
        pw2 = (v4u){PKW(P1, 0), PKW(P1, 2), PKW(P1, 4), PKW(P1, 6)}; pw3 = (v4u){PKW(P1, 8), PKW(P1, 10), PKW(P1, 12), PKW(P1, 14)}; \
        const lds_cptr vp_ = vp0 + sl_prev; \
        _Pragma("unroll") for (int i_ = 0; i_ < 8; ++i_) { vlo[i_] = vtr2(vp_ + ((i_ >> 2) * 4096 + (i_ & 3) * 1024)); vhi[i_] = vtr2(vp_ + ((i_ >> 2) * 4096 + (i_ & 3) * 1024 + 512)); } \
        o[0] = MFMA32(PAF(0), VFR(0), o[0]); o[1] = MFMA32(PAF(0), VFR(4), o[1]); o[0] = MFMA32(PAF(1), VFR(1), o[0]); o[1] = MFMA32(PAF(1), VFR(5), o[1]); \
        o[0] = MFMA32(PAF(2), VFR(2), o[0]); o[1] = MFMA32(PAF(2), VFR(6), o[1]); o[0] = MFMA32(PAF(3), VFR(3), o[0]); o[1] = MFMA32(PAF(3), VFR(7), o[1]); } while (0)
#define RESC() do { if (resc) { _Pragma("unroll") for (int g_ = 0; g_ < 4; ++g_) { const f32x4 a4_ = *(LAS const f32x4*)(wsf + 8 * g_ + 4 * hi); \
        _Pragma("unroll") for (int e_ = 0; e_ < 4; ++e_) { o[0][4 * g_ + e_] *= a4_[e_]; o[1][4 * g_ + e_] *= a4_[e_]; } } resc = false; } } while (0)
#define CLOSE(t) do { if ((t) + 3 < n) { if (KIND == 0) WAITB(3); else WAITB(2); } else if ((t) + 1 < n) { WAITB(1); } else { WAITB(0); } } while (0)
#define IDLE(t) do { DMA_SLOT(t); if ((t) + 1 >= ta && (t) + 1 <= tb) kload8(kf, kp0 + sl_next); CLOSE(t); ROT(); } while (0)

    if (KIND == 0) WAITB(4); else WAITB(2);
    if (ta == 0) { kload8(kf, kp0); FIRST(pA0, pA1, 0); }
    WAITB(0);
    DMA_K(3, 0); DMA_F(3); DMA_V(1, SLOTB);
    ROT();
    if (1 >= ta && 1 <= tb) kload8(kf, kp0 + sl_cur);
    if (KIND == 0) WAITB(3); else WAITB(2);
    int t = 1;
    if (ta > 0) {
        for (; t < ta; ++t) IDLE(t);
        DMA_SLOT(t); FIRST(pA0, pA1, t); if (t + 1 <= tb) kload8(kf, kp0 + sl_next); CLOSE(t); ROT(); ++t;
    }
    for (; t + 1 <= tb; t += 2) {
        STEP(pB0, pB1, pA0, pA1, t, true); CLOSE(t); RESC(); ROT();
        const bool gl2 = (t + 2 <= tb);
        STEP(pA0, pA1, pB0, pB1, t + 1, gl2); CLOSE(t + 1); RESC(); ROT();
    }
    if (t <= tb) { STEP(pB0, pB1, pA0, pA1, t, false); CLOSE(t); RESC(); ROT(); ++t;
        DMA_SLOT(t); DRAIN(pB0, pB1); CLOSE(t); ROT(); ++t; }
    else { DMA_SLOT(t); DRAIN(pA0, pA1); CLOSE(t); ROT(); ++t; }
    for (; t <= n; ++t) IDLE(t);
    { const float lt = halfsum(l_reg);
      if (hi == 0) wsf[32 + r32] = lt;
      float rli[16];
#pragma unroll
      for (int g = 0; g < 4; ++g) { const f32x4 a4 = *(LAS const f32x4*)(wsf + 32 + 8 * g + 4 * hi);
#pragma unroll
          for (int e = 0; e < 4; ++e) rli[4 * g + e] = __builtin_amdgcn_rcpf(a4[e]); }
      LAS bf16* stg = (LAS bf16*)(lds + PL_OST + wid * 4096);
#pragma unroll
      for (int r = 0; r < 16; ++r) { const int orow = crow(r, hi);
#pragma unroll
          for (int d0 = 0; d0 < 2; ++d0) stg[orow * 64 + d0 * 32 + r32] = (bf16)(cvtpk(o[d0][r] * rli[r], 0.f) & 0xffffu); }
      const size_t grow0 = rowbase + q0 + wid * 32;
#pragma unroll
      for (int i = 0; i < 4; ++i) { const int row = i * 8 + (lane >> 3), ch = lane & 7;
          const v4u v = *(LAS const v4u*)(stg + row * 64 + ch * 8);
          const v4u z = *(const v4u*)(SZ + (grow0 + row) * 512 + h * 64 + ch * 8);
          *(v4u*)(X.G + (grow0 + row) * 1024 + (KIND ? 0 : 512) + h * 64 + ch * 8) = mul8(v, z); } }
    asm volatile("s_waitcnt vmcnt(0) lgkmcnt(0)\n\ts_barrier" ::: "memory");
#undef DMA_K
#undef DMA_V
#undef DMA_F
#undef ROT
#undef CINIT
#undef CMASK
#undef MX3
#undef ROWMAX
#undef FIRST
#undef PKW
#undef PAF
#undef VFR
#undef GAPA
#undef GAPB
#undef VRD
#undef KRD
#undef DMA_SLOT
#undef STEP
#undef DRAIN
#undef RESC
#undef CLOSE
#undef IDLE
}

template <int KIND>
__device__ __forceinline__ void sample_unit(const Ctx& X, int bs, int h) {
    const int tid = fresh_tid(), lane = tid & 63, r32 = lane & 31, hi = lane >> 5; const int wid = __builtin_amdgcn_readfirstlane(tid >> 6);
    LAS unsigned char* lds = X.lds;
    const int ncache = KIND ? AKEEP : PAST, nct = ncache / 64, ntile = nct + 1;
    const float* Kc = (KIND ? X.cak : X.cbk) + ((size_t)bs * ncache * 8 + h) * 64;
    const float* Vc = (KIND ? X.cav : X.cbv) + ((size_t)bs * ncache * 8 + h) * 64;
    const bf16* Q = KIND ? X.QA : X.QB; const bf16* Kn = KIND ? X.KA : X.KB; const bf16* Vn = KIND ? X.VA : X.VB; const bf16* SZ = KIND ? X.SZA : X.SZB;
    const size_t nrow0 = (size_t)MP + 16 * bs;
    LAS float* wsf = (LAS float*)(lds + WSF_OFF) + wid * 64;
    LAS float* tb = (LAS float*)(lds + TB_OFF);
    if (KIND == 1) { if (tid < NREL) tb[tid] = X.rel[h * NREL + tid] * L2E; }
    __syncthreads();
    bf16x8 qr[4];
#pragma unroll
    for (int d0 = 0; d0 < 4; ++d0) qr[d0] = *(const bf16x8*)(Q + (nrow0 + (r32 & 15)) * 512 + h * 64 + d0 * 16 + hi * 8);
    const float* Fsr = X.Fs + (size_t)(bs * 8 + h) * FS_PITCH;
    const float Fref = (KIND == 0) ? Fsr[PAST - 1] : 0.f;
    LAS unsigned char* kslot = lds + wid * 16384; LAS unsigned char* vslot = kslot + 8192;
    float m_run = -1e30f, l_run = 0.f; f32x16 o[2]; o[0] = f32x16{}; o[1] = f32x16{};
    const int tq = r32 & 15;
    for (int t = wid; t < ntile; t += 8) {
        if (t < nct) {
            const float* kr = Kc + (size_t)(t * 64 + (lane >> 4)) * 512 + (lane & 15) * 4; const float* vr = Vc + (size_t)(t * 64 + (lane >> 4)) * 512 + (lane & 15) * 4;
            f32x4 kq[16], vq[16];
#pragma unroll
            for (int i = 0; i < 16; ++i) kq[i] = *(const f32x4*)(kr + (size_t)i * 4 * 512);
#pragma unroll
            for (int i = 0; i < 16; ++i) vq[i] = *(const f32x4*)(vr + (size_t)i * 4 * 512);
            LAS unsigned char* kw = kslot + ((lane & 15) >> 1) * 1024 + (lane >> 4) * 16 + (lane & 1) * 8;
            LAS unsigned char* vw = vslot + ((lane & 15) >> 3) * 4096 + (lane >> 4) * 64 + (lane & 7) * 8;
#pragma unroll
            for (int i = 0; i < 16; ++i) { v2u w; w.x = cvtpk(kq[i][0], kq[i][1]); w.y = cvtpk(kq[i][2], kq[i][3]); *(LAS v2u*)(kw + i * 64) = w; }
#pragma unroll
            for (int i = 0; i < 16; ++i) { v2u w; w.x = cvtpk(vq[i][0], vq[i][1]); w.y = cvtpk(vq[i][2], vq[i][3]); *(LAS v2u*)(vw + i * 256) = w; }
        } else {
#pragma unroll
            for (int c = 0; c < 8; ++c) { v4u wk = (v4u){0u, 0u, 0u, 0u}, wv = wk;
                if (lane < 16) { wk = *(const v4u*)(Kn + (nrow0 + lane) * 512 + h * 64 + c * 8); wv = *(const v4u*)(Vn + (nrow0 + lane) * 512 + h * 64 + c * 8); }
                *(LAS v4u*)(kslot + c * 1024 + lane * 16) = wk;
                *(LAS v4u*)(vslot + (c >> 2) * 4096 + lane * 64 + (c & 3) * 16) = wv; }
        }
        f32x16 c0, c1, p0, p1;
        if (KIND == 0) {
            const float* fb = Fsr + t * 64;
#pragma unroll
            for (int g = 0; g < 4; ++g) { const f32x4 f0 = *(const f32x4*)(fb + 8 * g + 4 * hi), f1 = *(const f32x4*)(fb + 32 + 8 * g + 4 * hi);
#pragma unroll
                for (int e = 0; e < 4; ++e) { c0[4 * g + e] = (Fref - f0[e]) * L2E; c1[4 * g + e] = (Fref - f1[e]) * L2E; } }
        } else { c0 = f32x16{}; c1 = f32x16{}; }
        qkt(p0, p1, (ldsc)kslot, qr, c0, c1, r32, hi);
        if (KIND == 1) {
            const int dist0 = ncache + tq - (64 * t + 4 * hi) + 63;
#pragma unroll
            for (int r = 0; r < 16; ++r) { const int i0 = dist0 - ((r & 3) + 8 * (r >> 2));
                const int a0 = min(max(i0, 0), NREL - 1), a1 = min(max(i0 - 32, 0), NREL - 1);
                p0[r] += tb[a0]; p1[r] += tb[a1]; }
        }
        if (t == nct) {
#pragma unroll
            for (int r = 0; r < 16; ++r) { const int kv = 4 * hi + (r & 3) + 8 * (r >> 2);
                const bool ok = (kv < 16) && (KIND == 1 || kv <= tq);
                if (!ok) p0[r] = -1e30f; p1[r] = -1e30f; }
        }
        softmax_pv(p0, p1, o, m_run, l_run, wsf, (ldsc)vslot, lane, r32, hi);
    }
    const float lt = halfsum(l_run);
    __syncthreads();
    LAS float* OP = (LAS float*)lds;
    LAS float* ML = (LAS float*)(lds + 32768);
    if (lane < 16) { ML[(wid * 16 + lane) * 2] = m_run; ML[(wid * 16 + lane) * 2 + 1] = lt; }
#pragma unroll
    for (int r = 0; r < 8; ++r) { const int q = crow(r, hi);
#pragma unroll
        for (int d0 = 0; d0 < 2; ++d0) OP[(wid * 16 + q) * 64 + d0 * 32 + r32] = o[d0][r]; }
    __syncthreads();
    { const int q = tid >> 5, d = (tid & 31) * 2;
      float M = -1e30f;
#pragma unroll
      for (int w = 0; w < 8; ++w) M = fmaxf(M, ML[(w * 16 + q) * 2]);
      float L = 0.f, a0 = 0.f, a1 = 0.f;
#pragma unroll
      for (int w = 0; w < 8; ++w) { const float f = fexp2(ML[(w * 16 + q) * 2] - M); L += ML[(w * 16 + q) * 2 + 1] * f;
          const f32x2 ov = *(LAS const f32x2*)(OP + (w * 16 + q) * 64 + d); a0 += ov[0] * f; a1 += ov[1] * f; }
      const float rl = 1.0f / L;
      const unsigned z = *(const unsigned*)(SZ + (nrow0 + q) * 512 + h * 64 + d);
      *(unsigned*)(X.G + (nrow0 + q) * 1024 + (KIND ? 0 : 512) + h * 64 + d) = cvtpk(a0 * rl * bflo(z), a1 * rl * bfhi(z)); }
    __syncthreads();
}
}


__device__ __forceinline__ f32x16 mini_tile(const bf16* Xrow0, const bf16* Wrow0, int k0, int ksteps, f32x16 acc, int r32, int hi) {
    const bf16* ap = Wrow0 + (size_t)r32 * DM + k0 + hi * 8;
    const bf16* bp = Xrow0 + (size_t)r32 * DM + k0 + hi * 8;
#pragma unroll 8
    for (int s = 0; s < ksteps; ++s) { const bf16x8 a = *(const bf16x8*)(ap + 16 * s); const bf16x8 b = *(const bf16x8*)(bp + 16 * s);
        acc = __builtin_amdgcn_mfma_f32_32x32x16_bf16(a, b, acc, 0, 0, 0); }
    return acc;
}
__device__ __forceinline__ void mini_slice_to_lds(const bf16* Xrow0, const bf16* Wrow0, LAS float* part, int slot, int wave, int lane) {
    const int r32 = lane & 31, hi = lane >> 5;
    const bf16* ap = Wrow0 + (size_t)r32 * DM + wave * 128 + hi * 8;
    const bf16* bp = Xrow0 + (size_t)r32 * DM + wave * 128 + hi * 8;
    bf16x8 a[8], b[8];
#pragma unroll
    for (int s = 0; s < 8; ++s) { a[s] = *(const bf16x8*)(ap + 16 * s); b[s] = *(const bf16x8*)(bp + 16 * s); }
    f32x16 acc = f32x16{};
#pragma unroll
    for (int s = 0; s < 8; ++s) acc = __builtin_amdgcn_mfma_f32_32x32x16_bf16(a[s], b[s], acc, 0, 0, 0);
    LAS f32x4* p = (LAS f32x4*)(part + (size_t)slot * 1024 + lane * 16);
#pragma unroll
    for (int g = 0; g < 4; ++g) p[g] = (f32x4){acc[4 * g], acc[4 * g + 1], acc[4 * g + 2], acc[4 * g + 3]};
}
__device__ __forceinline__ f32x16 mini_reduce(LAS const float* part, int NT, int i, int w0, int w1, int lane) {
    f32x16 acc = f32x16{};
    for (int w = w0; w < w1; ++w) { LAS const f32x4* p = (LAS const f32x4*)(part + (size_t)(w * NT + i) * 1024 + lane * 16);
#pragma unroll
        for (int g = 0; g < 4; ++g) { const f32x4 v = p[g]; acc[4 * g] += v[0]; acc[4 * g + 1] += v[1]; acc[4 * g + 2] += v[2]; acc[4 * g + 3] += v[3]; } }
    return acc;
}
struct SampleInProj { bf16 *QA, *KA, *VA, *SZA, *QB, *KB, *VB, *SZB, *SMA, *SMB; float* out; };
__device__ __forceinline__ void sample_inproj_store(const SampleInProj& E, const f32x16& acc, int m0, int n0, int r32, int hi) {
    const int pn = n0 >> 8; bf16* dst; int ldd, cbase, actk; float* f32p = nullptr; int fmode = 0;
    if (pn < 16) { const int seg = pn >> 1; ldd = 512; cbase = seg * 512;
        if (seg == 0) { dst = E.QA; actk = 1; } else if (seg == 1) { dst = E.KA; actk = 0; } else if (seg == 2) { dst = E.VA; actk = 0; } else if (seg == 3) { dst = E.SZA; actk = 2; }
        else if (seg == 4) { dst = E.QB; actk = 1; } else if (seg == 5) { dst = E.KB; actk = 0; } else if (seg == 6) { dst = E.VB; actk = 0; } else { dst = E.SZB; actk = 2; }
        if (seg == 1 || seg == 2) { f32p = E.out + (seg == 1 ? O_AKS : O_AVS); fmode = 2; }
        else if (seg == 5 || seg == 6) { f32p = E.out + (seg == 5 ? O_BKS : O_BVS); fmode = 1; }
    } else { ldd = 1024; actk = 3; if (pn < 20) { dst = E.SMA; cbase = 4096; } else { dst = E.SMB; cbase = 5120; } }
    const int rl = m0 + r32; const size_t grow = (size_t)MP + rl;
    const size_t ro = (fmode == 1) ? (size_t)rl * 512 : ((size_t)((rl >> 4) * 512 + 496 + (rl & 15))) * 512;
#pragma unroll
    for (int g = 0; g < 4; ++g) { const int col = n0 + 8 * g + 4 * hi - cbase;
        f32x4 v = {acc[4 * g], acc[4 * g + 1], acc[4 * g + 2], acc[4 * g + 3]};
        if (f32p != nullptr) *(f32x4*)(f32p + ro + col) = v;
        if (actk == 1) v = v * C2;
        else if (actk == 2) {
#pragma unroll
            for (int e = 0; e < 4; ++e) v[e] = v[e] * sigmoidf_(v[e]); }
        else if (actk == 3) {
#pragma unroll
            for (int e = 0; e < 4; ++e) v[e] = sigmoidf_(v[e]); }
        v2u w; w.x = cvtpk(v[0], v[1]); w.y = cvtpk(v[2], v[3]);
        *(v2u*)(dst + grow * ldd + col) = w; }
}

#ifndef REP_FP
#define REP_FP 1
#endif
#ifndef REP_BP
#define REP_BP 1
#endif
#ifndef REP_S
#define REP_S 1
#endif
#ifndef REP_P0
#define REP_P0 1
#endif
#ifndef REP_P1
#define REP_P1 1
#endif
#ifndef REP_P2
#define REP_P2 1
#endif
#ifndef REP_P3A
#define REP_P3A 1
#endif
#ifndef REP_P3B
#define REP_P3B 1
#endif
#ifndef REP_P4
#define REP_P4 1
#endif
__global__ void __launch_bounds__(512, 2) fwd_kernel(Args args) {
    extern __shared__ __attribute__((aligned(16))) unsigned char lds_raw[];
    LAS unsigned char* lds = (LAS unsigned char*)lds_raw;
    const int G = gridDim.x; const int bx = blockIdx.x; const int vcu = (G % 8 == 0) ? (bx % 8) * (G / 8) + bx / 8 : bx;
    unsigned char* ws = args.ws; float* out = args.out;
    gu32* ctl = (gu32*)(ws + WS_CTL);
    const float* x_p = args.in[0]; const float* x_s = args.in[1];
    const float *cak = args.in[2], *cav = args.in[3], *cbk = args.in[4], *cbv = args.in[5], *cbl = args.in[6];
    const float *g_pre = args.in[7], *w_in = args.in[8], *b_f = args.in[9], *rel = args.in[10], *w_bra = args.in[11], *w_brb = args.in[12], *w_out = args.in[13], *g_post = args.in[14];
    float* Fp = (float*)(ws + WS_FP); float* LFp = (float*)(ws + WS_LFP); float* Fs = (float*)(ws + WS_FS); float* LFn = (float*)(ws + WS_LFN);
    bf16* WIN = (bf16*)(ws + WS_WIN); bf16* WBR = (bf16*)(ws + WS_WBR); bf16* WOUT = (bf16*)(ws + WS_WOUT);
    bf16* XN = (bf16*)(ws + WS_XN);
    bf16 *QA = (bf16*)(ws + WS_QA), *KA = (bf16*)(ws + WS_KA), *VA = (bf16*)(ws + WS_VA), *QB = (bf16*)(ws + WS_QB), *KB = (bf16*)(ws + WS_KB), *VB = (bf16*)(ws + WS_VB);
    bf16 *SZA = (bf16*)(ws + WS_SZA), *SZB = (bf16*)(ws + WS_SZB), *SMA = (bf16*)(ws + WS_SMA), *SMB = (bf16*)(ws + WS_SMB);
    bf16* MG = (bf16*)(ws + WS_MG); float* OUTF = (float*)(ws + WS_OUTF);

    for (int u = threadIdx.x; u < (LDS_BYTES - LDSCTL_OFF) / 4; u += 512) ((LAS unsigned*)(lds + LDSCTL_OFF))[u] = 0u;
    __syncthreads();
    volatile LAS unsigned* MISC = (volatile LAS unsigned*)(lds + MISC_OFF);
    XcdBarrier bar = xcd_barrier_post((unsigned*)(ctl + CW_BAR), MISC + 8);
    const int NGW = G * 8;

#pragma nounroll
    for (int rep = 0; rep < REP_P0; ++rep) {
        const int tid = fresh_tid(), lane = tid & 63; const int wave = __builtin_amdgcn_readfirstlane(tid >> 6); const int gw = vcu * 8 + wave;
        LAS float* wfT = (LAS float*)(lds + 73728);
        for (int k = tid; k < DM; k += 512) { const f32x4 a = *(const f32x4*)(w_in + (size_t)k * NIN + 4096), b = *(const f32x4*)(w_in + (size_t)k * NIN + 4100);
            wfT[0 * DM + k] = a[0]; wfT[1 * DM + k] = a[1]; wfT[2 * DM + k] = a[2]; wfT[3 * DM + k] = a[3];
            wfT[4 * DM + k] = b[0]; wfT[5 * DM + k] = b[1]; wfT[6 * DM + k] = b[2]; wfT[7 * DM + k] = b[3]; }
        __syncthreads();
        LAS float* scr = (LAS float*)(lds + wave * 8704);
        constexpr int I_IN = 16 * 192, I_BR = 8 * 32, I_OUT = 16 * 32, NITEMS = I_IN + 2 * I_BR + I_OUT;
        for (int it = gw; it < NITEMS; it += NGW) {
            int r = it;
            if (r < I_IN) { const int kb = r / 192, nb = r % 192, n0 = 32 * nb; p0_transpose_item(w_in, NIN, n0 + (n0 >= 4096 ? 8 : 0), WIN, DM, 0, n0, scr, 64 * kb, lane); continue; } r -= I_IN;
            if (r < I_BR) { const int kb = r / 32, nb = r % 32; p0_transpose_item(w_bra, DM, 32 * nb, WBR, DM, 0, 32 * nb, scr, 64 * kb, lane); continue; } r -= I_BR;
            if (r < I_BR) { const int kb = r / 32, nb = r % 32; p0_transpose_item(w_brb, DM, 32 * nb, WBR, DM, 512, 32 * nb, scr, 64 * kb, lane); continue; } r -= I_BR;
            { const int kb = r / 32, nb = r % 32; p0_transpose_item(w_out, DM, 32 * nb, WOUT, DM, 0, 32 * nb, scr, 64 * kb, lane); }
        }
        f32x4 gv[4];
#pragma unroll
        for (int j = 0; j < 4; ++j) gv[j] = *((const f32x4*)g_pre + lane + 64 * j);
        for (int m = gw; m < MTOT; m += NGW) {
            GAS unsigned long long* o8 = (GAS unsigned long long*)(XN + (size_t)m * DM) + lane;
            if (m >= MP + MS) {
#pragma unroll
                for (int j = 0; j < 4; ++j) o8[64 * j] = 0ull;
                continue; }
            const float* xrow = (m < MP) ? x_p + (size_t)m * DM : x_s + (size_t)(m - MP) * DM;
            f32x4 v[4]; float ss = 0.f;
#pragma unroll
            for (int j = 0; j < 4; ++j) { v[j] = *((const f32x4*)xrow + lane + 64 * j); ss += (v[j][0] * v[j][0] + v[j][1] * v[j][1]) + (v[j][2] * v[j][2] + v[j][3] * v[j][3]); }
            float dt[8];
#pragma unroll
            for (int hh = 0; hh < 8; ++hh) dt[hh] = 0.f;
#pragma unroll
            for (int j = 0; j < 4; ++j) { v[j] = v[j] * gv[j];
#pragma unroll
                for (int hh = 0; hh < 8; ++hh) { const f32x4 w = *(LAS const f32x4*)(wfT + hh * DM + 256 * j + 4 * lane);
                    dt[hh] += (v[j][0] * w[0] + v[j][1] * w[1]) + (v[j][2] * w[2] + v[j][3] * w[3]); } }
            ss = wave_sum(ss);
            const float rs = 1.0f / sqrtf(ss * (1.0f / DM) + EPS);
            {
                const bool u5 = (lane & 32) != 0, u4 = (lane & 16) != 0, u3 = (lane & 8) != 0;
#pragma unroll
                for (int i = 0; i < 4; ++i) { const float snd = u5 ? dt[i] : dt[i + 4], kp = u5 ? dt[i + 4] : dt[i]; dt[i] = kp + __shfl_xor(snd, 32); }
#pragma unroll
                for (int i = 0; i < 2; ++i) { const float snd = u4 ? dt[i] : dt[i + 2], kp = u4 ? dt[i + 2] : dt[i]; dt[i] = kp + __shfl_xor(snd, 16); }
                { const float snd = u3 ? dt[0] : dt[1], kp = u3 ? dt[1] : dt[0]; dt[0] = kp + __shfl_xor(snd, 8); }
                dt[0] += __shfl_xor(dt[0], 1); dt[0] += __shfl_xor(dt[0], 2); dt[0] += __shfl_xor(dt[0], 4);
            }
            if ((lane & 7) == 0) {
                const int hh = lane >> 3;
                const float val = dt[0] * rs + b_f[hh];
                const float lf = (val >= 0.f) ? -log1pf(expf(-val)) : (val - log1pf(expf(val)));
                if (m < MP) { out[O_BLP + (size_t)m * 8 + hh] = lf; LFp[(size_t)((m >> 14) * 8 + hh) * SEQ + (m & (SEQ - 1))] = lf; }
                else { const int ms = m - MP; out[O_BLS + (size_t)ms * 8 + hh] = lf; LFn[((ms >> 4) * 8 + hh) * 16 + (ms & 15)] = lf; }
            }
#pragma unroll
            for (int j = 0; j < 4; ++j) o8[64 * j] = (unsigned long long)cvtpk(v[j][0] * rs, v[j][1] * rs) | ((unsigned long long)cvtpk(v[j][2] * rs, v[j][3] * rs) << 32);
        }
        { const int gt = vcu * 512 + tid, NT = G * 512; constexpr int PER = 496 * 128;
          for (int i = gt; i < 2 * 8 * PER; i += NT) { const int ten = i / (8 * PER), r = i - ten * 8 * PER, bb = r / PER, off = r - bb * PER;
              const f32x4* src = (const f32x4*)(ten ? cav : cak) + (size_t)bb * 65536 + 2048 + off;
              f32x4* dst = (f32x4*)(out + (ten ? O_AVS : O_AKS)) + (size_t)bb * 65536 + off; *dst = *src; } }
    }
    xcd_barrier(bar);

    if (vcu < 24) {
        const int tid = fresh_tid(), lane = tid & 63; const int wave = __builtin_amdgcn_readfirstlane(tid >> 6);
        LAS float* wtot = (LAS float*)(lds + QMX_OFF);
        if (vcu < 16) {
            const float* in = LFp + (size_t)vcu * SEQ + wave * 2048 + lane * 32; float* o = Fp + (size_t)vcu * SEQ + wave * 2048 + lane * 32;
            f32x4 v[8];
#pragma unroll
            for (int i = 0; i < 8; ++i) v[i] = *((const f32x4*)in + i);
            float run = 0.f;
#pragma unroll
            for (int i = 0; i < 8; ++i) { v[i][0] += run; v[i][1] += v[i][0]; v[i][2] += v[i][1]; v[i][3] += v[i][2]; run = v[i][3]; }
            float inc = run;
#pragma unroll
            for (int ofs = 1; ofs < 64; ofs <<= 1) { const float t = __shfl_up(inc, ofs); if (lane >= ofs) inc += t; }
            if (lane == 63) wtot[wave] = inc;
            __syncthreads();
            float carry = inc - run;
#pragma unroll
            for (int w = 0; w < 8; ++w) if (w < wave) carry += wtot[w];
#pragma unroll
            for (int i = 0; i < 8; ++i) { v[i] = v[i] + carry; *((f32x4*)o + i) = v[i]; }
        } else {
            const int sidx = (vcu - 16) * 8 + wave, bs = vcu - 16, hh = wave;
            const float* in = cbl + ((size_t)bs * PAST + 64 * lane) * 8 + hh; float* o = Fs + (size_t)sidx * FS_PITCH + 64 * lane;
            float v[64];
#pragma unroll
            for (int i = 0; i < 64; ++i) v[i] = in[i * 8];
            float run = 0.f;
#pragma unroll
            for (int i = 0; i < 64; ++i) { run += v[i]; v[i] = run; }
            float inc = run;
#pragma unroll
            for (int ofs = 1; ofs < 64; ofs <<= 1) { const float t = __shfl_up(inc, ofs); if (lane >= ofs) inc += t; }
            const float carry = inc - run;
#pragma unroll
            for (int i = 0; i < 16; ++i) { f32x4 q4 = {v[4 * i] + carry, v[4 * i + 1] + carry, v[4 * i + 2] + carry, v[4 * i + 3] + carry}; *((f32x4*)o + i) = q4; }
            const float last = __shfl(inc, 63);
            if (lane == 0) { float r2 = last; float* on = Fs + (size_t)sidx * FS_PITCH + PAST;
                for (int i = 0; i < 16; ++i) { r2 += LFn[sidx * 16 + i]; on[i] = r2; }
                for (int i = 16; i < 64; ++i) on[i] = r2; }
            __syncthreads();
        }
    }
#pragma nounroll
    for (int rep = 0; rep < REP_P1; ++rep) {
        if (rep) xcd_barrier(bar);
        if (rep == 0) {
            const int tid = fresh_tid(), lane = tid & 63; const int wave = __builtin_amdgcn_readfirstlane(tid >> 6);
            LAS float* part = (LAS float*)lds;
#pragma unroll
            for (int i = 0; i < 3; ++i) { const int task = vcu * 3 + i; if (task < 768) { const int mb = task & 3, nb = task >> 2;
                mini_slice_to_lds(XN + (size_t)(MP + 32 * mb) * DM, WIN + (size_t)(32 * nb) * DM, part, wave * 3 + i, wave, lane); } }
            __syncthreads();
            if (wave < 3) { const int task = vcu * 3 + wave; if (task < 768) { const int mb = task & 3, nb = task >> 2;
                const f32x16 acc = mini_reduce(part, 3, wave, 0, 8, lane);
                SampleInProj SE{QA, KA, VA, SZA, QB, KB, VB, SZB, SMA, SMB, out};
                sample_inproj_store(SE, acc, 32 * mb, 32 * nb, lane & 31, lane >> 5); } }
            __syncthreads();
        }
        pg8::Gemm g{XN, WIN, DM, DM / 64}; pg8::StaticOrder S; S.init(MP, NG, G, bx, 1);
        pg8::EpiInProj E{QA, KA, VA, SZA, QB, KB, VB, SZB, SMA, SMB, out, (unsigned*)(ctl + CW_KNORM)};
        pg8::gemm_phase<pg8::EpiInProj, pg8::StaticOrder>(lds, g, S, E);
    }
    xcd_barrier(bar);

#pragma nounroll
    for (int rep = 0; rep < REP_P2; ++rep) {
        if (rep) xcd_barrier(bar);
        att::Ctx X; X.lds = lds; X.QA = QA; X.KA = KA; X.VA = VA; X.QB = QB; X.KB = KB; X.VB = VB; X.SZA = SZA; X.SZB = SZB; X.G = XN;
        X.Fp = Fp; X.Fs = Fs; X.rel = rel; X.cak = cak; X.cav = cav; X.cbk = cbk; X.cbv = cbv; X.knorm = (const unsigned*)(ctl + CW_KNORM);
        constexpr int NU = 64 + 1024 + 1024 + 64;
        gu32* qctr = ctl + CW_QUEUE + rep * 64;
        volatile LAS unsigned* qw = (volatile LAS unsigned*)(lds + MISC_OFF) + 16;
        if (threadIdx.x == 0) qw[0] = __hip_atomic_fetch_add(qctr, 1u, RLX_AGENT);
        __syncthreads();
        for (;;) {
            const int u = (int)__builtin_amdgcn_readfirstlane(qw[0]);
            if (u >= NU) break;
            unsigned nxt = 0u;
            if (threadIdx.x == 0) nxt = __hip_atomic_fetch_add(qctr, 1u, RLX_AGENT);

            if (u < 64) { for (int r2 = 0; r2 < REP_S; ++r2) att::sample_unit<0>(X, u >> 3, u & 7); }
            else if (u < 64 + 2048) { const int kind = (u - 64) >> 10, idx = (u - 64) & 1023;
                const int hh = ((idx & 7) + (idx >> 8)) & 7, bb = (idx >> 3) & 1, qb = 63 - (idx >> 4);
                if (kind == 0) { for (int r2 = 0; r2 < REP_FP; ++r2) att::prompt_unit<0, 8>(X, bb, hh, qb); } else { for (int r2 = 0; r2 < REP_BP; ++r2) att::prompt_unit<1, 8>(X, bb, hh, qb); } }
            else { const int i2 = u - 64 - 2048; for (int r2 = 0; r2 < REP_S; ++r2) att::sample_unit<1>(X, i2 >> 3, i2 & 7); }
            if (threadIdx.x == 0) qw[0] = nxt;
            __syncthreads();
        }
    }
    xcd_barrier(bar);

#pragma nounroll
    for (int rep = 0; rep < REP_P3A; ++rep) {
        if (rep) xcd_barrier(bar);
        if (rep == 0 && vcu < 128) {
            const int tid = fresh_tid(), lane = tid & 63, r32 = lane & 31, hi = lane >> 5; const int wave = __builtin_amdgcn_readfirstlane(tid >> 6);
            const int mb = vcu & 3, nb = vcu >> 2;
            LAS float* part = (LAS float*)lds;
            mini_slice_to_lds(XN + (size_t)(MP + 32 * mb) * DM, WBR + (size_t)(32 * nb) * DM, part, wave, wave, lane);
            __syncthreads();
            if (wave == 0) {
                const f32x16 a1 = mini_reduce(part, 1, 0, 0, 4, lane), a2 = mini_reduce(part, 1, 0, 4, 8, lane);
                const size_t grow = (size_t)MP + 32 * mb + r32;
#pragma unroll
                for (int g4 = 0; g4 < 4; ++g4) { const int col = 32 * nb + 8 * g4 + 4 * hi;
                    const v2u sa = *(const v2u*)(SMA + grow * 1024 + col), sb = *(const v2u*)(SMB + grow * 1024 + col);
                    v2u w; w.x = cvtpk(bflo(sa.x) * a1[4 * g4] + bflo(sb.x) * a2[4 * g4], bfhi(sa.x) * a1[4 * g4 + 1] + bfhi(sb.x) * a2[4 * g4 + 1]);
                    w.y = cvtpk(bflo(sa.y) * a1[4 * g4 + 2] + bflo(sb.y) * a2[4 * g4 + 2], bfhi(sa.y) * a1[4 * g4 + 3] + bfhi(sb.y) * a2[4 * g4 + 3]);
                    *(v2u*)(MG + grow * 1024 + col) = w; }
            }
            __syncthreads();
        }
        pg8::Gemm g{XN, WBR, DM, 8}; pg8::StaticOrder S; S.init(MP, DM, G, bx, 2);
        pg8::EpiMerge E{SMA, SMB, MG};
        pg8::gemm_phase<pg8::EpiMerge, pg8::StaticOrder>(lds, g, S, E);
    }
    xcd_barrier(bar);
#pragma nounroll
    for (int rep = 0; rep < REP_P3B; ++rep) {
        if (rep) xcd_barrier(bar);
        if (rep == 0 && vcu < 128) {
            const int tid = fresh_tid(), lane = tid & 63, r32 = lane & 31, hi = lane >> 5; const int wave = __builtin_amdgcn_readfirstlane(tid >> 6);
            const int mb = vcu & 3, nb = vcu >> 2;
            LAS float* part = (LAS float*)lds;
            mini_slice_to_lds(MG + (size_t)(MP + 32 * mb) * DM, WOUT + (size_t)(32 * nb) * DM, part, wave, wave, lane);
            __syncthreads();
            if (wave == 0) {
                const f32x16 a1 = mini_reduce(part, 1, 0, 0, 8, lane);
                const size_t grow = (size_t)MP + 32 * mb + r32;
#pragma unroll
                for (int g4 = 0; g4 < 4; ++g4) { const f32x4 v = {a1[4 * g4], a1[4 * g4 + 1], a1[4 * g4 + 2], a1[4 * g4 + 3]}; *(f32x4*)(OUTF + grow * 1024 + 32 * nb + 8 * g4 + 4 * hi) = v; }
            }
            __syncthreads();
        }
        pg8::Gemm g{MG, WOUT, DM, DM / 64}; pg8::StaticOrder S; S.init(MP, DM, G, bx, 1);
        pg8::EpiF32 E{OUTF, DM};
        pg8::gemm_phase<pg8::EpiF32, pg8::StaticOrder>(lds, g, S, E);
    }
    xcd_barrier(bar);
#pragma nounroll
    for (int rep = 0; rep < REP_P4; ++rep) {
        const int tid = fresh_tid(), lane = tid & 63; const int wave = __builtin_amdgcn_readfirstlane(tid >> 6); const int gw = vcu * 8 + wave;
        f32x4 gv[4];
#pragma unroll
        for (int j = 0; j < 4; ++j) gv[j] = *((const f32x4*)g_post + lane + 64 * j);
        for (int m = gw; m < MP + MS; m += NGW) {
            const float* xrow = (m < MP) ? x_p + (size_t)m * DM : x_s + (size_t)(m - MP) * DM;
            float* yrow = (m < MP) ? out + O_YP + (size_t)m * DM : out + O_YS + (size_t)(m - MP) * DM;
            const float* orow = OUTF + (size_t)m * DM;
            f32x4 v[4], xv[4]; float ss = 0.f;
#pragma unroll
            for (int j = 0; j < 4; ++j) { v[j] = *((const f32x4*)orow + lane + 64 * j); xv[j] = *((const f32x4*)xrow + lane + 64 * j);
                ss += (v[j][0] * v[j][0] + v[j][1] * v[j][1]) + (v[j][2] * v[j][2] + v[j][3] * v[j][3]); }
            ss = wave_sum(ss);
            const float rs = 1.0f / sqrtf(ss * (1.0f / DM) + EPS);
#pragma unroll
            for (int j = 0; j < 4; ++j) *((f32x4*)yrow + lane + 64 * j) = xv[j] + v[j] * rs * gv[j];
        }
    }
}

extern "C" void kernel_launch(void* const* d_in, const int* in_sizes, int n_in, void* d_out, int out_size, void* d_ws, size_t ws_size, hipStream_t stream) {
    static int grid = 0;
    if (grid == 0) {
        if (n_in != 15 || in_sizes[0] != MP * DM || (size_t)out_size != O_END || ws_size < WS_END) {
            fprintf(stderr, "kernel_launch: unexpected shapes: n_in %d in0 %d out %d ws %zu (need %zu)\n", n_in, n_in > 0 ? in_sizes[0] : -1, out_size, ws_size, (size_t)WS_END); grid = -1; return; }
        int dev = 0, cus = 0, per_cu = 0;
        if (hipGetDevice(&dev) != hipSuccess || hipDeviceGetAttribute(&cus, hipDeviceAttributeMultiprocessorCount, dev) != hipSuccess) { fprintf(stderr, "kernel_launch: device query failed\n"); grid = -1; return; }
        if (hipFuncSetAttribute((const void*)fwd_kernel, hipFuncAttributeMaxDynamicSharedMemorySize, LDS_BYTES) != hipSuccess) { fprintf(stderr, "kernel_launch: hipFuncSetAttribute failed\n"); grid = -1; return; }
        if (hipOccupancyMaxActiveBlocksPerMultiprocessor(&per_cu, (const void*)fwd_kernel, 512, LDS_BYTES) != hipSuccess || per_cu < 1) {
            fprintf(stderr, "kernel_launch: occupancy query reports %d blocks per CU\n", per_cu); (void)hipGetLastError(); grid = -1; return; }
        grid = cus;
    }
    if (grid < 0) return;
    if (hipMemsetAsync((char*)d_ws + WS_CTL, 0, CTL_ZERO_BYTES, stream) != hipSuccess) { fprintf(stderr, "kernel_launch: memset failed\n"); return; }
    Args a{};
    for (int i = 0; i < 15; ++i) a.in[i] = (const float*)d_in[i];
    a.out = (float*)d_out; a.ws = (unsigned char*)d_ws;
    hipLaunchKernelGGL(fwd_kernel, dim3(grid), dim3(512), LDS_BYTES, stream, a);
    const hipError_t le = hipPeekAtLastError();
    if (le != hipSuccess) fprintf(stderr, "kernel_launch: launch failed: %s\n", hipGetErrorName(le));
}
```

```cpp
#include <hip/hip_runtime.h>
#include <hip/hip_bf16.h>
#include <cstdio>
#include <cstdint>

constexpr int DM = 1024, NB = 2, SEQ = 16384, DECB = 8, DECS = 16, PAST = 4096, AKEEP = 512;
constexpr int NH = 8, HD = 64, WA = 512;
constexpr int NIN = 6152;
constexpr int NG = 6144;
constexpr int MP = NB * SEQ;
constexpr int MS = DECB * DECS;
constexpr int MTOT = MP + 256;
constexpr int NREL = 192;
constexpr float EPS = 1e-6f;
constexpr float L2E = 1.4426950408889634f;
constexpr float C2 = 0.125f * L2E;
constexpr int FS_PITCH = 4160;

constexpr size_t O_YP = 0, O_YS = 33554432, O_AKP = 33685504, O_AVP = 34209792, O_BKP = 34734080, O_BVP = 51511296, O_BLP = 68288512,
                 O_AKS = 68550656, O_AVS = 70647808, O_BKS = 72744960, O_BVS = 72810496, O_BLS = 72876032, O_END = 72877056;

constexpr size_t MiB = 1u << 20;
constexpr size_t WS_CTL = 0, CTL_ZERO_BYTES = 32768;
constexpr size_t WS_FP = 1 * MiB;
constexpr size_t WS_LFP = 2 * MiB;
constexpr size_t WS_FS = 3 * MiB;
constexpr size_t WS_LFN = 5 * MiB;
constexpr size_t WS_WIN = 6 * MiB;
constexpr size_t WS_WBR = 18 * MiB;
constexpr size_t WS_WOUT = 20 * MiB;
constexpr size_t WS_XN = 24 * MiB;
constexpr size_t ACT_BYTES = (size_t)MTOT * 512 * 2;
constexpr size_t WS_QA = 89 * MiB, WS_KA = 122 * MiB, WS_VA = 155 * MiB, WS_QB = 188 * MiB, WS_KB = 221 * MiB, WS_VB = 254 * MiB;
constexpr size_t WS_MG = 89 * MiB;
constexpr size_t WS_OUTF = 155 * MiB;
constexpr size_t WS_SZA = 287 * MiB, WS_SZB = 320 * MiB;
constexpr size_t WS_SMA = 353 * MiB, WS_SMB = 418 * MiB;
constexpr size_t WS_END = 483 * MiB;
static_assert(ACT_BYTES <= 33 * MiB && WS_XN + 2 * ACT_BYTES <= WS_QA && WS_OUTF + (size_t)MTOT * 1024 * 4 <= WS_SZA && WS_MG + 2 * ACT_BYTES <= WS_OUTF, "ws map");

constexpr int CW_KNORM = 64;
constexpr int CW_QUEUE = 1024;
constexpr int CW_BAR = 4096;

constexpr int RING_BYTES = 131072;
constexpr int LDSCTL_OFF = RING_BYTES, MISC_OFF = LDSCTL_OFF + 320;
constexpr int TB_OFF = LDSCTL_OFF + 1024;
constexpr int WSF_OFF = LDSCTL_OFF + 2048;
constexpr int QMX_OFF = LDSCTL_OFF + 4096;
constexpr int LDS_BYTES = 147456;

#define GAS __attribute__((address_space(1)))
#define LAS __attribute__((address_space(3)))
typedef unsigned short bf16;
typedef unsigned v4u __attribute__((ext_vector_type(4)));
typedef unsigned v2u __attribute__((ext_vector_type(2)));
typedef float f32x4 __attribute__((ext_vector_type(4)));
typedef float f32x2 __attribute__((ext_vector_type(2)));
typedef float f32x16 __attribute__((ext_vector_type(16)));
typedef short bf16x8 __attribute__((ext_vector_type(8)));
typedef short s16x4 __attribute__((ext_vector_type(4)));
typedef short v4i16_t __attribute__((ext_vector_type(4)));
typedef __bf16 bf16x2_t __attribute__((ext_vector_type(2)));
typedef GAS unsigned gu32;
#define RLX_AGENT __ATOMIC_RELAXED, __HIP_MEMORY_SCOPE_AGENT

__device__ __forceinline__ unsigned cvtpk(float lo, float hi) { f32x2 v = {lo, hi}; bf16x2_t b = __builtin_convertvector(v, bf16x2_t); return __builtin_bit_cast(unsigned, b); }
__device__ __forceinline__ int fresh_tid() { int t = threadIdx.x; asm volatile("" : "+v"(t)); return t; }
__device__ __forceinline__ float bflo(unsigned u) { return __uint_as_float(u << 16); }
__device__ __forceinline__ float bfhi(unsigned u) { return __uint_as_float(u & 0xffff0000u); }
__device__ __forceinline__ float fexp2(float x) { return __builtin_amdgcn_exp2f(x); }
__device__ __forceinline__ float sigmoidf_(float v) { return __builtin_amdgcn_rcpf(1.0f + fexp2(-v * L2E)); }

namespace pg8 {
#define PG8_LAS __attribute__((address_space(3)))
typedef unsigned short bf16_t;
typedef unsigned u32x4 __attribute__((ext_vector_type(4)));
constexpr int BM = 256, BK = 64, HALF = 128, HTB = HALF * BK * 2, STAGE_BYTES = 8 * HTB, NXCD = 8, WGM = 8;

__host__ __device__ __forceinline__ int lds_byte(int r, int c) { const int st = (r >> 4) * 2 + (c >> 5), rr = r & 15, cc = c & 31, ob = rr * 64 + cc * 2; return st * 1024 + (ob ^ (((ob >> 9) & 1) << 5)); }
__host__ __device__ __forceinline__ void stage_rc(int b, int& R, int& C) { const int st = b / 1024, sb = b % 1024, swz = sb ^ (((sb >> 9) & 1) << 5); R = (st >> 1) * 16 + swz / 64; C = (st & 1) * 32 + (swz % 64) / 2; }
__host__ __device__ __forceinline__ int perm32(int rho) { const int n = rho >> 4, i = rho & 15; return 8 * (i >> 2) + 4 * n + (i & 3); }

struct Unit { int pm, pn, kh; };
struct Gemm { const bf16_t* A; const bf16_t* Bt; int ldk; int nt; };

struct StaticOrder {
    int nM, nN, nwg, G, c, nkh;
    __device__ void init(int M, int N, int G_, int c_, int nkh_) { nM = M / BM; nN = N / BM; nwg = nM * nN; G = G_; c = c_; nkh = nkh_; }
    __device__ bool next(int i, Unit& u) const {
        const int ti = i / nkh; u.kh = i - ti * nkh;
        const long L = (long)ti * G + c; if (L >= nwg) return false;
        int wgid = (int)L; { const int q = nwg / NXCD, r = nwg % NXCD, xcd = wgid % NXCD, off = wgid / NXCD; wgid = (xcd < r ? xcd * (q + 1) : r * (q + 1) + (xcd - r) * q) + off; }
        const int nig = WGM * nN, gid = wgid / nig, fm = gid * WGM, gsz = (nM - fm) < WGM ? (nM - fm) : WGM;
        u.pm = fm + ((wgid % nig) % gsz); u.pn = (wgid % nig) / gsz; return true;
    }
};


struct EpiInProj {
    static constexpr bool PERM = true;
    bf16_t *QA, *KA, *VA, *SZA, *QB, *KB, *VB, *SZB, *SMA, *SMB;
    float* out;
    unsigned* knorm;
    __device__ __forceinline__ bool keep(const Unit&) const { return false; }
    __device__ __forceinline__ void operator()(f32x4 (&acc)[2][2][4][2], const Unit& u, int wr, int wc, int fr, int fq) const {
        const int pn = u.pn, pm = u.pm;
        bf16_t* dst; int ldd, dcol, actk; float* f32p = nullptr; int fmode = 0, nvalid = 256; bool dnorm = false; int noff = 0;
        const bool sample = (pm == 128);
        if (pn < 16) {
            const int seg = pn >> 1; dcol = (pn & 1) * 256; ldd = 512;
            if (seg == 0) { dst = QA; actk = 1; }
            else if (seg == 1) { dst = KA; actk = 0; }
            else if (seg == 2) { dst = VA; actk = 0; }
            else if (seg == 3) { dst = SZA; actk = 2; }
            else if (seg == 4) { dst = QB; actk = 1; }
            else if (seg == 5) { dst = KB; actk = 0; }
            else if (seg == 6) { dst = VB; actk = 0; }
            else { dst = SZB; actk = 2; }
            if (seg == 1 || seg == 2) {
                if (!sample) { const int bt = pm & 63; if (bt >= 62) { f32p = out + (seg == 1 ? O_AKP : O_AVP) + ((size_t)((pm >> 6) * 512 + (bt - 62) * 256)) * 512 + dcol; fmode = 1; } }
                else { f32p = out + (seg == 1 ? O_AKS : O_AVS) + dcol; fmode = 2; nvalid = 128; }
            } else if (seg == 4) { if (!sample) { dnorm = true; noff = 32; }
            } else if (seg == 5 || seg == 6) {
                if (!sample) { f32p = out + (seg == 5 ? O_BKP : O_BVP) + (size_t)pm * 256 * 512 + dcol; fmode = 1; dnorm = (seg == 5); }
                else { f32p = out + (seg == 5 ? O_BKS : O_BVS) + dcol; fmode = 1; nvalid = 128; }
            }
        } else { ldd = 1024; actk = 3; if (pn < 20) { dst = SMA; dcol = (pn - 16) * 256; } else { dst = SMB; dcol = (pn - 20) * 256; } }
        const int rl0 = wr * 64 + fr, cl = wc * 32 + 8 * fq;
        if (dnorm) {
#pragma unroll
            for (int bj = 0; bj < 2; ++bj) { float mx = 0.f;
#pragma unroll
                for (int ai = 0; ai < 2; ++ai)
#pragma unroll
                    for (int m = 0; m < 4; ++m) { const f32x4 a = acc[ai][bj][m][0], b = acc[ai][bj][m][1];
                        float s = (a[0] * a[0] + a[1] * a[1]) + (a[2] * a[2] + a[3] * a[3]) + (b[0] * b[0] + b[1] * b[1]) + (b[2] * b[2] + b[3] * b[3]);
                        s += __shfl_xor(s, 16); s += __shfl_xor(s, 32); mx = fmaxf(mx, s); }
                mx = fmaxf(mx, __shfl_xor(mx, 1)); mx = fmaxf(mx, __shfl_xor(mx, 2)); mx = fmaxf(mx, __shfl_xor(mx, 4)); mx = fmaxf(mx, __shfl_xor(mx, 8));
                if (fr == 0 && fq == 0) { const int head = (pn & 1) * 4 + bj * 2 + (wc >> 1);
                    __hip_atomic_fetch_max(knorm + noff + (((pm >> 6) * 8 + head) * 2 + (wc & 1)), __float_as_uint(mx), __ATOMIC_RELAXED, __HIP_MEMORY_SCOPE_AGENT); }
            }
        }
#pragma unroll
        for (int ai = 0; ai < 2; ++ai)
#pragma unroll
            for (int m = 0; m < 4; ++m) { const int rl = rl0 + ai * HALF + m * 16; const size_t grow = (size_t)pm * BM + rl;
#pragma unroll
                for (int bj = 0; bj < 2; ++bj) { f32x4 v0 = acc[ai][bj][m][0], v1 = acc[ai][bj][m][1];
                    if (f32p != nullptr && rl < nvalid) { const size_t ro = (fmode == 1) ? (size_t)rl * 512 : ((size_t)((rl >> 4) * 512 + 496 + (rl & 15))) * 512;
                        *(f32x4*)(f32p + ro + cl + bj * HALF) = v0; *(f32x4*)(f32p + ro + cl + bj * HALF + 4) = v1; }
                    if (actk == 1) { v0 = v0 * C2; v1 = v1 * C2; }
                    else if (actk == 2) {
#pragma unroll
                        for (int e = 0; e < 4; ++e) { v0[e] = v0[e] * sigmoidf_(v0[e]); v1[e] = v1[e] * sigmoidf_(v1[e]); } }
                    else if (actk == 3) {
#pragma unroll
                        for (int e = 0; e < 4; ++e) { v0[e] = sigmoidf_(v0[e]); v1[e] = sigmoidf_(v1[e]); } }
                    u32x4 w; w.x = cvtpk(v0[0], v0[1]); w.y = cvtpk(v0[2], v0[3]); w.z = cvtpk(v1[0], v1[1]); w.w = cvtpk(v1[2], v1[3]);
                    *(u32x4*)(dst + grow * ldd + dcol + cl + bj * HALF) = w; } }
    }
};
struct EpiMerge {
    static constexpr bool PERM = true;
    const bf16_t *SMA, *SMB; bf16_t* MG;
    __device__ __forceinline__ bool keep(const Unit& u) const { return u.kh == 0; }
    __device__ __forceinline__ void operator()(f32x4 (&acc)[2][2][4][2], const Unit& u, int wr, int wc, int fr, int fq) const {
        const int rl0 = wr * 64 + fr, cl = wc * 32 + 8 * fq;
        const size_t off0 = ((size_t)u.pm * BM + rl0) * 1024 + u.pn * BM + cl;
#pragma unroll
        for (int ai = 0; ai < 2; ++ai) {
            u32x4 sb[4][2], sa[4][2];
#pragma unroll
            for (int m = 0; m < 4; ++m)
#pragma unroll
                for (int bj = 0; bj < 2; ++bj) { const size_t off = off0 + (size_t)(ai * HALF + m * 16) * 1024 + bj * HALF;
                    sb[m][bj] = *(const u32x4*)(SMB + off); if (u.kh == 0) sa[m][bj] = *(const u32x4*)(SMA + off); }
#pragma unroll
            for (int m = 0; m < 4; ++m)
#pragma unroll
                for (int bj = 0; bj < 2; ++bj) { const size_t off = off0 + (size_t)(ai * HALF + m * 16) * 1024 + bj * HALF;
                    const u32x4 b4 = sb[m][bj];
                    float g[8] = {bflo(b4.x), bfhi(b4.x), bflo(b4.y), bfhi(b4.y), bflo(b4.z), bfhi(b4.z), bflo(b4.w), bfhi(b4.w)};
                    if (u.kh == 0) { const u32x4 a4 = sa[m][bj];
                        const float a[8] = {bflo(a4.x), bfhi(a4.x), bflo(a4.y), bfhi(a4.y), bflo(a4.z), bfhi(a4.z), bflo(a4.w), bfhi(a4.w)};
#pragma unroll
                        for (int e = 0; e < 8; ++e) g[e] = a[e] * __builtin_amdgcn_rcpf(g[e]);
#pragma unroll
                        for (int e = 0; e < 4; ++e) { acc[ai][bj][m][0][e] *= g[e]; acc[ai][bj][m][1][e] *= g[4 + e]; }
                    } else { f32x4 v0 = acc[ai][bj][m][0], v1 = acc[ai][bj][m][1];
#pragma unroll
                        for (int e = 0; e < 4; ++e) { v0[e] *= g[e]; v1[e] *= g[4 + e]; }
                        u32x4 w; w.x = cvtpk(v0[0], v0[1]); w.y = cvtpk(v0[2], v0[3]); w.z = cvtpk(v1[0], v1[1]); w.w = cvtpk(v1[2], v1[3]);
                        *(u32x4*)(MG + off) = w; } }
        }
    }
};
struct EpiF32 {
    static constexpr bool PERM = false;
    float* C; int ldc;
    __device__ __forceinline__ bool keep(const Unit&) const { return false; }
    __device__ __forceinline__ void operator()(f32x4 (&acc)[2][2][4][2], const Unit& u, int wr, int wc, int fr, int fq) const {
        const int row0 = u.pm * BM + wr * 64 + fr, col0 = u.pn * BM + wc * 32 + 4 * fq;
#pragma unroll
        for (int ai = 0; ai < 2; ++ai)
#pragma unroll
            for (int m = 0; m < 4; ++m) { float* rowp = C + (size_t)(row0 + ai * HALF + m * 16) * ldc + col0;
#pragma unroll
                for (int bj = 0; bj < 2; ++bj)
#pragma unroll
                    for (int n = 0; n < 2; ++n) *(f32x4*)(rowp + bj * HALF + n * 16) = acc[ai][bj][m][n]; }
    }
};

struct EpiBf16Out {
    static constexpr bool PERM = true;
    bf16_t* C; int ldc;
    __device__ __forceinline__ bool keep(const Unit&) const { return false; }
    __device__ __forceinline__ void operator()(f32x4 (&acc)[2][2][4][2], const Unit& u, int wr, int wc, int fr, int fq) const {
        const int row0 = u.pm * BM + wr * 64 + fr, col0 = u.pn * BM + wc * 32 + 8 * fq;
#pragma unroll
        for (int ai = 0; ai < 2; ++ai)
#pragma unroll
            for (int m = 0; m < 4; ++m) { bf16_t* rowp = C + (size_t)(row0 + ai * HALF + m * 16) * ldc + col0;
#pragma unroll
                for (int bj = 0; bj < 2; ++bj) { const f32x4 v0 = acc[ai][bj][m][0], v1 = acc[ai][bj][m][1];
                    u32x4 w; w.x = cvtpk(v0[0], v0[1]); w.y = cvtpk(v0[2], v0[3]); w.z = cvtpk(v1[0], v1[1]); w.w = cvtpk(v1[2], v1[3]);
                    *(u32x4*)(rowp + bj * HALF) = w; } }
    }
};
template <class Epi, class Sched>
__device__ __forceinline__ void gemm_phase(PG8_LAS unsigned char* lds, const Gemm g, const Sched& S, const Epi& E) {
    const int tid = fresh_tid(), wid = __builtin_amdgcn_readfirstlane(tid >> 6), lane = tid & 63, wr = wid >> 2, wc = wid & 3, fr = lane & 15, fq = lane >> 4;
    const int K = g.ldk, nt = g.nt;
    unsigned voffA[2], voffB[2];
#pragma unroll
    for (int i = 0; i < 2; ++i) { int R, C; stage_rc(tid * 16 + i * 8192, R, C); const int Rb = Epi::PERM ? ((R & ~31) + perm32(R & 31)) : R;
        voffA[i] = (unsigned)(R * K + C) * 2u; voffB[i] = (unsigned)(Rb * K + C) * 2u; }
    const size_t kstep = (size_t)(BK * 2);
    const size_t hstep = (size_t)HALF * K * 2;
    const size_t tstep = 2 * hstep;
    const size_t khb = (size_t)nt * BK * 2;
    const unsigned ldsw = (unsigned)wid * 1024u;
    const int aoff = lds_byte(wr * 64 + fr, fq * 8), boff = lds_byte(wc * 32 + fr, fq * 8);
#define PG8_SA(b, h) (((b) * 2 + (h)) * HTB)
#define PG8_SB(b, h) ((4 + (b) * 2 + (h)) * HTB)
#define PG8_STAGE(bufoff, gbase, voff) do { _Pragma("unroll") for (int _i = 0; _i < 2; ++_i) \
        __builtin_amdgcn_global_load_lds((const unsigned*)((const char*)(gbase) + (voff)[_i]), (PG8_LAS unsigned*)(lds + (bufoff) + ldsw + _i * 8192), 16, 0, 0); } while (0)
#define PG8_LDA(dst, b, h) do { _Pragma("unroll") for (int m = 0; m < 4; ++m) _Pragma("unroll") for (int k = 0; k < 2; ++k) dst[m][k] = *(const PG8_LAS bf16x8*)(lds + PG8_SA(b, h) + aoff + m * 2048 + k * 1024); } while (0)
#define PG8_LDB(dst, b, h) do { _Pragma("unroll") for (int n = 0; n < 2; ++n) _Pragma("unroll") for (int k = 0; k < 2; ++k) dst[n][k] = *(const PG8_LAS bf16x8*)(lds + PG8_SB(b, h) + boff + n * 2048 + k * 1024); } while (0)
#define PG8_MMA(ai, bj, At, Bt) do { __builtin_amdgcn_s_setprio(1); _Pragma("unroll") for (int m = 0; m < 4; ++m) _Pragma("unroll") for (int n = 0; n < 2; ++n) _Pragma("unroll") for (int k = 0; k < 2; ++k) \
        acc[ai][bj][m][n] = __builtin_amdgcn_mfma_f32_16x16x32_bf16(Bt[n][k], At[m][k], acc[ai][bj][m][n], 0, 0, 0); __builtin_amdgcn_s_setprio(0); } while (0)
#define PG8_WAIT_V(n) asm volatile("s_waitcnt vmcnt(" #n ")" ::: "memory")
#define PG8_WAIT_L(n) asm volatile("s_waitcnt lgkmcnt(" #n ")" ::: "memory")
#define PG8_BAR __builtin_amdgcn_s_barrier()
#define PG8_SCHED __builtin_amdgcn_sched_barrier(0)
    Unit cur, nxt; int ui = 0;
    if (!S.next(0, cur)) return;
    f32x4 acc[2][2][4][2];
#pragma unroll
    for (int a = 0; a < 2; ++a)
#pragma unroll
        for (int b = 0; b < 2; ++b)
#pragma unroll
            for (int m = 0; m < 4; ++m)
#pragma unroll
                for (int n = 0; n < 2; ++n) acc[a][b][m][n] = (f32x4){0.f, 0.f, 0.f, 0.f};
    bf16x8 At[4][2], B0[2][2], B1[2][2];
    const char* cA = (const char*)g.A + (size_t)cur.pm * tstep + (size_t)cur.kh * khb; const char* cB = (const char*)g.Bt + (size_t)cur.pn * tstep + (size_t)cur.kh * khb;
    PG8_STAGE(PG8_SB(0, 0), cB, voffB); PG8_STAGE(PG8_SB(0, 1), cB + hstep, voffB); PG8_STAGE(PG8_SA(0, 0), cA, voffA); PG8_STAGE(PG8_SA(0, 1), cA + hstep, voffA);
    if (wr == 1) PG8_BAR;
    PG8_WAIT_V(2); PG8_BAR;
    PG8_STAGE(PG8_SB(1, 0), cB + kstep, voffB); PG8_STAGE(PG8_SA(1, 0), cA + kstep, voffA); PG8_STAGE(PG8_SB(1, 1), cB + hstep + kstep, voffB);
    PG8_WAIT_V(6); PG8_BAR;
    for (;;) {
        const bool has_next = S.next(ui + 1, nxt);
        const char* nA = has_next ? (const char*)g.A + (size_t)nxt.pm * tstep + (size_t)nxt.kh * khb : cA; const char* nB = has_next ? (const char*)g.Bt + (size_t)nxt.pn * tstep + (size_t)nxt.kh * khb : cB;
        for (int t = 0; t < nt; t += 2) {
            const bool last = (t == nt - 2);
            const char* a1 = cA + (size_t)(t + 1) * kstep;
            const char* a2 = last ? nA : cA + (size_t)(t + 2) * kstep; const char* b2 = last ? nB : cB + (size_t)(t + 2) * kstep;
            const char* a3 = a2 + kstep; const char* b3 = b2 + kstep;
            PG8_LDB(B0, 0, 0); PG8_LDB(B1, 0, 1); PG8_SCHED; PG8_LDA(At, 0, 0); PG8_STAGE(PG8_SA(1, 1), a1 + hstep, voffA);
            PG8_WAIT_V(8); PG8_WAIT_L(0); PG8_BAR; PG8_MMA(0, 0, At, B0); PG8_MMA(0, 1, At, B1); PG8_BAR; PG8_SCHED;
            PG8_LDA(At, 0, 1); PG8_STAGE(PG8_SB(0, 0), b2, voffB); PG8_STAGE(PG8_SB(0, 1), b2 + hstep, voffB); PG8_STAGE(PG8_SA(0, 0), a2, voffA);
            PG8_WAIT_V(8); PG8_WAIT_L(0); PG8_BAR; PG8_MMA(1, 0, At, B0); PG8_MMA(1, 1, At, B1); PG8_BAR; PG8_SCHED;
            PG8_LDB(B0, 1, 0); PG8_LDB(B1, 1, 1); PG8_SCHED; PG8_LDA(At, 1, 0); PG8_STAGE(PG8_SA(0, 1), a2 + hstep, voffA);
            PG8_WAIT_V(8); PG8_WAIT_L(0); PG8_BAR; PG8_MMA(0, 0, At, B0); PG8_MMA(0, 1, At, B1); PG8_BAR; PG8_SCHED;
            PG8_LDA(At, 1, 1); PG8_STAGE(PG8_SB(1, 0), b3, voffB); PG8_STAGE(PG8_SB(1, 1), b3 + hstep, voffB); PG8_STAGE(PG8_SA(1, 0), a3, voffA);
            PG8_WAIT_V(8); PG8_WAIT_L(0); PG8_BAR; PG8_MMA(1, 0, At, B0); PG8_MMA(1, 1, At, B1); PG8_BAR; PG8_SCHED;
        }
        if (wr == 0) PG8_BAR;
        E(acc, cur, wr, wc, fr, fq);
        if (!has_next) break;
        if (!E.keep(cur)) {
#pragma unroll
            for (int a = 0; a < 2; ++a)
#pragma unroll
                for (int b = 0; b < 2; ++b)
#pragma unroll
                    for (int m = 0; m < 4; ++m)
#pragma unroll
                        for (int n = 0; n < 2; ++n) acc[a][b][m][n] = (f32x4){0.f, 0.f, 0.f, 0.f};
        }
        cur = nxt; cA = nA; cB = nB; ++ui;
        if (wr == 1) PG8_BAR;
    }
    PG8_WAIT_V(0);
    PG8_BAR;
#undef PG8_SA
#undef PG8_SB
#undef PG8_STAGE
#undef PG8_LDA
#undef PG8_LDB
#undef PG8_MMA
#undef PG8_WAIT_V
#undef PG8_WAIT_L
#undef PG8_BAR
#undef PG8_SCHED
}
}

#define XB_TMO      128
#define XB_XCNT(j)  (256  + 64 * (j))
#define XB_XSUB(j)  (1280 + 64 * (j))
#define XB_XGEN(j)  (2304 + 64 * (j))
#define XB_TOP      3328
#define XB_TOPGEN   3392
#define XCD_BAR_WORDS 3456
#define XB_SPIN_CAP (1u << 18)
__device__ __forceinline__ unsigned xb_ld(unsigned* p)              { return __hip_atomic_load(p, __ATOMIC_RELAXED, __HIP_MEMORY_SCOPE_AGENT); }
__device__ __forceinline__ unsigned xb_add(unsigned* p, unsigned v) { return __hip_atomic_fetch_add(p, v, __ATOMIC_RELAXED, __HIP_MEMORY_SCOPE_AGENT); }
__device__ __forceinline__ unsigned xb_xcc_id() { return (unsigned)__builtin_amdgcn_s_getreg((3 << 11) | 20) & 0xFu; }
#define XB_SPIN(cond, bar) do { unsigned _sp = 0; while (cond) { __builtin_amdgcn_s_sleep(1); \
    if ((++_sp & 255u) == 0u) { if (xb_ld(&(bar)[XB_TMO])) break; if (_sp > XB_SPIN_CAP) { atomicAdd(&(bar)[XB_TMO], 1u); break; } } } } while (0)
struct XcdBarrier { unsigned* bar; unsigned x; volatile LAS unsigned* st; };
__device__ __forceinline__ XcdBarrier xcd_barrier_post(unsigned* bar, volatile LAS unsigned* st) {
    XcdBarrier b; b.bar = bar; b.x = xb_xcc_id(); b.st = st;
    if (threadIdx.x == 0) (void)xb_add(&bar[XB_XCNT(b.x)], 1u);
    return b;
}
__device__ __forceinline__ void xcd_barrier_complete(unsigned* bar, unsigned x, unsigned& nloc, unsigned& nx) {
    const unsigned G = gridDim.x * gridDim.y * gridDim.z;
    unsigned sum, cnt, mine, sp = 0u;
    for (;;) {
        sum = 0u; cnt = 0u; mine = 0u;
#pragma unroll
        for (unsigned j = 0; j < 16; ++j) { const unsigned c = xb_ld(&bar[XB_XCNT(j)]); sum += c; cnt += (c > 0u) ? 1u : 0u; mine = (j == x) ? c : mine; }
        if (sum == G) break;
        __builtin_amdgcn_s_sleep(1);
        if ((++sp & 255u) == 0u) { if (xb_ld(&bar[XB_TMO])) break; if (sp > XB_SPIN_CAP) { atomicAdd(&bar[XB_TMO], 1u); break; } }
    }
    nloc = mine > 0u ? mine : 1u; nx = cnt > 0u ? cnt : 1u;
}
__device__ __forceinline__ void xcd_barrier(const XcdBarrier& b) {
    asm volatile("s_waitcnt vmcnt(0)" ::: "memory");
    __syncthreads();
    if (threadIdx.x == 0) {
        unsigned* bar = b.bar;
        __builtin_amdgcn_s_waitcnt(0);
        unsigned nloc = b.st[0], nx = b.st[1];
        if (nloc == 0u) { xcd_barrier_complete(bar, b.x, nloc, nx); b.st[0] = nloc; b.st[1] = nx; }
        const unsigned old = xb_add(&bar[XB_XSUB(b.x)], 1u);
        const unsigned gen = old / nloc;
        if (old + 1u == (gen + 1u) * nloc) {
            __builtin_amdgcn_fence(__ATOMIC_RELEASE, "agent");
            asm volatile("s_waitcnt vmcnt(0)" ::: "memory");
            const unsigned og = xb_add(&bar[XB_TOP], 1u);
            const unsigned tg = og / nx;
            if (og + 1u == (tg + 1u) * nx) xb_add(&bar[XB_TOPGEN], 1u);
            else XB_SPIN(xb_ld(&bar[XB_TOPGEN]) == tg, bar);
            __builtin_amdgcn_fence(__ATOMIC_ACQUIRE, "agent");
            xb_add(&bar[XB_XGEN(b.x)], 1u);
            asm volatile("s_waitcnt vmcnt(0)" ::: "memory");
        } else {
            XB_SPIN(xb_ld(&bar[XB_XGEN(b.x)]) == gen, bar);
            __builtin_amdgcn_fence(__ATOMIC_ACQUIRE, "agent");
            asm volatile("s_waitcnt vmcnt(0)" ::: "memory");
        }
    }
    __syncthreads();
}

struct Args { const float* in[15]; float* out; unsigned char* ws; };

__device__ __forceinline__ float wave_sum(float v) {
#pragma unroll
    for (int o = 1; o < 64; o <<= 1) v += __shfl_xor(v, o);
    return v;
}
__device__ __forceinline__ float wave_max(float v) {
#pragma unroll
    for (int o = 1; o < 64; o <<= 1) v = fmaxf(v, __shfl_xor(v, o));
    return v;
}

__device__ __forceinline__ void p0_transpose_item(const float* W, int ldw, int csrc, bf16* WT, int ldt, int kdst, int nrow0, LAS float* scr, int k0, int lane) {
#pragma unroll 8
    for (int i = 0; i < 32; ++i) { const int kk = 2 * i + (lane >> 5); scr[kk * 33 + (lane & 31)] = W[(size_t)(k0 + kk) * ldw + csrc + (lane & 31)]; }
    asm volatile("s_waitcnt lgkmcnt(0)" ::: "memory");
    const int c = lane & 7;
#pragma unroll
    for (int j = 0; j < 4; ++j) { const int n = (lane >> 3) + 8 * j; const LAS float* s = scr + (8 * c) * 33 + n;
        v4u o; o.x = cvtpk(s[0 * 33], s[1 * 33]); o.y = cvtpk(s[2 * 33], s[3 * 33]); o.z = cvtpk(s[4 * 33], s[5 * 33]); o.w = cvtpk(s[6 * 33], s[7 * 33]);
        *(GAS v4u*)(WT + (size_t)(nrow0 + n) * ldt + kdst + k0 + 8 * c) = o; }
    asm volatile("s_waitcnt lgkmcnt(0)" ::: "memory");
}

namespace att {
typedef LAS const unsigned char* ldsc;
__device__ __forceinline__ int crow(int r, int hi) { return (r & 3) + 8 * (r >> 2) + 4 * hi; }
#define MFMA32(a, b, c) __builtin_amdgcn_mfma_f32_32x32x16_bf16(a, b, c, 0, 0, 0)
__device__ __forceinline__ s16x4 vtr(ldsc p) { return __builtin_bit_cast(s16x4, __builtin_amdgcn_ds_read_tr16_b64_v4i16((LAS v4i16_t*)p)); }

__device__ __forceinline__ void qkt(f32x16& p0, f32x16& p1, ldsc Kslot, const bf16x8* qr, const f32x16& c0, const f32x16& c1, int r32, int hi) {
    ldsc kb = Kslot + hi * 1024 + r32 * 16;
#pragma unroll
    for (int d0 = 0; d0 < 4; ++d0) {
        const bf16x8 b0 = *(LAS const bf16x8*)(kb + d0 * 2048);
        const bf16x8 b1 = *(LAS const bf16x8*)(kb + d0 * 2048 + 512);
        if (d0 == 0) { p0 = MFMA32(b0, qr[0], c0); p1 = MFMA32(b1, qr[0], c1); }
        else { p0 = MFMA32(b0, qr[d0], p0); p1 = MFMA32(b1, qr[d0], p1); } }
}
__device__ __forceinline__ float rowmax(const f32x16& p0, const f32x16& p1) {
    float a = fmaxf(p0[0], p1[0]);
#pragma unroll
    for (int r = 1; r < 16; ++r) a = fmaxf(a, fmaxf(p0[r], p1[r]));
    auto rr = __builtin_amdgcn_permlane32_swap(__float_as_uint(a), __float_as_uint(a), false, false);
    return fmaxf(__uint_as_float(rr[0]), __uint_as_float(rr[1]));
}
__device__ __forceinline__ float halfsum(float a) {
    auto rr = __builtin_amdgcn_permlane32_swap(__float_as_uint(a), __float_as_uint(a), false, false);
    return __uint_as_float(rr[0]) + __uint_as_float(rr[1]);
}
__device__ __forceinline__ void softmax_pv(f32x16& p0, f32x16& p1, f32x16 (&o)[2], float& m_run, float& l_run, LAS float* wsf, ldsc Vslot, int lane, int r32, int hi) {
    const float rm = rowmax(p0, p1);
    const float mn = fmaxf(m_run, rm); const float alpha = fexp2(m_run - mn); m_run = mn;
    float s = 0.f;
#pragma unroll
    for (int r = 0; r < 16; ++r) { p0[r] = fexp2(p0[r] - mn); p1[r] = fexp2(p1[r] - mn); s += p0[r] + p1[r]; }
    l_run = l_run * alpha + s;
    if (hi == 0) wsf[r32] = alpha;
#pragma unroll
    for (int g = 0; g < 4; ++g) { const f32x4 a4 = *(LAS const f32x4*)(wsf + 8 * g + 4 * hi);
#pragma unroll
        for (int j = 0; j < 4; ++j) { o[0][4 * g + j] *= a4[j]; o[1][4 * g + j] *= a4[j]; } }
    bf16x8 pa[4];
    { v4u w;
      w.x = cvtpk(p0[0], p0[1]); w.y = cvtpk(p0[2], p0[3]); w.z = cvtpk(p0[4], p0[5]); w.w = cvtpk(p0[6], p0[7]); pa[0] = __builtin_bit_cast(bf16x8, w);
      w.x = cvtpk(p0[8], p0[9]); w.y = cvtpk(p0[10], p0[11]); w.z = cvtpk(p0[12], p0[13]); w.w = cvtpk(p0[14], p0[15]); pa[1] = __builtin_bit_cast(bf16x8, w);
      w.x = cvtpk(p1[0], p1[1]); w.y = cvtpk(p1[2], p1[3]); w.z = cvtpk(p1[4], p1[5]); w.w = cvtpk(p1[6], p1[7]); pa[2] = __builtin_bit_cast(bf16x8, w);
      w.x = cvtpk(p1[8], p1[9]); w.y = cvtpk(p1[10], p1[11]); w.z = cvtpk(p1[12], p1[13]); w.w = cvtpk(p1[14], p1[15]); pa[3] = __builtin_bit_cast(bf16x8, w); }
    ldsc vp = Vslot + ((lane >> 4) & 1) * 32 + (lane & 3) * 8 + (4 * hi + ((lane & 15) >> 2)) * 64;
#pragma unroll
    for (int d0 = 0; d0 < 2; ++d0)
#pragma unroll
        for (int ks = 0; ks < 4; ++ks) { const s16x4 lo = vtr(vp + d0 * 4096 + ks * 1024), hh = vtr(vp + d0 * 4096 + ks * 1024 + 512);
            const bf16x8 vb = (bf16x8){lo[0], lo[1], lo[2], lo[3], hh[0], hh[1], hh[2], hh[3]};
            o[d0] = MFMA32(pa[ks], vb, o[d0]); }
}
__device__ __forceinline__ v4u mul8(v4u a, v4u z) {
    v4u r; r.x = cvtpk(bflo(a.x) * bflo(z.x), bfhi(a.x) * bfhi(z.x)); r.y = cvtpk(bflo(a.y) * bflo(z.y), bfhi(a.y) * bfhi(z.y));
    r.z = cvtpk(bflo(a.z) * bflo(z.z), bfhi(a.z) * bfhi(z.z)); r.w = cvtpk(bflo(a.w) * bflo(z.w), bfhi(a.w) * bfhi(z.w)); return r;
}

struct Ctx {
    LAS unsigned char* lds;
    const bf16 *QA, *KA, *VA, *QB, *KB, *VB, *SZA, *SZB; bf16* G;
    const float *Fp, *Fs, *rel; const float *cak, *cav, *cbk, *cbv;
    const unsigned* knorm;
};

constexpr int PL_K = 0, PL_V = 24576, PL_F = 49152, PL_BT = 51200, PL_OST = 77824, SLOTB = 8192;
__device__ __forceinline__ void glds16(const void* gsrc, unsigned lds_dst) { unsigned keep;
    asm volatile("s_mov_b32 %0, m0\n\ts_mov_b32 m0, %2\n\ts_nop 0\n\tglobal_load_lds_dwordx4 %1, off\n\ts_mov_b32 m0, %0" : "=&s"(keep) : "v"(gsrc), "s"(lds_dst) : "memory"); }
__device__ __forceinline__ void glds4(const void* gsrc, unsigned lds_dst) { unsigned keep;
    asm volatile("s_mov_b32 %0, m0\n\ts_mov_b32 m0, %2\n\ts_nop 0\n\tglobal_load_lds_dword %1, off\n\ts_mov_b32 m0, %0" : "=&s"(keep) : "v"(gsrc), "s"(lds_dst) : "memory"); }
typedef LAS const char* lds_cptr;
__device__ __forceinline__ void kload8(bf16x8* kf, lds_cptr kp) {
    kf[0] = *(LAS const bf16x8*)(kp);        kf[1] = *(LAS const bf16x8*)(kp + 512);
    kf[2] = *(LAS const bf16x8*)(kp + 2048); kf[3] = *(LAS const bf16x8*)(kp + 2560);
    kf[4] = *(LAS const bf16x8*)(kp + 4096); kf[5] = *(LAS const bf16x8*)(kp + 4608);
    kf[6] = *(LAS const bf16x8*)(kp + 6144); kf[7] = *(LAS const bf16x8*)(kp + 6656);
}
__device__ __forceinline__ void kload2(bf16x8* kf, lds_cptr kp, int j) { kf[2 * j] = *(LAS const bf16x8*)(kp + j * 2048); kf[2 * j + 1] = *(LAS const bf16x8*)(kp + j * 2048 + 512); }
__device__ __forceinline__ s16x4 vtr2(lds_cptr p) { return __builtin_bit_cast(s16x4, __builtin_amdgcn_ds_read_tr16_b64_v4i16((LAS v4i16_t*)p)); }
#define SBAR() __builtin_amdgcn_sched_barrier(0)
#define PIN(x) asm volatile("" : "+v"(x))
#define WAITB(N) asm volatile("s_waitcnt vmcnt(" #N ") lgkmcnt(0)\n\ts_barrier" ::: "memory")

template <int KIND, int THRL>
__device__ __forceinline__ void prompt_unit(const Ctx& X, int b, int h, int qb) {
    const int tid = fresh_tid(), lane = tid & 63, r32 = lane & 31, hi = lane >> 5; const int wid = __builtin_amdgcn_readfirstlane(tid >> 6);
    LAS unsigned char* lds = X.lds;
    const bf16* Q = KIND ? X.QA : X.QB; const bf16* Kt = KIND ? X.KA : X.KB; const bf16* Vt = KIND ? X.VA : X.VB; const bf16* SZ = KIND ? X.SZA : X.SZB;
    const size_t rowbase = (size_t)b * SEQ; const int q0 = qb * 256;
    const bf16* Qw = Q + (rowbase + q0 + wid * 32) * 512 + h * 64;
    const unsigned lds0 = (unsigned)(uintptr_t)lds;
    LAS float* wsf = (LAS float*)(lds + WSF_OFF) + wid * 64;
    const float* Fbh = X.Fp + (size_t)(b * 8 + h) * SEQ;
    int j_lo; const int j_hi = 4 * qb + 3; float Fq0L = 0.f;
    if (KIND == 0) {
        const float kn = __uint_as_float(__hip_atomic_load(X.knorm + ((b * 8 + h) * 2), RLX_AGENT)) + __uint_as_float(__hip_atomic_load(X.knorm + ((b * 8 + h) * 2) + 1, RLX_AGENT));
        const float qn = __uint_as_float(__hip_atomic_load(X.knorm + 32 + ((b * 8 + h) * 2), RLX_AGENT)) + __uint_as_float(__hip_atomic_load(X.knorm + 32 + ((b * 8 + h) * 2) + 1, RLX_AGENT));
        const float thr = 2.0f * C2 * sqrtf(qn * kn) * 1.02f + 40.0f;
        const float Fq0 = Fbh[q0]; Fq0L = Fq0 * L2E;
        int cnt = 0, base = 4 * qb - 1;
        for (;;) {
            const int jb = base - lane; bool ok = false;
            if (jb >= 0) ok = (Fq0 - Fbh[64 * jb + 63]) * L2E >= -thr;
            const unsigned long long mk = __ballot(ok);
            const int c = (mk == ~0ull) ? 64 : __builtin_ctzll(~mk);
            cnt += c; if (c < 64) break; base -= 64; if (base < 0) break;
        }
        j_lo = 4 * qb - cnt; if (j_lo < 0) j_lo = 0;
        if (((j_hi - j_lo + 1) & 1) && j_lo > 0) --j_lo;
        j_lo = __builtin_amdgcn_readfirstlane(j_lo);
    } else {
        j_lo = 4 * qb - 8; if (j_lo < 0) j_lo = 0;
    }
    const int n = j_hi - j_lo + 1;
    int ta, tb;
    if (KIND == 0) { ta = 0; tb = n - 4 + (wid >> 1); }
    else { const int cw = 4 * qb + (wid >> 1); ta = cw - 8; if (ta < 0) ta = 0; ta -= j_lo; tb = cw - j_lo; }
    const bf16* Kh = Kt + (rowbase + (size_t)j_lo * 64) * 512 + h * 64; const bf16* Vh = Vt + (rowbase + (size_t)j_lo * 64) * 512 + h * 64;
    const float* Fj = Fbh + 64 * j_lo;
    const bf16* ksrc = Kh + (size_t)lane * 512 + wid * 8;
    const bf16* vsrc = Vh + (size_t)(16 * (wid & 3) + (lane >> 2)) * 512 + (wid >> 2) * 32 + (lane & 3) * 8;
    const unsigned kdst = lds0 + PL_K + wid * 1024, vdst = lds0 + PL_V + wid * 1024, fdst = lds0 + PL_F;
#define DMA_K(t, slot) glds16(ksrc + (size_t)(t) * 64 * 512, (unsigned)__builtin_amdgcn_readfirstlane(kdst + (slot)))
#define DMA_V(t, slot) glds16(vsrc + (size_t)(t) * 64 * 512, (unsigned)__builtin_amdgcn_readfirstlane(vdst + (slot)))
#define DMA_F(t) do { if (KIND == 0) glds4(Fj + 64 * (t) + lane, (unsigned)__builtin_amdgcn_readfirstlane(fdst + ((t) & 3) * 256)); } while (0)
    const lds_cptr shm3 = (lds_cptr)lds; const lds_cptr kp0 = shm3 + PL_K + hi * 1024 + r32 * 16;
    const lds_cptr vp0 = shm3 + PL_V + ((lane >> 4) & 1) * 32 + (lane & 3) * 8 + (4 * hi + ((lane & 15) >> 2)) * 64;
    LAS const float* BT = (LAS const float*)(lds + PL_BT);
    float c191 = 0.f;
    if (KIND == 1) {
        const float* relh = X.rel + h * NREL;
#pragma unroll
        for (int k = 0; k < 12; ++k) { const int e = tid + 512 * k, di = e >> 10, ln = (e >> 4) & 63, r = e & 15;
            int idx = (32 * di - 32) + (ln & 31) - crow(r, ln >> 5) + 63; idx = min(max(idx, 0), NREL - 1);
            ((LAS float*)(lds + PL_BT))[e] = relh[idx] * L2E; }
        c191 = relh[NREL - 1] * L2E;
    }
    DMA_K(0, 0); DMA_F(0); DMA_V(0, 0); DMA_K(1, SLOTB); DMA_F(1);
    bf16x8 qr[4];
#pragma unroll
    for (int d0 = 0; d0 < 4; ++d0) qr[d0] = *(const bf16x8*)(Qw + (size_t)r32 * 512 + d0 * 16 + hi * 8);
    DMA_K(2, 2 * SLOTB); DMA_F(2);
    float mhat = 0.f, l_reg = 0.f; f32x16 o[2]; o[0] = f32x16{}; o[1] = f32x16{};
    const int qrel = wid * 32 + r32;
    bool resc = false;
    f32x16 pA0, pA1, pB0, pB1; bf16x8 kf[8];
    s16x4 vlo[8], vhi[8]; v4u pw0, pw1, pw2, pw3;
    int sl_prev = 0, sl_cur = 0, sl_next = SLOTB;
#define ROT() do { sl_prev = sl_cur; sl_cur = sl_next; sl_next = (sl_next == 2 * SLOTB) ? 0 : sl_next + SLOTB; } while (0)
#define CINIT(C0, C1, t) do { \
        if (KIND == 0) { LAS const float* fb_ = (LAS const float*)(lds + PL_F + ((t) & 3) * 256); const float base_ = Fq0L - mhat; \
            _Pragma("unroll") for (int g_ = 0; g_ < 4; ++g_) { const f32x4 f0_ = *(LAS const f32x4*)(fb_ + 8 * g_ + 4 * hi), f1_ = *(LAS const f32x4*)(fb_ + 32 + 8 * g_ + 4 * hi); \
                _Pragma("unroll") for (int e_ = 0; e_ < 4; ++e_) { C0[4 * g_ + e_] = __builtin_fmaf(f0_[e_], -L2E, base_); C1[4 * g_ + e_] = __builtin_fmaf(f1_[e_], -L2E, base_); } } \
        } else { const int dl0_ = 32 * (wid & 1) + 64 * (tb - (t)); \
            if (dl0_ >= 160) { const float cc_ = c191 - mhat; _Pragma("unroll") for (int r_ = 0; r_ < 16; ++r_) C0[r_] = cc_; } \
            else { LAS const float* bp_ = BT + (((dl0_ + 32) >> 5) * 64 + lane) * 16; \
                _Pragma("unroll") for (int g_ = 0; g_ < 4; ++g_) { const f32x4 f0_ = *(LAS const f32x4*)(bp_ + 4 * g_); _Pragma("unroll") for (int e_ = 0; e_ < 4; ++e_) C0[4 * g_ + e_] = f0_[e_] - mhat; } } \
            if (dl0_ - 32 >= 160) { const float cc_ = c191 - mhat; _Pragma("unroll") for (int r_ = 0; r_ < 16; ++r_) C1[r_] = cc_; } \
            else { LAS const float* bp_ = BT + (((dl0_) >> 5) * 64 + lane) * 16; \
                _Pragma("unroll") for (int g_ = 0; g_ < 4; ++g_) { const f32x4 f1_ = *(LAS const f32x4*)(bp_ + 4 * g_); _Pragma("unroll") for (int e_ = 0; e_ < 4; ++e_) C1[4 * g_ + e_] = f1_[e_] - mhat; } } \
        } } while (0)
#define CMASK(P0, P1, t) do { if (KIND == 0) { const int jb_ = (t) - (n - 4); if (jb_ >= 0) { const int kb_ = 64 * jb_ + 4 * hi; \
        _Pragma("unroll") for (int r_ = 0; r_ < 16; ++r_) { const int kv_ = kb_ + (r_ & 3) + 8 * (r_ >> 2); if (kv_ > qrel) P0[r_] = -INFINITY; if (kv_ + 32 > qrel) P1[r_] = -INFINITY; } } } } while (0)
#define MX3(a, b, c) __builtin_fmaxf(__builtin_fmaxf((a), (b)), (c))
#define ROWMAX(C0, C1, rm) do { float a_ = MX3(C0[0], C0[1], C1[0]), b_ = MX3(C0[2], C0[3], C1[1]); a_ = MX3(a_, C1[2], C1[3]); \
        _Pragma("unroll") for (int r_ = 4; r_ < 16; r_ += 4) { a_ = MX3(a_, C0[r_], C0[r_ + 1]); b_ = MX3(b_, C0[r_ + 2], C0[r_ + 3]); a_ = MX3(a_, C1[r_], C1[r_ + 1]); b_ = MX3(b_, C1[r_ + 2], C1[r_ + 3]); } \
        rm = __builtin_fmaxf(a_, b_); { auto rr_ = __builtin_amdgcn_permlane32_swap(__float_as_uint(rm), __float_as_uint(rm), false, false); rm = __builtin_fmaxf(__uint_as_float(rr_[0]), __uint_as_float(rr_[1])); } } while (0)
#define FIRST(C0, C1, t) do { CINIT(C0, C1, t); \
        C0 = MFMA32(kf[0], qr[0], C0); C1 = MFMA32(kf[1], qr[0], C1); C0 = MFMA32(kf[2], qr[1], C0); C1 = MFMA32(kf[3], qr[1], C1); \
        C0 = MFMA32(kf[4], qr[2], C0); C1 = MFMA32(kf[5], qr[2], C1); C0 = MFMA32(kf[6], qr[3], C0); C1 = MFMA32(kf[7], qr[3], C1); \
        CMASK(C0, C1, t); float rm_; ROWMAX(C0, C1, rm_); mhat += rm_; \
        _Pragma("unroll") for (int r_ = 0; r_ < 16; ++r_) { C0[r_] = fexp2(C0[r_] - rm_); C1[r_] = fexp2(C1[r_] - rm_); } } while (0)
#define PKW(P, B) cvtpk(P[B], P[B + 1])
#define PAF(k) __builtin_bit_cast(bf16x8, pw##k)
#define VFR(i) (bf16x8){vlo[i][0], vlo[i][1], vlo[i][2], vlo[i][3], vhi[i][0], vhi[i][1], vhi[i][2], vhi[i][3]}
#define GAPA(MF, A0, A1, A2, A3, W0, W1, PW) do { MF; sacc += A0; sacc += A1; sacc += A2; sacc += A3; PIN(sacc); W0; W1; PIN(PW); SBAR(); } while (0)
#define GAPB(MF, Xv, B) do { MF; Xv[B] = fexp2(Xv[B]); Xv[B + 1] = fexp2(Xv[B + 1]); Xv[B + 2] = fexp2(Xv[B + 2]); Xv[B + 3] = fexp2(Xv[B + 3]); PIN(Xv); SBAR(); } while (0)
#define VRD(i) do { vlo[i] = vtr2(vp_ + (((i) >> 2) * 4096 + ((i) & 3) * 1024)); vhi[i] = vtr2(vp_ + (((i) >> 2) * 4096 + ((i) & 3) * 1024 + 512)); } while (0)
#define KRD(G, j) do { if (G) { kload2(kf, kp0 + sl_next, j); SBAR(); } } while (0)
#define DMA_SLOT(t) do { if ((t) + 3 < n) { DMA_K((t) + 3, sl_cur); DMA_F((t) + 3); } if ((t) + 1 < n) { DMA_V((t) + 1, sl_next); } } while (0)
#define STEP(C0, C1, P0, P1, t, GL) do { CINIT(C0, C1, t); SBAR(); \
        const lds_cptr vp_ = vp0 + sl_prev; \
        VRD(0); SBAR(); float sacc = (P0[0] + P0[1]); \
        GAPA(C0 = MFMA32(kf[0], qr[0], C0), P0[2], P0[3], P0[4], P0[5],     pw0[0] = PKW(P0, 0), pw0[1] = PKW(P0, 2), pw0); \
        VRD(4); SBAR(); GAPA(C1 = MFMA32(kf[1], qr[0], C1), P0[6], P0[7], P0[8], P0[9],     pw0[2] = PKW(P0, 4), pw0[3] = PKW(P0, 6), pw0); \
        VRD(1); SBAR(); GAPA(C0 = MFMA32(kf[2], qr[1], C0), P0[10], P0[11], P0[12], P0[13], pw1[0] = PKW(P0, 8), pw1[1] = PKW(P0, 10), pw1); \
        VRD(5); SBAR(); GAPA(C1 = MFMA32(kf[3], qr[1], C1), P0[14], P0[15], P1[0], P1[1],   pw1[2] = PKW(P0, 12), pw1[3] = PKW(P0, 14), pw1); \
        VRD(2); SBAR(); GAPA(C0 = MFMA32(kf[4], qr[2], C0), P1[2], P1[3], P1[4], P1[5],     pw2[0] = PKW(P1, 0), pw2[1] = PKW(P1, 2), pw2); \
        VRD(6); SBAR(); GAPA(C1 = MFMA32(kf[5], qr[2], C1), P1[6], P1[7], P1[8], P1[9],     pw2[2] = PKW(P1, 4), pw2[3] = PKW(P1, 6), pw2); \
        VRD(3); SBAR(); GAPA(C0 = MFMA32(kf[6], qr[3], C0), P1[10], P1[11], P1[12], P1[13], pw3[0] = PKW(P1, 8), pw3[1] = PKW(P1, 10), pw3); \
        VRD(7); SBAR(); GAPA(C1 = MFMA32(kf[7], qr[3], C1), P1[14], P1[15], 0.f, 0.f,       pw3[2] = PKW(P1, 12), pw3[3] = PKW(P1, 14), pw3); \
        l_reg += sacc; \
        DMA_SLOT(t); \
        CMASK(C0, C1, t); \
        { float rm; ROWMAX(C0, C1, rm); resc = false; \
          if (__builtin_expect(__any(rm > (float)THRL), 0)) { const float dl = __builtin_fmaxf(rm, 0.f); mhat += dl; \
            _Pragma("unroll") for (int r_ = 0; r_ < 16; ++r_) { C0[r_] -= dl; C1[r_] -= dl; } \
            const float f = fexp2(-dl); l_reg *= f; if (hi == 0) wsf[r32] = f; resc = true; } } \
        SBAR(); \
        GAPB(o[0] = MFMA32(PAF(0), VFR(0), o[0]), C0, 0); \
        GAPB(o[1] = MFMA32(PAF(0), VFR(4), o[1]), C0, 4); \
        KRD(GL, 0); GAPB(o[0] = MFMA32(PAF(1), VFR(1), o[0]), C0, 8); \
        KRD(GL, 1); GAPB(o[1] = MFMA32(PAF(1), VFR(5), o[1]), C0, 12); \
        KRD(GL, 2); GAPB(o[0] = MFMA32(PAF(2), VFR(2), o[0]), C1, 0); \
        KRD(GL, 3); GAPB(o[1] = MFMA32(PAF(2), VFR(6), o[1]), C1, 4); \
        GAPB(o[0] = MFMA32(PAF(3), VFR(3), o[0]), C1, 8); \
        GAPB(o[1] = MFMA32(PAF(3), VFR(7), o[1]), C1, 12); \
    } while (0)
#define DRAIN(P0, P1) do { float sacc = P0[0] + P0[1]; _Pragma("unroll") for (int r_ = 2; r_ < 16; ++r_) sacc += P0[r_]; _Pragma("unroll") for (int r_ = 0; r_ < 16; ++r_) sacc += P1[r_]; l_reg += sacc; \
        pw0 = (v4u){PKW(P0, 0), PKW(P0, 2), PKW(P0, 4), PKW(P0, 6)}; pw1 = (v4u){PKW(P0, 8), PKW(P0, 10), PKW(P0, 12), PKW(P0, 14)}; \
        pw2 = (v4u){PKW(P1, 0), PKW(P1, 2), PKW(P1, 4), PKW(P1, 6)}; pw3 = (v4u){PKW(P1, 8), PKW(P1, 10), PKW(P1, 12), PKW(P1, 14)}; \
        const lds_cptr vp_ = vp0 + sl_prev; \
        _Pragma("unroll") for (int i_ = 0; i_ < 8; ++i_) { vlo[i_] = vtr2(vp_ + ((i_ >> 2) * 4096 + (i_ & 3) * 1024)); vhi[i_] = vtr2(vp_ + ((i_ >> 2) * 4096 + (i_ & 3) * 1024 + 512)); } \
        o[0] = MFMA32(PAF(0), VFR(0), o[0]); o[1] = MFMA32(PAF(0), VFR(4), o[1]); o[0] = MFMA32(PAF(1), VFR(1), o[0]); o[1] = MFMA32(PAF(1), VFR(5), o[1]); \
        o[0] = MFMA32(PAF(2), VFR(2), o[0]); o[1] = MFMA32(PAF(2), VFR(6), o[1]); o[0] = MFMA32(PAF(3), VFR(3), o[0]); o[1] = MFMA32(PAF(3), VFR(7), o[1]); } while (0)
#define RESC() do { if (resc) { _Pragma("unroll") for (int g_ = 0; g_ < 4; ++g_) { const f32x4 a4_ = *(LAS const f32x4*)(wsf + 8 * g_ + 4 * hi); \
        _Pragma("unroll") for (int e_ = 0; e_ < 4; ++e_) { o[0][4 * g_ + e_] *= a4_[e_]; o[1][4 * g_ + e_] *= a4_[e_]; } } resc = false; } } while (0)
#define CLOSE(t) do { if ((t) + 3 < n) { if (KIND == 0) WAITB(3); else WAITB(2); } else if ((t) + 1 < n) { WAITB(1); } else { WAITB(0); } } while (0)
#define IDLE(t) do { DMA_SLOT(t); if ((t) + 1 >= ta && (t) + 1 <= tb) kload8(kf, kp0 + sl_next); CLOSE(t); ROT(); } while (0)

    if (KIND == 0) WAITB(4); else WAITB(2);
    if (ta == 0) { kload8(kf, kp0); FIRST(pA0, pA1, 0); }
    WAITB(0);
    DMA_K(3, 0); DMA_F(3); DMA_V(1, SLOTB);
    ROT();
    if (1 >= ta && 1 <= tb) kload8(kf, kp0 + sl_cur);
    if (KIND == 0) WAITB(3); else WAITB(2);
    int t = 1;
    if (ta > 0) {
        for (; t < ta; ++t) IDLE(t);
        DMA_SLOT(t); FIRST(pA0, pA1, t); if (t + 1 <= tb) kload8(kf, kp0 + sl_next); CLOSE(t); ROT(); ++t;
    }
    for (; t + 1 <= tb; t += 2) {
        STEP(pB0, pB1, pA0, pA1, t, true); CLOSE(t); RESC(); ROT();
        const bool gl2 = (t + 2 <= tb);
        STEP(pA0, pA1, pB0, pB1, t + 1, gl2); CLOSE(t + 1); RESC(); ROT();
    }
    if (t <= tb) { STEP(pB0, pB1, pA0, pA1, t, false); CLOSE(t); RESC(); ROT(); ++t;
        DMA_SLOT(t); DRAIN(pB0, pB1); CLOSE(t); ROT(); ++t; }
    else { DMA_SLOT(t); DRAIN(pA0, pA1); CLOSE(t); ROT(); ++t; }
    for (; t <= n; ++t) IDLE(t);
    { const float lt = halfsum(l_reg);
      if (hi == 0) wsf[32 + r32] = lt;
      float rli[16];
#pragma unroll
      for (int g = 0; g < 4; ++g) { const f32x4 a4 = *(LAS const f32x4*)(wsf + 32 + 8 * g + 4 * hi);
#pragma unroll
          for (int e = 0; e < 4; ++e) rli[4 * g + e] = __builtin_amdgcn_rcpf(a4[e]); }
      LAS bf16* stg = (LAS bf16*)(lds + PL_OST + wid * 4096);
#pragma unroll
      for (int r = 0; r < 16; ++r) { const int orow = crow(r, hi);
#pragma unroll
          for (int d0 = 0; d0 < 2; ++d0) stg[orow * 64 + d0 * 32 + r32] = (bf16)(cvtpk(o[d0][r] * rli[r], 0.f) & 0xffffu); }
      const size_t grow0 = rowbase + q0 + wid * 32;
#pragma unroll
      for (int i = 0; i < 4; ++i) { const int row = i * 8 + (lane >> 3), ch = lane & 7;
          const v4u v = *(LAS const v4u*)(stg + row * 64 + ch * 8);
          const v4u z = *(const v4u*)(SZ + (grow0 + row) * 512 + h * 64 + ch * 8);
          *(v4u*)(X.G + (grow0 + row) * 1024 + (KIND ? 0 : 512) + h * 64 + ch * 8) = mul8(v, z); } }
    asm volatile("s_waitcnt vmcnt(0) lgkmcnt(0)\n\ts_barrier" ::: "memory");
#undef DMA_K
#undef DMA_V
#undef DMA_F
#undef ROT
#undef CINIT
#undef CMASK
#undef MX3
#undef ROWMAX
#undef FIRST
#undef PKW
#undef PAF
#undef VFR
#undef GAPA
#undef GAPB
#undef VRD
#undef KRD
#undef DMA_SLOT
#undef STEP
#undef DRAIN
#undef RESC
#undef CLOSE
#undef IDLE
}

template <int KIND>
__device__ __forceinline__ void sample_unit(const Ctx& X, int bs, int h) {
    const int tid = fresh_tid(), lane = tid & 63, r32 = lane & 31, hi = lane >> 5; const int wid = __builtin_amdgcn_readfirstlane(tid >> 6);
    LAS unsigned char* lds = X.lds;
    const int ncache = KIND ? AKEEP : PAST, nct = ncache / 64, ntile = nct + 1;
    const float* Kc = (KIND ? X.cak : X.cbk) + ((size_t)bs * ncache * 8 + h) * 64;
    const float* Vc = (KIND ? X.cav : X.cbv) + ((size_t)bs * ncache * 8 + h) * 64;
    const bf16* Q = KIND ? X.QA : X.QB; const bf16* Kn = KIND ? X.KA : X.KB; const bf16* Vn = KIND ? X.VA : X.VB; const bf16* SZ = KIND ? X.SZA : X.SZB;
    const size_t nrow0 = (size_t)MP + 16 * bs;
    LAS float* wsf = (LAS float*)(lds + WSF_OFF) + wid * 64;
    LAS float* tb = (LAS float*)(lds + TB_OFF);
    if (KIND == 1) { if (tid < NREL) tb[tid] = X.rel[h * NREL + tid] * L2E; }
    __syncthreads();
    bf16x8 qr[4];
#pragma unroll
    for (int d0 = 0; d0 < 4; ++d0) qr[d0] = *(const bf16x8*)(Q + (nrow0 + (r32 & 15)) * 512 + h * 64 + d0 * 16 + hi * 8);
    const float* Fsr = X.Fs + (size_t)(bs * 8 + h) * FS_PITCH;
    const float Fref = (KIND == 0) ? Fsr[PAST - 1] : 0.f;
    LAS unsigned char* kslot = lds + wid * 16384; LAS unsigned char* vslot = kslot + 8192;
    float m_run = -1e30f, l_run = 0.f; f32x16 o[2]; o[0] = f32x16{}; o[1] = f32x16{};
    const int tq = r32 & 15;
    for (int t = wid; t < ntile; t += 8) {
        if (t < nct) {
            const float* kr = Kc + (size_t)(t * 64 + (lane >> 4)) * 512 + (lane & 15) * 4; const float* vr = Vc + (size_t)(t * 64 + (lane >> 4)) * 512 + (lane & 15) * 4;
            f32x4 kq[16], vq[16];
#pragma unroll
            for (int i = 0; i < 16; ++i) kq[i] = *(const f32x4*)(kr + (size_t)i * 4 * 512);
#pragma unroll
            for (int i = 0; i < 16; ++i) vq[i] = *(const f32x4*)(vr + (size_t)i * 4 * 512);
            LAS unsigned char* kw = kslot + ((lane & 15) >> 1) * 1024 + (lane >> 4) * 16 + (lane & 1) * 8;
            LAS unsigned char* vw = vslot + ((lane & 15) >> 3) * 4096 + (lane >> 4) * 64 + (lane & 7) * 8;
#pragma unroll
            for (int i = 0; i < 16; ++i) { v2u w; w.x = cvtpk(kq[i][0], kq[i][1]); w.y = cvtpk(kq[i][2], kq[i][3]); *(LAS v2u*)(kw + i * 64) = w; }
#pragma unroll
            for (int i = 0; i < 16; ++i) { v2u w; w.x = cvtpk(vq[i][0], vq[i][1]); w.y = cvtpk(vq[i][2], vq[i][3]); *(LAS v2u*)(vw + i * 256) = w; }
        } else {
#pragma unroll
            for (int c = 0; c < 8; ++c) { v4u wk = (v4u){0u, 0u, 0u, 0u}, wv = wk;
                if (lane < 16) { wk = *(const v4u*)(Kn + (nrow0 + lane) * 512 + h * 64 + c * 8); wv = *(const v4u*)(Vn + (nrow0 + lane) * 512 + h * 64 + c * 8); }
                *(LAS v4u*)(kslot + c * 1024 + lane * 16) = wk;
                *(LAS v4u*)(vslot + (c >> 2) * 4096 + lane * 64 + (c & 3) * 16) = wv; }
        }
        f32x16 c0, c1, p0, p1;
        if (KIND == 0) {
            const float* fb = Fsr + t * 64;
#pragma unroll
            for (int g = 0; g < 4; ++g) { const f32x4 f0 = *(const f32x4*)(fb + 8 * g + 4 * hi), f1 = *(const f32x4*)(fb + 32 + 8 * g + 4 * hi);
#pragma unroll
                for (int e = 0; e < 4; ++e) { c0[4 * g + e] = (Fref - f0[e]) * L2E; c1[4 * g + e] = (Fref - f1[e]) * L2E; } }
        } else { c0 = f32x16{}; c1 = f32x16{}; }
        qkt(p0, p1, (ldsc)kslot, qr, c0, c1, r32, hi);
        if (KIND == 1) {
            const int dist0 = ncache + tq - (64 * t + 4 * hi) + 63;
#pragma unroll
            for (int r = 0; r < 16; ++r) { const int i0 = dist0 - ((r & 3) + 8 * (r >> 2));
                const int a0 = min(max(i0, 0), NREL - 1), a1 = min(max(i0 - 32, 0), NREL - 1);
                p0[r] += tb[a0]; p1[r] += tb[a1]; }
        }
        if (t == nct) {
#pragma unroll
            for (int r = 0; r < 16; ++r) { const int kv = 4 * hi + (r & 3) + 8 * (r >> 2);
                const bool ok = (kv < 16) && (KIND == 1 || kv <= tq);
                if (!ok) p0[r] = -1e30f; p1[r] = -1e30f; }
        }
        softmax_pv(p0, p1, o, m_run, l_run, wsf, (ldsc)vslot, lane, r32, hi);
    }
    const float lt = halfsum(l_run);
    __syncthreads();
    LAS float* OP = (LAS float*)lds;
    LAS float* ML = (LAS float*)(lds + 32768);
    if (lane < 16) { ML[(wid * 16 + lane) * 2] = m_run; ML[(wid * 16 + lane) * 2 + 1] = lt; }
#pragma unroll
    for (int r = 0; r < 8; ++r) { const int q = crow(r, hi);
#pragma unroll
        for (int d0 = 0; d0 < 2; ++d0) OP[(wid * 16 + q) * 64 + d0 * 32 + r32] = o[d0][r]; }
    __syncthreads();
    { const int q = tid >> 5, d = (tid & 31) * 2;
      float M = -1e30f;
#pragma unroll
      for (int w = 0; w < 8; ++w) M = fmaxf(M, ML[(w * 16 + q) * 2]);
      float L = 0.f, a0 = 0.f, a1 = 0.f;
#pragma unroll
      for (int w = 0; w < 8; ++w) { const float f = fexp2(ML[(w * 16 + q) * 2] - M); L += ML[(w * 16 + q) * 2 + 1] * f;
          const f32x2 ov = *(LAS const f32x2*)(OP + (w * 16 + q) * 64 + d); a0 += ov[0] * f; a1 += ov[1] * f; }
      const float rl = 1.0f / L;
      const unsigned z = *(const unsigned*)(SZ + (nrow0 + q) * 512 + h * 64 + d);
      *(unsigned*)(X.G + (nrow0 + q) * 1024 + (KIND ? 0 : 512) + h * 64 + d) = cvtpk(a0 * rl * bflo(z), a1 * rl * bfhi(z)); }
    __syncthreads();
}
}


__device__ __forceinline__ f32x16 mini_tile(const bf16* Xrow0, const bf16* Wrow0, int k0, int ksteps, f32x16 acc, int r32, int hi) {
    const bf16* ap = Wrow0 + (size_t)r32 * DM + k0 + hi * 8;
    const bf16* bp = Xrow0 + (size_t)r32 * DM + k0 + hi * 8;
#pragma unroll 8
    for (int s = 0; s < ksteps; ++s) { const bf16x8 a = *(const bf16x8*)(ap + 16 * s); const bf16x8 b = *(const bf16x8*)(bp + 16 * s);
        acc = __builtin_amdgcn_mfma_f32_32x32x16_bf16(a, b, acc, 0, 0, 0); }
    return acc;
}
__device__ __forceinline__ void mini_slice_to_lds(const bf16* Xrow0, const bf16* Wrow0, LAS float* part, int slot, int wave, int lane) {
    const int r32 = lane & 31, hi = lane >> 5;
    const bf16* ap = Wrow0 + (size_t)r32 * DM + wave * 128 + hi * 8;
    const bf16* bp = Xrow0 + (size_t)r32 * DM + wave * 128 + hi * 8;
    bf16x8 a[8], b[8];
#pragma unroll
    for (int s = 0; s < 8; ++s) { a[s] = *(const bf16x8*)(ap + 16 * s); b[s] = *(const bf16x8*)(bp + 16 * s); }
    f32x16 acc = f32x16{};
#pragma unroll
    for (int s = 0; s < 8; ++s) acc = __builtin_amdgcn_mfma_f32_32x32x16_bf16(a[s], b[s], acc, 0, 0, 0);
    LAS f32x4* p = (LAS f32x4*)(part + (size_t)slot * 1024 + lane * 16);
#pragma unroll
    for (int g = 0; g < 4; ++g) p[g] = (f32x4){acc[4 * g], acc[4 * g + 1], acc[4 * g + 2], acc[4 * g + 3]};
}
__device__ __forceinline__ f32x16 mini_reduce(LAS const float* part, int NT, int i, int w0, int w1, int lane) {
    f32x16 acc = f32x16{};
    for (int w = w0; w < w1; ++w) { LAS const f32x4* p = (LAS const f32x4*)(part + (size_t)(w * NT + i) * 1024 + lane * 16);
#pragma unroll
        for (int g = 0; g < 4; ++g) { const f32x4 v = p[g]; acc[4 * g] += v[0]; acc[4 * g + 1] += v[1]; acc[4 * g + 2] += v[2]; acc[4 * g + 3] += v[3]; } }
    return acc;
}
struct SampleInProj { bf16 *QA, *KA, *VA, *SZA, *QB, *KB, *VB, *SZB, *SMA, *SMB; float* out; };
__device__ __forceinline__ void sample_inproj_store(const SampleInProj& E, const f32x16& acc, int m0, int n0, int r32, int hi) {
    const int pn = n0 >> 8; bf16* dst; int ldd, cbase, actk; float* f32p = nullptr; int fmode = 0;
    if (pn < 16) { const int seg = pn >> 1; ldd = 512; cbase = seg * 512;
        if (seg == 0) { dst = E.QA; actk = 1; } else if (seg == 1) { dst = E.KA; actk = 0; } else if (seg == 2) { dst = E.VA; actk = 0; } else if (seg == 3) { dst = E.SZA; actk = 2; }
        else if (seg == 4) { dst = E.QB; actk = 1; } else if (seg == 5) { dst = E.KB; actk = 0; } else if (seg == 6) { dst = E.VB; actk = 0; } else { dst = E.SZB; actk = 2; }
        if (seg == 1 || seg == 2) { f32p = E.out + (seg == 1 ? O_AKS : O_AVS); fmode = 2; }
        else if (seg == 5 || seg == 6) { f32p = E.out + (seg == 5 ? O_BKS : O_BVS); fmode = 1; }
    } else { ldd = 1024; actk = 3; if (pn < 20) { dst = E.SMA; cbase = 4096; } else { dst = E.SMB; cbase = 5120; } }
    const int rl = m0 + r32; const size_t grow = (size_t)MP + rl;
    const size_t ro = (fmode == 1) ? (size_t)rl * 512 : ((size_t)((rl >> 4) * 512 + 496 + (rl & 15))) * 512;
#pragma unroll
    for (int g = 0; g < 4; ++g) { const int col = n0 + 8 * g + 4 * hi - cbase;
        f32x4 v = {acc[4 * g], acc[4 * g + 1], acc[4 * g + 2], acc[4 * g + 3]};
        if (f32p != nullptr) *(f32x4*)(f32p + ro + col) = v;
        if (actk == 1) v = v * C2;
        else if (actk == 2) {
#pragma unroll
            for (int e = 0; e < 4; ++e) v[e] = v[e] * sigmoidf_(v[e]); }
        else if (actk == 3) {
#pragma unroll
            for (int e = 0; e < 4; ++e) v[e] = sigmoidf_(v[e]); }
        v2u w; w.x = cvtpk(v[0], v[1]); w.y = cvtpk(v[2], v[3]);
        *(v2u*)(dst + grow * ldd + col) = w; }
}

#ifndef REP_FP
#define REP_FP 1
#endif
#ifndef REP_BP
#define REP_BP 1
#endif
#ifndef REP_S
#define REP_S 1
#endif
#ifndef REP_P0
#define REP_P0 1
#endif
#ifndef REP_P1
#define REP_P1 1
#endif
#ifndef REP_P2
#define REP_P2 1
#endif
#ifndef REP_P3A
#define REP_P3A 1
#endif
#ifndef REP_P3B
#define REP_P3B 1
#endif
#ifndef REP_P4
#define REP_P4 1
#endif
__global__ void __launch_bounds__(512, 2) fwd_kernel(Args args) {
    extern __shared__ __attribute__((aligned(16))) unsigned char lds_raw[];
    LAS unsigned char* lds = (LAS unsigned char*)lds_raw;
    const int G = gridDim.x; const int bx = blockIdx.x; const int vcu = (G % 8 == 0) ? (bx % 8) * (G / 8) + bx / 8 : bx;
    unsigned char* ws = args.ws; float* out = args.out;
    gu32* ctl = (gu32*)(ws + WS_CTL);
    const float* x_p = args.in[0]; const float* x_s = args.in[1];
    const float *cak = args.in[2], *cav = args.in[3], *cbk = args.in[4], *cbv = args.in[5], *cbl = args.in[6];
    const float *g_pre = args.in[7], *w_in = args.in[8], *b_f = args.in[9], *rel = args.in[10], *w_bra = args.in[11], *w_brb = args.in[12], *w_out = args.in[13], *g_post = args.in[14];
    float* Fp = (float*)(ws + WS_FP); float* LFp = (float*)(ws + WS_LFP); float* Fs = (float*)(ws + WS_FS); float* LFn = (float*)(ws + WS_LFN);
    bf16* WIN = (bf16*)(ws + WS_WIN); bf16* WBR = (bf16*)(ws + WS_WBR); bf16* WOUT = (bf16*)(ws + WS_WOUT);
    bf16* XN = (bf16*)(ws + WS_XN);
    bf16 *QA = (bf16*)(ws + WS_QA), *KA = (bf16*)(ws + WS_KA), *VA = (bf16*)(ws + WS_VA), *QB = (bf16*)(ws + WS_QB), *KB = (bf16*)(ws + WS_KB), *VB = (bf16*)(ws + WS_VB);
    bf16 *SZA = (bf16*)(ws + WS_SZA), *SZB = (bf16*)(ws + WS_SZB), *SMA = (bf16*)(ws + WS_SMA), *SMB = (bf16*)(ws + WS_SMB);
    bf16* MG = (bf16*)(ws + WS_MG); bf16* OUTB = (bf16*)(ws + WS_OUTF);

    for (int u = threadIdx.x; u < (LDS_BYTES - LDSCTL_OFF) / 4; u += 512) ((LAS unsigned*)(lds + LDSCTL_OFF))[u] = 0u;
    __syncthreads();
    volatile LAS unsigned* MISC = (volatile LAS unsigned*)(lds + MISC_OFF);
    XcdBarrier bar = xcd_barrier_post((unsigned*)(ctl + CW_BAR), MISC + 8);
    const int NGW = G * 8;

#pragma nounroll
    for (int rep = 0; rep < REP_P0; ++rep) {
        const int tid = fresh_tid(), lane = tid & 63; const int wave = __builtin_amdgcn_readfirstlane(tid >> 6); const int gw = vcu * 8 + wave;
        LAS float* wfT = (LAS float*)(lds + 73728);
        for (int k = tid; k < DM; k += 512) { const f32x4 a = *(const f32x4*)(w_in + (size_t)k * NIN + 4096), b = *(const f32x4*)(w_in + (size_t)k * NIN + 4100);
            wfT[0 * DM + k] = a[0]; wfT[1 * DM + k] = a[1]; wfT[2 * DM + k] = a[2]; wfT[3 * DM + k] = a[3];
            wfT[4 * DM + k] = b[0]; wfT[5 * DM + k] = b[1]; wfT[6 * DM + k] = b[2]; wfT[7 * DM + k] = b[3]; }
        __syncthreads();
        LAS float* scr = (LAS float*)(lds + wave * 8704);
        constexpr int I_IN = 16 * 192, I_BR = 8 * 32, I_OUT = 16 * 32, NITEMS = I_IN + 2 * I_BR + I_OUT;
        for (int it = gw; it < NITEMS; it += NGW) {
            int r = it;
            if (r < I_IN) { const int kb = r / 192, nb = r % 192, n0 = 32 * nb; p0_transpose_item(w_in, NIN, n0 + (n0 >= 4096 ? 8 : 0), WIN, DM, 0, n0, scr, 64 * kb, lane); continue; } r -= I_IN;
            if (r < I_BR) { const int kb = r / 32, nb = r % 32; p0_transpose_item(w_bra, DM, 32 * nb, WBR, DM, 0, 32 * nb, scr, 64 * kb, lane); continue; } r -= I_BR;
            if (r < I_BR) { const int kb = r / 32, nb = r % 32; p0_transpose_item(w_brb, DM, 32 * nb, WBR, DM, 512, 32 * nb, scr, 64 * kb, lane); continue; } r -= I_BR;
            { const int kb = r / 32, nb = r % 32; p0_transpose_item(w_out, DM, 32 * nb, WOUT, DM, 0, 32 * nb, scr, 64 * kb, lane); }
        }
        f32x4 gv[4];
#pragma unroll
        for (int j = 0; j < 4; ++j) gv[j] = *((const f32x4*)g_pre + lane + 64 * j);
        f32x4 nv[4];
        { const float* xr0 = (gw < MP) ? x_p + (size_t)gw * DM : x_s + (size_t)(gw - MP) * DM;
#pragma unroll
          for (int j = 0; j < 4; ++j) nv[j] = *((const f32x4*)xr0 + lane + 64 * j); }
        for (int m = gw; m < MP + MS; m += NGW) {
            GAS unsigned long long* o8 = (GAS unsigned long long*)(XN + (size_t)m * DM) + lane;
            f32x4 v[4]; float ss = 0.f;
#pragma unroll
            for (int j = 0; j < 4; ++j) v[j] = nv[j];
            { const int mn = m + NGW;
              if (mn < MP + MS) { const float* xrn = (mn < MP) ? x_p + (size_t)mn * DM : x_s + (size_t)(mn - MP) * DM;
#pragma unroll
                  for (int j = 0; j < 4; ++j) nv[j] = *((const f32x4*)xrn + lane + 64 * j); } }
#pragma unroll
            for (int j = 0; j < 4; ++j) ss += (v[j][0] * v[j][0] + v[j][1] * v[j][1]) + (v[j][2] * v[j][2] + v[j][3] * v[j][3]);
            float dt[8];
#pragma unroll
            for (int hh = 0; hh < 8; ++hh) dt[hh] = 0.f;
#pragma unroll
            for (int j = 0; j < 4; ++j) { v[j] = v[j] * gv[j];
#pragma unroll
                for (int hh = 0; hh < 8; ++hh) { const f32x4 w = *(LAS const f32x4*)(wfT + hh * DM + 256 * j + 4 * lane);
                    dt[hh] += (v[j][0] * w[0] + v[j][1] * w[1]) + (v[j][2] * w[2] + v[j][3] * w[3]); } }
            ss = wave_sum(ss);
            const float rs = 1.0f / sqrtf(ss * (1.0f / DM) + EPS);
            {
                const bool u5 = (lane & 32) != 0, u4 = (lane & 16) != 0, u3 = (lane & 8) != 0;
#pragma unroll
                for (int i = 0; i < 4; ++i) { const float snd = u5 ? dt[i] : dt[i + 4], kp = u5 ? dt[i + 4] : dt[i]; dt[i] = kp + __shfl_xor(snd, 32); }
#pragma unroll
                for (int i = 0; i < 2; ++i) { const float snd = u4 ? dt[i] : dt[i + 2], kp = u4 ? dt[i + 2] : dt[i]; dt[i] = kp + __shfl_xor(snd, 16); }
                { const float snd = u3 ? dt[0] : dt[1], kp = u3 ? dt[1] : dt[0]; dt[0] = kp + __shfl_xor(snd, 8); }
                dt[0] += __shfl_xor(dt[0], 1); dt[0] += __shfl_xor(dt[0], 2); dt[0] += __shfl_xor(dt[0], 4);
            }
            if ((lane & 7) == 0) {
                const int hh = lane >> 3;
                const float val = dt[0] * rs + b_f[hh];
                const float lf = (val >= 0.f) ? -log1pf(expf(-val)) : (val - log1pf(expf(val)));
                if (m < MP) { out[O_BLP + (size_t)m * 8 + hh] = lf; LFp[(size_t)((m >> 14) * 8 + hh) * SEQ + (m & (SEQ - 1))] = lf; }
                else { const int ms = m - MP; out[O_BLS + (size_t)ms * 8 + hh] = lf; LFn[((ms >> 4) * 8 + hh) * 16 + (ms & 15)] = lf; }
            }
#pragma unroll
            for (int j = 0; j < 4; ++j) o8[64 * j] = (unsigned long long)cvtpk(v[j][0] * rs, v[j][1] * rs) | ((unsigned long long)cvtpk(v[j][2] * rs, v[j][3] * rs) << 32);
        }
        { const int gt = vcu * 512 + tid, NT = G * 512; constexpr int PER = 496 * 128;
          for (int i = gt; i < 2 * 8 * PER; i += NT) { const int ten = i / (8 * PER), r = i - ten * 8 * PER, bb = r / PER, off = r - bb * PER;
              const f32x4* src = (const f32x4*)(ten ? cav : cak) + (size_t)bb * 65536 + 2048 + off;
              f32x4* dst = (f32x4*)(out + (ten ? O_AVS : O_AKS)) + (size_t)bb * 65536 + off; *dst = *src; } }
    }
    xcd_barrier(bar);

    if (vcu < 24) {
        const int tid = fresh_tid(), lane = tid & 63; const int wave = __builtin_amdgcn_readfirstlane(tid >> 6);
        LAS float* wtot = (LAS float*)(lds + QMX_OFF);
        if (vcu < 16) {
            const float* in = LFp + (size_t)vcu * SEQ + wave * 2048 + lane * 32; float* o = Fp + (size_t)vcu * SEQ + wave * 2048 + lane * 32;
            f32x4 v[8];
#pragma unroll
            for (int i = 0; i < 8; ++i) v[i] = *((const f32x4*)in + i);
            float run = 0.f;
#pragma unroll
            for (int i = 0; i < 8; ++i) { v[i][0] += run; v[i][1] += v[i][0]; v[i][2] += v[i][1]; v[i][3] += v[i][2]; run = v[i][3]; }
            float inc = run;
#pragma unroll
            for (int ofs = 1; ofs < 64; ofs <<= 1) { const float t = __shfl_up(inc, ofs); if (lane >= ofs) inc += t; }
            if (lane == 63) wtot[wave] = inc;
            __syncthreads();
            float carry = inc - run;
#pragma unroll
            for (int w = 0; w < 8; ++w) if (w < wave) carry += wtot[w];
#pragma unroll
            for (int i = 0; i < 8; ++i) { v[i] = v[i] + carry; *((f32x4*)o + i) = v[i]; }
        } else {
            const int sidx = (vcu - 16) * 8 + wave, bs = vcu - 16, hh = wave;
            const float* in = cbl + ((size_t)bs * PAST + 64 * lane) * 8 + hh; float* o = Fs + (size_t)sidx * FS_PITCH + 64 * lane;
            float v[64];
#pragma unroll
            for (int i = 0; i < 64; ++i) v[i] = in[i * 8];
            float run = 0.f;
#pragma unroll
            for (int i = 0; i < 64; ++i) { run += v[i]; v[i] = run; }
            float inc = run;
#pragma unroll
            for (int ofs = 1; ofs < 64; ofs <<= 1) { const float t = __shfl_up(inc, ofs); if (lane >= ofs) inc += t; }
            const float carry = inc - run;
#pragma unroll
            for (int i = 0; i < 16; ++i) { f32x4 q4 = {v[4 * i] + carry, v[4 * i + 1] + carry, v[4 * i + 2] + carry, v[4 * i + 3] + carry}; *((f32x4*)o + i) = q4; }
            const float last = __shfl(inc, 63);
            if (lane == 0) { float r2 = last; float* on = Fs + (size_t)sidx * FS_PITCH + PAST;
                for (int i = 0; i < 16; ++i) { r2 += LFn[sidx * 16 + i]; on[i] = r2; }
                for (int i = 16; i < 64; ++i) on[i] = r2; }
            __syncthreads();
        }
    }
#pragma nounroll
    for (int rep = 0; rep < REP_P1; ++rep) {
        if (rep) xcd_barrier(bar);
        if (rep == 0) {
            const int tid = fresh_tid(), lane = tid & 63; const int wave = __builtin_amdgcn_readfirstlane(tid >> 6);
            LAS float* part = (LAS float*)lds;
#pragma unroll
            for (int i = 0; i < 3; ++i) { const int task = vcu * 3 + i; if (task < 768) { const int mb = task & 3, nb = task >> 2;
                mini_slice_to_lds(XN + (size_t)(MP + 32 * mb) * DM, WIN + (size_t)(32 * nb) * DM, part, wave * 3 + i, wave, lane); } }
            __syncthreads();
            if (wave < 3) { const int task = vcu * 3 + wave; if (task < 768) { const int mb = task & 3, nb = task >> 2;
                const f32x16 acc = mini_reduce(part, 3, wave, 0, 8, lane);
                SampleInProj SE{QA, KA, VA, SZA, QB, KB, VB, SZB, SMA, SMB, out};
                sample_inproj_store(SE, acc, 32 * mb, 32 * nb, lane & 31, lane >> 5); } }
            __syncthreads();
        }
        pg8::Gemm g{XN, WIN, DM, DM / 64}; pg8::StaticOrder S; S.init(MP, NG, G, bx, 1);
        pg8::EpiInProj E{QA, KA, VA, SZA, QB, KB, VB, SZB, SMA, SMB, out, (unsigned*)(ctl + CW_KNORM)};
        pg8::gemm_phase<pg8::EpiInProj, pg8::StaticOrder>(lds, g, S, E);
    }
    xcd_barrier(bar);

#pragma nounroll
    for (int rep = 0; rep < REP_P2; ++rep) {
        if (rep) xcd_barrier(bar);
        att::Ctx X; X.lds = lds; X.QA = QA; X.KA = KA; X.VA = VA; X.QB = QB; X.KB = KB; X.VB = VB; X.SZA = SZA; X.SZB = SZB; X.G = XN;
        X.Fp = Fp; X.Fs = Fs; X.rel = rel; X.cak = cak; X.cav = cav; X.cbk = cbk; X.cbv = cbv; X.knorm = (const unsigned*)(ctl + CW_KNORM);
        constexpr int NU = 64 + 1024 + 1024 + 64;
        gu32* qctr = ctl + CW_QUEUE + rep * 64;
        volatile LAS unsigned* qw = (volatile LAS unsigned*)(lds + MISC_OFF) + 16;
        if (threadIdx.x == 0) qw[0] = __hip_atomic_fetch_add(qctr, 1u, RLX_AGENT);
        __syncthreads();
        for (;;) {
            const int u = (int)__builtin_amdgcn_readfirstlane(qw[0]);
            if (u >= NU) break;
            unsigned nxt = 0u;
            if (threadIdx.x == 0) nxt = __hip_atomic_fetch_add(qctr, 1u, RLX_AGENT);

            if (u < 64) { for (int r2 = 0; r2 < REP_S; ++r2) att::sample_unit<0>(X, u >> 3, u & 7); }
            else if (u < 64 + 2048) { const int kind = (u - 64) >> 10, idx = (u - 64) & 1023;
                const int hh = ((idx & 7) + (idx >> 8)) & 7, bb = (idx >> 3) & 1, qb = 63 - (idx >> 4);
                if (kind == 0) { for (int r2 = 0; r2 < REP_FP; ++r2) att::prompt_unit<0, 8>(X, bb, hh, qb); } else { for (int r2 = 0; r2 < REP_BP; ++r2) att::prompt_unit<1, 8>(X, bb, hh, qb); } }
            else { const int i2 = u - 64 - 2048; for (int r2 = 0; r2 < REP_S; ++r2) att::sample_unit<1>(X, i2 >> 3, i2 & 7); }
            if (threadIdx.x == 0) qw[0] = nxt;
            __syncthreads();
        }
    }
    xcd_barrier(bar);

#pragma nounroll
    for (int rep = 0; rep < REP_P3A; ++rep) {
        if (rep) xcd_barrier(bar);
        if (rep == 0 && vcu < 128) {
            const int tid = fresh_tid(), lane = tid & 63, r32 = lane & 31, hi = lane >> 5; const int wave = __builtin_amdgcn_readfirstlane(tid >> 6);
            const int mb = vcu & 3, nb = vcu >> 2;
            LAS float* part = (LAS float*)lds;
            mini_slice_to_lds(XN + (size_t)(MP + 32 * mb) * DM, WBR + (size_t)(32 * nb) * DM, part, wave, wave, lane);
            __syncthreads();
            if (wave == 0) {
                const f32x16 a1 = mini_reduce(part, 1, 0, 0, 4, lane), a2 = mini_reduce(part, 1, 0, 4, 8, lane);
                const size_t grow = (size_t)MP + 32 * mb + r32;
#pragma unroll
                for (int g4 = 0; g4 < 4; ++g4) { const int col = 32 * nb + 8 * g4 + 4 * hi;
                    const v2u sa = *(const v2u*)(SMA + grow * 1024 + col), sb = *(const v2u*)(SMB + grow * 1024 + col);
                    v2u w; w.x = cvtpk(bflo(sa.x) * a1[4 * g4] + bflo(sb.x) * a2[4 * g4], bfhi(sa.x) * a1[4 * g4 + 1] + bfhi(sb.x) * a2[4 * g4 + 1]);
                    w.y = cvtpk(bflo(sa.y) * a1[4 * g4 + 2] + bflo(sb.y) * a2[4 * g4 + 2], bfhi(sa.y) * a1[4 * g4 + 3] + bfhi(sb.y) * a2[4 * g4 + 3]);
                    *(v2u*)(MG + grow * 1024 + col) = w; }
            }
            __syncthreads();
        }
        pg8::Gemm g{XN, WBR, DM, 8}; pg8::StaticOrder S; S.init(MP, DM, G, bx, 2);
        pg8::EpiMerge E{SMA, SMB, MG};
        pg8::gemm_phase<pg8::EpiMerge, pg8::StaticOrder>(lds, g, S, E);
    }
    xcd_barrier(bar);
#pragma nounroll
    for (int rep = 0; rep < REP_P3B; ++rep) {
        if (rep) xcd_barrier(bar);
        if (rep == 0 && vcu < 128) {
            const int tid = fresh_tid(), lane = tid & 63, r32 = lane & 31, hi = lane >> 5; const int wave = __builtin_amdgcn_readfirstlane(tid >> 6);
            const int mb = vcu & 3, nb = vcu >> 2;
            LAS float* part = (LAS float*)lds;
            mini_slice_to_lds(MG + (size_t)(MP + 32 * mb) * DM, WOUT + (size_t)(32 * nb) * DM, part, wave, wave, lane);
            __syncthreads();
            if (wave == 0) {
                const f32x16 a1 = mini_reduce(part, 1, 0, 0, 8, lane);
                const size_t grow = (size_t)MP + 32 * mb + r32;
#pragma unroll
                for (int g4 = 0; g4 < 4; ++g4) { v2u w; w.x = cvtpk(a1[4 * g4], a1[4 * g4 + 1]); w.y = cvtpk(a1[4 * g4 + 2], a1[4 * g4 + 3]); *(v2u*)(OUTB + grow * 1024 + 32 * nb + 8 * g4 + 4 * hi) = w; }
            }
            __syncthreads();
        }
        pg8::Gemm g{MG, WOUT, DM, DM / 64}; pg8::StaticOrder S; S.init(MP, DM, G, bx, 1);
        pg8::EpiBf16Out E{OUTB, DM};
        pg8::gemm_phase<pg8::EpiBf16Out, pg8::StaticOrder>(lds, g, S, E);
    }
    xcd_barrier(bar);
#pragma nounroll
    for (int rep = 0; rep < REP_P4; ++rep) {
        const int tid = fresh_tid(), lane = tid & 63; const int wave = __builtin_amdgcn_readfirstlane(tid >> 6); const int gw = vcu * 8 + wave;
        f32x4 gv[4];
#pragma unroll
        for (int j = 0; j < 4; ++j) gv[j] = *((const f32x4*)g_post + lane + 64 * j);
        for (int m = gw; m < MP + MS; m += NGW) {
            const float* xrow = (m < MP) ? x_p + (size_t)m * DM : x_s + (size_t)(m - MP) * DM;
            float* yrow = (m < MP) ? out + O_YP + (size_t)m * DM : out + O_YS + (size_t)(m - MP) * DM;
            const bf16* orow = OUTB + (size_t)m * DM;
            f32x4 v[4], xv[4]; float ss = 0.f;
#pragma unroll
            for (int j = 0; j < 4; ++j) { const v2u ob = *((const v2u*)orow + lane + 64 * j); v[j] = (f32x4){bflo(ob.x), bfhi(ob.x), bflo(ob.y), bfhi(ob.y)}; xv[j] = *((const f32x4*)xrow + lane + 64 * j);
                ss += (v[j][0] * v[j][0] + v[j][1] * v[j][1]) + (v[j][2] * v[j][2] + v[j][3] * v[j][3]); }
            ss = wave_sum(ss);
            const float rs = 1.0f / sqrtf(ss * (1.0f / DM) + EPS);
#pragma unroll
            for (int j = 0; j < 4; ++j) *((f32x4*)yrow + lane + 64 * j) = xv[j] + v[j] * rs * gv[j];
        }
    }
}

extern "C" void kernel_launch(void* const* d_in, const int* in_sizes, int n_in, void* d_out, int out_size, void* d_ws, size_t ws_size, hipStream_t stream) {
    static int grid = 0;
    if (grid == 0) {
        if (n_in != 15 || in_sizes[0] != MP * DM || (size_t)out_size != O_END || ws_size < WS_END) {
            fprintf(stderr, "kernel_launch: unexpected shapes: n_in %d in0 %d out %d ws %zu (need %zu)\n", n_in, n_in > 0 ? in_sizes[0] : -1, out_size, ws_size, (size_t)WS_END); grid = -1; return; }
        int dev = 0, cus = 0, per_cu = 0;
        if (hipGetDevice(&dev) != hipSuccess || hipDeviceGetAttribute(&cus, hipDeviceAttributeMultiprocessorCount, dev) != hipSuccess) { fprintf(stderr, "kernel_launch: device query failed\n"); grid = -1; return; }
        if (hipFuncSetAttribute((const void*)fwd_kernel, hipFuncAttributeMaxDynamicSharedMemorySize, LDS_BYTES) != hipSuccess) { fprintf(stderr, "kernel_launch: hipFuncSetAttribute failed\n"); grid = -1; return; }
        if (hipOccupancyMaxActiveBlocksPerMultiprocessor(&per_cu, (const void*)fwd_kernel, 512, LDS_BYTES) != hipSuccess || per_cu < 1) {
            fprintf(stderr, "kernel_launch: occupancy query reports %d blocks per CU\n", per_cu); (void)hipGetLastError(); grid = -1; return; }
        grid = cus;
    }
    if (grid < 0) return;
    if (hipMemsetAsync((char*)d_ws + WS_CTL, 0, CTL_ZERO_BYTES, stream) != hipSuccess) { fprintf(stderr, "kernel_launch: memset failed\n"); return; }
    Args a{};
    for (int i = 0; i < 15; ++i) a.in[i] = (const float*)d_in[i];
    a.out = (float*)d_out; a.ws = (unsigned char*)d_ws;
    hipLaunchKernelGGL(fwd_kernel, dim3(grid), dim3(512), LDS_BYTES, stream, a);
    const hipError_t le = hipPeekAtLastError();
    if (le != hipSuccess) fprintf(stderr, "kernel_launch: launch failed: %s\n", hipGetErrorName(le));
}
```
